# Optimizing an MI355X kernel written in HIP

```python
import jax
import jax.numpy as jnp
from jax import lax
import numpy as np

D_MODEL = 1024
BATCH = 8
SEQ = 8192
DEPTH = 2

D_FF = 2816
LN_EPS = 1e-5
RMS_EPS = 1e-6
DEEPNORM_ALPHA = (2 * DEPTH) ** 0.25
DEEPNORM_BETA = (8 * DEPTH) ** -0.25
HALF_STEP = 0.5
N_EVEN = (DEPTH + 1) // 2
N_ODD = DEPTH // 2
NEG = -1e30
BIG = 1e9
ALIBI_MAX_BIAS = 8.0

MLA_HEADS = 8
MLA_Q_RANK = 384
MLA_KV_RANK = 256
MLA_NOPE = 64
MLA_ROPE = 32
MLA_V = 64
ROPE_THETA = 10000.0
MLA_BLOCK = 128

NSA_HEADS = 8
NSA_KV_GROUPS = 2
NSA_HEADS_PER_GROUP = NSA_HEADS // NSA_KV_GROUPS
NSA_HEAD_DIM = 64
CMP_LEN = 32
CMP_STRIDE = 16
CMP_HIDDEN = 256
SEL_BLOCK = 64
SEL_TOPK = 16
WIN = 512
NSA_CHUNK = SEL_BLOCK

DIL_PATTERNS = ((128, 1), (512, 4), (2048, 16))
DIL_GROUPS = 3
DIL_HEADS_PER_GROUP = 4
DIL_HEAD_DIM = 128
DIL_CHUNK = 128
DIL_MAX_WIN = 2048

NSA_KV_WIDTH = NSA_KV_GROUPS * NSA_HEAD_DIM
EVEN_SPLITS = (MLA_Q_RANK, MLA_KV_RANK, MLA_ROPE, NSA_HEADS * NSA_HEAD_DIM) + (NSA_KV_WIDTH,) * 6 + (3 * NSA_HEADS,)
EVEN_IN = sum(EVEN_SPLITS)
EVEN_OUT = MLA_HEADS * MLA_V + NSA_HEADS * NSA_HEAD_DIM
ODD_IN = 3 * DIL_GROUPS * DIL_HEADS_PER_GROUP * DIL_HEAD_DIM
ODD_OUT = DIL_HEADS_PER_GROUP * DIL_HEAD_DIM

kernel_name = "hybrid_mla_nsa_dilated_macaron_deepnorm"


def layer_norm(x, g, b):
    x32 = x.astype(jnp.float32)
    mu = jnp.mean(x32, axis=-1, keepdims=True)
    var = jnp.mean(jnp.square(x32 - mu), axis=-1, keepdims=True)
    y = (x32 - mu) * lax.rsqrt(var + LN_EPS)
    return (y * g.astype(jnp.float32) + b.astype(jnp.float32)).astype(x.dtype)


def rms_norm(x, g):
    x32 = x.astype(jnp.float32)
    y = x32 * lax.rsqrt(jnp.mean(x32 * x32, axis=-1, keepdims=True) + RMS_EPS)
    return (y * g.astype(jnp.float32)).astype(x.dtype)


def swiglu(x, w_gate, w_up, w_down):
    return (jax.nn.silu(x @ w_gate) * (x @ w_up)) @ w_down


def alibi_slopes(n):
    return 2.0 ** (-ALIBI_MAX_BIAS * jnp.arange(1, n + 1, dtype=jnp.float32) / n)


def masked_softmax(s, mask):
    s = jnp.where(mask, s, NEG)
    m = jnp.max(s, axis=-1, keepdims=True)
    e = jnp.where(mask, jnp.exp(s - m), 0.0)
    den = jnp.sum(e, axis=-1, keepdims=True)
    return e / jnp.maximum(den, 1e-30)


def rope(x, pos):
    half = x.shape[-1] // 2
    inv = ROPE_THETA ** (-jnp.arange(half, dtype=jnp.float32) / half)
    ang = pos.astype(jnp.float32)[..., None] * inv
    ang = ang.reshape(ang.shape[:2] + (1,) * (x.ndim - 3) + (half,))
    cos, sin = jnp.cos(ang), jnp.sin(ang)
    x32 = x.astype(jnp.float32)
    x1, x2 = x32[..., :half], x32[..., half:]
    return jnp.concatenate([x1 * cos - x2 * sin, x2 * cos + x1 * sin], axis=-1).astype(x.dtype)


def mla_attention(c_q, c_kv, k_pe, pos, q_norm_g, kv_norm_g, w_uq, w_uk, w_uv):
    B, S, _ = c_kv.shape
    cq = rms_norm(c_q, q_norm_g)
    ckv = rms_norm(c_kv, kv_norm_g)
    q = (cq @ w_uq).reshape(B, S, MLA_HEADS, MLA_NOPE + MLA_ROPE)
    q_nope = q[..., :MLA_NOPE]
    q_pe = rope(q[..., MLA_NOPE:], pos)
    k_nope = (ckv @ w_uk).reshape(B, S, MLA_HEADS, MLA_NOPE)
    v = (ckv @ w_uv).reshape(B, S, MLA_HEADS, MLA_V)
    k_rot = rope(k_pe, pos)
    scale = (MLA_NOPE + MLA_ROPE) ** -0.5
    key_idx = jnp.arange(S)

    def block(i):
        start = i * MLA_BLOCK
        qn = lax.dynamic_slice_in_dim(q_nope, start, MLA_BLOCK, axis=1)
        qp = lax.dynamic_slice_in_dim(q_pe, start, MLA_BLOCK, axis=1)
        s = (jnp.einsum('bqhd,bkhd->bhqk', qn, k_nope)
             + jnp.einsum('bqhr,bkr->bhqk', qp, k_rot)).astype(jnp.float32) * scale
        q_idx = start + jnp.arange(MLA_BLOCK)
        p = masked_softmax(s, q_idx[:, None] >= key_idx[None, :])
        return jnp.einsum('bhqk,bkhd->bqhd', p.astype(v.dtype), v)

    out = lax.map(block, jnp.arange(S // MLA_BLOCK))
    return out.transpose(1, 0, 2, 3, 4).reshape(B, S, MLA_HEADS * MLA_V)


def nsa_attention(q, k_cmp, v_cmp, k_sel, v_sel, k_win, v_win, gate_logits, pos,
                  cmp_pos, cmp_k_w1, cmp_k_w2, cmp_v_w1, cmp_v_w2):
    B, S, _ = q.shape
    G, HPG, DH = NSA_KV_GROUPS, NSA_HEADS_PER_GROUP, NSA_HEAD_DIM
    NC = S // CMP_STRIDE - 1
    NS = S // SEL_BLOCK
    SEL_K = min(SEL_TOPK, NS)
    scale = DH ** -0.5
    q = q.reshape(B, S, G, HPG, DH)
    slopes = alibi_slopes(NSA_HEADS).reshape(G, HPG)[:, :, None, None]
    pos_f = pos.astype(jnp.float32)

    def compress(kv, w1, w2):
        halves = kv.reshape(B, S // CMP_STRIDE, CMP_STRIDE, G, DH)
        blocks = jnp.concatenate([halves[:, :-1], halves[:, 1:]], axis=2) + cmp_pos[:, None, :]
        flat = blocks.transpose(0, 1, 3, 2, 4).reshape(B, NC, G, CMP_LEN * DH)
        return jax.nn.gelu(flat @ w1) @ w2

    kc = compress(k_cmp, cmp_k_w1, cmp_k_w2)
    vc = compress(v_cmp, cmp_v_w1, cmp_v_w2)
    cend_idx = jnp.arange(NC) * CMP_STRIDE + (CMP_LEN - 1)
    pos_cend = pos_f[:, CMP_LEN - 1::CMP_STRIDE]
    cstart = jnp.arange(NC)[:, None] * CMP_STRIDE
    sstart = jnp.arange(NS)[None, :] * SEL_BLOCK
    overlap = ((cstart < sstart + SEL_BLOCK) & (cstart + CMP_LEN > sstart)).astype(jnp.float32)

    ks = k_sel.reshape(B, NS, SEL_BLOCK, G, DH).transpose(0, 3, 1, 2, 4)
    vs = v_sel.reshape(B, NS, SEL_BLOCK, G, DH).transpose(0, 3, 1, 2, 4)
    pos_sel = pos_f.reshape(B, NS, SEL_BLOCK)
    pad = ((0, 0), (WIN, 0), (0, 0), (0, 0))
    kw = jnp.pad(k_win.reshape(B, S, G, DH), pad)
    vw = jnp.pad(v_win.reshape(B, S, G, DH), pad)
    pos_win = jnp.pad(pos_f, ((0, 0), (WIN, 0)))
    gates = jax.nn.sigmoid(gate_logits.reshape(B, S, 3, G, HPG))
    b_ix = jnp.arange(B)[:, None, None, None]
    g_ix = jnp.arange(G)[None, :, None, None]
    blk = jnp.arange(NS)
    J = SEL_K * SEL_BLOCK
    L = WIN + NSA_CHUNK

    def chunk(c):
        start = c * NSA_CHUNK
        t = start + jnp.arange(NSA_CHUNK)
        qc = lax.dynamic_slice_in_dim(q, start, NSA_CHUNK, axis=1)
        pq = lax.dynamic_slice_in_dim(pos_f, start, NSA_CHUNK, axis=1)
        s = jnp.einsum('bqgnd,bkgd->bgnqk', qc, kc).astype(jnp.float32) * scale
        s = s - slopes * (pq[:, :, None] - pos_cend[:, None, :])[:, None, None]
        p_c = masked_softmax(s, cend_idx[None, :] <= t[:, None])
        o_c = jnp.einsum('bgnqk,bkgd->bqgnd', p_c.astype(vc.dtype), vc)
        imp = jnp.einsum('bgnqk,ks->bgqs', p_c, overlap)
        imp = jnp.where((blk == 0) | (blk == c), BIG, imp)
        imp = jnp.where(blk <= c, imp, NEG)
        _, idx = lax.top_k(imp, SEL_K)
        valid = idx <= c
        kg = ks[b_ix, g_ix, idx].reshape(B, G, NSA_CHUNK, J, DH)
        vg = vs[b_ix, g_ix, idx].reshape(B, G, NSA_CHUNK, J, DH)
        kpos = pos_sel[b_ix, idx].reshape(B, G, NSA_CHUNK, J)
        kidx = idx[..., None] * SEL_BLOCK + jnp.arange(SEL_BLOCK)
        mask_s = (valid[..., None] & (kidx <= t[:, None, None])).reshape(B, G, NSA_CHUNK, J)
        s = jnp.einsum('bqgnd,bgqjd->bgnqj', qc, kg).astype(jnp.float32) * scale
        s = s - slopes * (pq[:, None, :, None] - kpos)[:, :, None]
        p_s = masked_softmax(s, mask_s[:, :, None])
        o_s = jnp.einsum('bgnqj,bgqjd->bqgnd', p_s.astype(vg.dtype), vg)
        kwc = lax.dynamic_slice_in_dim(kw, start, L, axis=1)
        vwc = lax.dynamic_slice_in_dim(vw, start, L, axis=1)
        pwc = lax.dynamic_slice_in_dim(pos_win, start, L, axis=1)
        widx = start - WIN + jnp.arange(L)
        diff = t[:, None] - widx[None, :]
        mask_w = (widx[None, :] >= 0) & (diff >= 0) & (diff < WIN)
        s = jnp.einsum('bqgnd,bkgd->bgnqk', qc, kwc).astype(jnp.float32) * scale
        s = s - slopes * (pq[:, :, None] - pwc[:, None, :])[:, None, None]
        p_w = masked_softmax(s, mask_w)
        o_w = jnp.einsum('bgnqk,bkgd->bqgnd', p_w.astype(vwc.dtype), vwc)
        gc = lax.dynamic_slice_in_dim(gates, start, NSA_CHUNK, axis=1)
        return (gc[:, :, 0, :, :, None] * o_c + gc[:, :, 1, :, :, None] * o_s
                + gc[:, :, 2, :, :, None] * o_w)

    out = lax.map(chunk, jnp.arange(S // NSA_CHUNK))
    return out.transpose(1, 0, 2, 3, 4, 5).reshape(B, S, NSA_HEADS * DH)


def dilated_attention(qkv, pos):
    B, S, _ = qkv.shape
    GH, DH, Q = DIL_HEADS_PER_GROUP, DIL_HEAD_DIM, DIL_CHUNK
    scale = DH ** -0.5
    qkv = qkv.reshape(B, S, 3, DIL_GROUPS, GH, DH)
    pad = ((0, 0), (DIL_MAX_WIN, 0), (0, 0), (0, 0))
    pos_f = pos.astype(jnp.float32)
    pos_pad = jnp.pad(pos_f, ((0, 0), (DIL_MAX_WIN, 0)))
    slopes = alibi_slopes(DIL_GROUPS * GH).reshape(DIL_GROUPS, GH)
    qs = [qkv[:, :, 0, g] for g in range(DIL_GROUPS)]
    ks = [jnp.pad(qkv[:, :, 1, g], pad) for g in range(DIL_GROUPS)]
    vs = [jnp.pad(qkv[:, :, 2, g], pad) for g in range(DIL_GROUPS)]

    def chunk(c):
        start = c * Q
        pq = lax.dynamic_slice_in_dim(pos_f, start, Q, axis=1)
        outs, lses = [], []
        for g, (w, dil) in enumerate(DIL_PATTERNS):
            L = w + Q
            off = start + DIL_MAX_WIN - w
            qg = lax.dynamic_slice_in_dim(qs[g], start, Q, axis=1).reshape(B, Q // dil, dil, GH, DH)
            kg = lax.dynamic_slice_in_dim(ks[g], off, L, axis=1).reshape(B, L // dil, dil, GH, DH)
            vg = lax.dynamic_slice_in_dim(vs[g], off, L, axis=1).reshape(B, L // dil, dil, GH, DH)
            pk = lax.dynamic_slice_in_dim(pos_pad, off, L, axis=1).reshape(B, L // dil, dil)
            dist = (pq.reshape(B, Q // dil, dil).transpose(0, 2, 1)[:, :, :, None]
                    - pk.transpose(0, 2, 1)[:, :, None, :])
            s = jnp.einsum('bjrhd,birhd->bhrji', qg, kg).astype(jnp.float32) * scale
            s = s - slopes[g][:, None, None, None] * dist[:, None]
            jj = jnp.arange(Q // dil)[:, None]
            ii = jnp.arange(L // dil)[None, :]
            kidx = start - w + ii * dil + jnp.arange(dil)[:, None, None]
            mask = (ii >= jj) & (ii <= jj + w // dil) & (kidx >= 0)
            s = jnp.where(mask, s, NEG)
            m = jnp.max(s, axis=-1, keepdims=True)
            e = jnp.exp(s - m)
            den = jnp.sum(e, axis=-1, keepdims=True)
            o = jnp.einsum('bhrji,birhd->bjrhd', (e / den).astype(vg.dtype), vg)
            outs.append(o.reshape(B, Q, GH, DH))
            lses.append((m + jnp.log(den))[..., 0].transpose(0, 3, 2, 1).reshape(B, Q, GH))
        wts = jax.nn.softmax(jnp.stack(lses), axis=0)
        out = jnp.einsum('gbqh,gbqhd->bqhd', wts.astype(outs[0].dtype), jnp.stack(outs))
        return out.reshape(B, Q, GH * DH)

    out = lax.map(chunk, jnp.arange(S // Q))
    return out.transpose(1, 0, 2, 3).reshape(B, S, ODD_OUT)


def even_mixer(x, pos, w_in, q_norm_g, kv_norm_g, w_uq, w_uk, w_uv,
               cmp_pos, cmp_k_w1, cmp_k_w2, cmp_v_w1, cmp_v_w2, w_out):
    h = x @ w_in
    cuts = np.cumsum(EVEN_SPLITS)[:-1].tolist()
    c_q, c_kv, k_pe, q, k_c, v_c, k_s, v_s, k_w, v_w, gate_logits = jnp.split(h, cuts, axis=-1)
    o_mla = mla_attention(c_q, c_kv, k_pe, pos, q_norm_g, kv_norm_g, w_uq, w_uk, w_uv)
    o_nsa = nsa_attention(q, k_c, v_c, k_s, v_s, k_w, v_w, gate_logits, pos,
                          cmp_pos, cmp_k_w1, cmp_k_w2, cmp_v_w1, cmp_v_w2)
    return jnp.concatenate([o_mla, o_nsa], axis=-1) @ w_out


def odd_mixer(x, pos, w_in, w_out):
    return dilated_attention(x @ w_in, pos) @ w_out


def setup_inputs(seed: int = 0) -> dict:
    key = jax.random.key(seed)
    keys = iter(jax.random.split(key, 40))
    f32 = jnp.float32

    def nrm(shape, scale):
        return jax.random.normal(next(keys), shape, f32) * scale

    def gain(shape):
        return 1.0 + nrm(shape, 0.02)

    x = jax.random.normal(next(keys), (BATCH, SEQ, D_MODEL), f32)
    offset = jax.random.randint(next(keys), (BATCH, 1), 0, 4096, dtype=jnp.int32)
    positions = offset + jnp.arange(SEQ, dtype=jnp.int32)[None, :]
    return {
        "x": x,
        "positions": positions,
        "ln1_g": gain((DEPTH, D_MODEL)),
        "ln1_b": nrm((DEPTH, D_MODEL), 0.02),
        "ffn1_w_gate": nrm((DEPTH, D_MODEL, D_FF), D_MODEL ** -0.5),
        "ffn1_w_up": nrm((DEPTH, D_MODEL, D_FF), D_MODEL ** -0.5),
        "ffn1_w_down": nrm((DEPTH, D_FF, D_MODEL), DEEPNORM_BETA * D_FF ** -0.5),
        "mix_in_even": nrm((N_EVEN, D_MODEL, EVEN_IN), D_MODEL ** -0.5),
        "mla_q_norm": gain((N_EVEN, MLA_Q_RANK)),
        "mla_kv_norm": gain((N_EVEN, MLA_KV_RANK)),
        "mla_w_uq": nrm((N_EVEN, MLA_Q_RANK, MLA_HEADS * (MLA_NOPE + MLA_ROPE)), MLA_Q_RANK ** -0.5),
        "mla_w_uk": nrm((N_EVEN, MLA_KV_RANK, MLA_HEADS * MLA_NOPE), MLA_KV_RANK ** -0.5),
        "mla_w_uv": nrm((N_EVEN, MLA_KV_RANK, MLA_HEADS * MLA_V), MLA_KV_RANK ** -0.5),
        "nsa_cmp_pos": nrm((N_EVEN, CMP_LEN, NSA_HEAD_DIM), 0.5),
        "nsa_cmp_k_w1": nrm((N_EVEN, CMP_LEN * NSA_HEAD_DIM, CMP_HIDDEN), (CMP_LEN * NSA_HEAD_DIM) ** -0.5),
        "nsa_cmp_k_w2": nrm((N_EVEN, CMP_HIDDEN, NSA_HEAD_DIM), CMP_HIDDEN ** -0.5),
        "nsa_cmp_v_w1": nrm((N_EVEN, CMP_LEN * NSA_HEAD_DIM, CMP_HIDDEN), (CMP_LEN * NSA_HEAD_DIM) ** -0.5),
        "nsa_cmp_v_w2": nrm((N_EVEN, CMP_HIDDEN, NSA_HEAD_DIM), CMP_HIDDEN ** -0.5),
        "mix_out_even": nrm((N_EVEN, EVEN_OUT, D_MODEL), DEEPNORM_BETA * EVEN_OUT ** -0.5),
        "mix_in_odd": nrm((N_ODD, D_MODEL, ODD_IN), D_MODEL ** -0.5),
        "mix_out_odd": nrm((N_ODD, ODD_OUT, D_MODEL), DEEPNORM_BETA * ODD_OUT ** -0.5),
        "ln2_g": gain((DEPTH, D_MODEL)),
        "ln2_b": nrm((DEPTH, D_MODEL), 0.02),
        "ffn2_w_gate": nrm((DEPTH, D_MODEL, D_FF), D_MODEL ** -0.5),
        "ffn2_w_up": nrm((DEPTH, D_MODEL, D_FF), D_MODEL ** -0.5),
        "ffn2_w_down": nrm((DEPTH, D_FF, D_MODEL), DEEPNORM_BETA * D_FF ** -0.5),
        "ln3_g": gain((DEPTH, D_MODEL)),
        "ln3_b": nrm((DEPTH, D_MODEL), 0.02),
    }


def reference(x, positions, ln1_g, ln1_b, ffn1_w_gate, ffn1_w_up, ffn1_w_down,
              mix_in_even, mla_q_norm, mla_kv_norm, mla_w_uq, mla_w_uk, mla_w_uv,
              nsa_cmp_pos, nsa_cmp_k_w1, nsa_cmp_k_w2, nsa_cmp_v_w1, nsa_cmp_v_w2, mix_out_even,
              mix_in_odd, mix_out_odd, ln2_g, ln2_b,
              ffn2_w_gate, ffn2_w_up, ffn2_w_down, ln3_g, ln3_b):
    for i in range(DEPTH):
        j = i // 2
        x = layer_norm(DEEPNORM_ALPHA * x + HALF_STEP * swiglu(x, ffn1_w_gate[i], ffn1_w_up[i], ffn1_w_down[i]),
                       ln1_g[i], ln1_b[i])
        if i % 2 == 0:
            mix = even_mixer(x, positions, mix_in_even[j], mla_q_norm[j], mla_kv_norm[j],
                             mla_w_uq[j], mla_w_uk[j], mla_w_uv[j], nsa_cmp_pos[j],
                             nsa_cmp_k_w1[j], nsa_cmp_k_w2[j], nsa_cmp_v_w1[j], nsa_cmp_v_w2[j],
                             mix_out_even[j])
        else:
            mix = odd_mixer(x, positions, mix_in_odd[j], mix_out_odd[j])
        x = layer_norm(DEEPNORM_ALPHA * x + mix, ln2_g[i], ln2_b[i])
        x = layer_norm(DEEPNORM_ALPHA * x + HALF_STEP * swiglu(x, ffn2_w_gate[i], ffn2_w_up[i], ffn2_w_down[i]),
                       ln3_g[i], ln3_b[i])
    return x
```

```cpp
#include <hip/hip_runtime.h>
#include <hip/hip_cooperative_groups.h>
#include <cstdio>
#include <cstdint>
namespace cg = cooperative_groups;
namespace pg8 {
#define PG8_LAS __attribute__((address_space(3)))
typedef unsigned short bf16_t;
typedef short bf16x8 __attribute__((ext_vector_type(8)));
typedef float f32x4 __attribute__((ext_vector_type(4)));
typedef unsigned u32x4 __attribute__((ext_vector_type(4)));
constexpr int BM = 256, BK = 64, HALF = 128, HTB = HALF * BK * 2  , STAGE_BYTES = 8 * HTB, NXCD = 8, WGM = 8;

__host__ __device__ __forceinline__ int lds_byte(int r, int c) { const int st = (r >> 4) * 2 + (c >> 5), rr = r & 15, cc = c & 31, ob = rr * 64 + cc * 2; return st * 1024 + (ob ^ (((ob >> 9) & 1) << 5)); }
__host__ __device__ __forceinline__ void stage_rc(int b, int& R, int& C) { const int st = b / 1024, sb = b % 1024, swz = sb ^ (((sb >> 9) & 1) << 5); R = (st >> 1) * 16 + swz / 64; C = (st & 1) * 32 + (swz % 64) / 2; }
__host__ __device__ __forceinline__ int perm32(int rho) { const int n = rho >> 4, i = rho & 15; return 8 * (i >> 2) + 4 * n + (i & 3); }

struct Unit { int pm, pn; };
struct Gemm { const bf16_t* A; const bf16_t* Bt; int M, N, K; int lda, ldb, kstepA, bdil;
    __device__ __forceinline__ size_t aoff(int pm) const { return (size_t)pm * 256 * lda * 2; }
    __device__ __forceinline__ size_t boff(int pn) const {
        if (bdil == 0) return (size_t)pn * 256 * ldb * 2;
        const int per = 32 / bdil, b = pn >> 5, rem = pn & 31, r = rem / per, jt = rem % per;
        return ((size_t)b * 8192 + r + (size_t)bdil * 256 * jt) * 1024 * 2; } };

struct StaticOrder {
    int nM, nN, nwg, G, c;
    __host__ __device__ void init(int M, int N, int G_, int c_) { nM = M / BM; nN = N / BM; nwg = nM * nN; G = G_; c = c_; }
    __host__ __device__ bool next(int i, Unit& u) const {
        const long L = (long)i * G + c; if (L >= nwg) return false;
        int wgid = (int)L; { const int q = nwg / NXCD, r = nwg % NXCD, xcd = wgid % NXCD, off = wgid / NXCD; wgid = (xcd < r ? xcd * (q + 1) : r * (q + 1) + (xcd - r) * q) + off; }
        const int nig = WGM * nN, gid = wgid / nig, fm = gid * WGM, gsz = (nM - fm) < WGM ? (nM - fm) : WGM;
        u.pm = fm + ((wgid % nig) % gsz); u.pn = (wgid % nig) / gsz; return true;
    }
    __device__ __forceinline__ void a_ready(const Unit&) const {}
    __device__ __forceinline__ void done(const Unit&) const {}
};

__device__ __forceinline__ unsigned cvt_pk_bf16(float lo, float hi) { unsigned r; asm volatile("v_cvt_pk_bf16_f32 %0, %1, %2" : "=v"(r) : "v"(lo), "v"(hi)); return r; }
typedef float f32x2 __attribute__((ext_vector_type(2)));
template <class Epi, class Sched, bool ALIGN_EPI = false, bool SP2 = false>
__device__ __forceinline__ void gemm_phase(PG8_LAS unsigned char* lds, const Gemm g, const Sched& S, const Epi& E) {
    int tid_o = threadIdx.x; asm volatile("" : "+v"(tid_o)); const int tid = tid_o, wid = __builtin_amdgcn_readfirstlane(tid >> 6), lane = tid & 63, wr = wid >> 2, wc = wid & 3, fr = lane & 15, fq = lane >> 4;
    const int K = g.K, nt = K / BK;
    unsigned voffA[2], voffB[2];
#pragma unroll
    for (int i = 0; i < 2; ++i) { int R, C; stage_rc(tid * 16 + i * 8192, R, C); const int Rb = Epi::PERM ? ((R & ~31) + perm32(R & 31)) : R;
        voffA[i] = (unsigned)(R * g.lda + C) * 2u; voffB[i] = (unsigned)(Rb * g.ldb + C) * 2u; }
    const size_t kstepB = (size_t)(BK * 2), kstepA = (size_t)g.kstepA;
    const size_t hstepA = (size_t)HALF * g.lda * 2, hstepB = (size_t)HALF * g.ldb * 2;
    const unsigned ldsw = (unsigned)wid * 1024u;
    const int aoff = lds_byte(wr * 64 + fr, fq * 8), boff = lds_byte(wc * 32 + fr, fq * 8);
#define PG8_SA(b, h) (((b) * 2 + (h)) * HTB)
#define PG8_SB(b, h) ((4 + (b) * 2 + (h)) * HTB)
#define PG8_STAGE(bufoff, gbase, voff) do { _Pragma("unroll") for (int _i = 0; _i < 2; ++_i) \
        __builtin_amdgcn_global_load_lds((const unsigned*)((const char*)(gbase) + (voff)[_i]), (PG8_LAS unsigned*)(lds + (bufoff) + ldsw + _i * 8192), 16, 0, 0); } while (0)
#define PG8_LDA(dst, b, h) do { _Pragma("unroll") for (int m = 0; m < 4; ++m) _Pragma("unroll") for (int k = 0; k < 2; ++k) dst[m][k] = *(const PG8_LAS bf16x8*)(lds + PG8_SA(b, h) + aoff + m * 2048 + k * 1024); } while (0)
#define PG8_LDB(dst, b, h) do { _Pragma("unroll") for (int n = 0; n < 2; ++n) _Pragma("unroll") for (int k = 0; k < 2; ++k) dst[n][k] = *(const PG8_LAS bf16x8*)(lds + PG8_SB(b, h) + boff + n * 2048 + k * 1024); } while (0)
#define PG8_MMA(ai, bj, At, Bt) do { __builtin_amdgcn_s_setprio(1); _Pragma("unroll") for (int m = 0; m < 4; ++m) _Pragma("unroll") for (int n = 0; n < 2; ++n) _Pragma("unroll") for (int k = 0; k < 2; ++k) \
        acc[ai][bj][m][n] = __builtin_amdgcn_mfma_f32_16x16x32_bf16(Bt[n][k], At[m][k], acc[ai][bj][m][n], 0, 0, 0); __builtin_amdgcn_s_setprio(0); } while (0)
#define PG8_WAIT_V(n) asm volatile("s_waitcnt vmcnt(" #n ")" ::: "memory")
#define PG8_WAIT_L(n) asm volatile("s_waitcnt lgkmcnt(" #n ")" ::: "memory")
#define PG8_BAR __builtin_amdgcn_s_barrier()
#define PG8_SCHED __builtin_amdgcn_sched_barrier(0)
    Unit cur, nxt; int ui = 0;
    if (!S.next(0, cur)) return;
    f32x4 acc[2][2][4][2];
#pragma unroll
    for (int a = 0; a < 2; ++a)
#pragma unroll
        for (int b = 0; b < 2; ++b)
#pragma unroll
            for (int m = 0; m < 4; ++m)
#pragma unroll
                for (int n = 0; n < 2; ++n) acc[a][b][m][n] = (f32x4){0.f, 0.f, 0.f, 0.f};
    bf16x8 At[4][2], B0[2][2], B1[2][2];
    const char* cA = (const char*)g.A + g.aoff(cur.pm); const char* cB = (const char*)g.Bt + g.boff(cur.pn);
    S.a_ready(cur);
    if constexpr (SP2) {
        PG8_STAGE(PG8_SB(0, 0), cB, voffB); PG8_STAGE(PG8_SB(0, 1), cB + hstepB, voffB); PG8_STAGE(PG8_SA(0, 0), cA, voffA); PG8_STAGE(PG8_SA(0, 1), cA + hstepA, voffA);
        if (wr == 1) PG8_BAR;
        PG8_WAIT_V(2); PG8_BAR;
        PG8_STAGE(PG8_SB(1, 0), cB + kstepB, voffB); PG8_STAGE(PG8_SA(1, 0), cA + kstepA, voffA); PG8_STAGE(PG8_SB(1, 1), cB + hstepB + kstepB, voffB);
        PG8_WAIT_V(6); PG8_BAR;
    } else {
        PG8_STAGE(PG8_SB(0, 0), cB, voffB); PG8_STAGE(PG8_SA(0, 0), cA, voffA); PG8_STAGE(PG8_SB(0, 1), cB + hstepB, voffB); PG8_STAGE(PG8_SA(0, 1), cA + hstepA, voffA);
        if (wr == 1) PG8_BAR;
        PG8_WAIT_V(4); PG8_BAR;
        PG8_STAGE(PG8_SB(1, 0), cB + kstepB, voffB); PG8_STAGE(PG8_SA(1, 0), cA + kstepA, voffA); PG8_STAGE(PG8_SB(1, 1), cB + hstepB + kstepB, voffB);
        PG8_WAIT_V(6); PG8_BAR;
    }
    for (;;) {
        const bool has_next = S.next(ui + 1, nxt);
        const char* nA = has_next ? (const char*)g.A + g.aoff(nxt.pm) : cA; const char* nB = has_next ? (const char*)g.Bt + g.boff(nxt.pn) : cB;
        _Pragma("clang loop unroll(disable)") for (int t = 0; t < nt; t += 2) {
            const bool last = (t == nt - 2);
            const char* a1 = cA + (size_t)(t + 1) * kstepA;
            const char* a2 = last ? nA : cA + (size_t)(t + 2) * kstepA; const char* b2 = last ? nB : cB + (size_t)(t + 2) * kstepB;
            const char* a3 = a2 + kstepA; const char* b3 = b2 + kstepB;
            if (last && has_next) S.a_ready(nxt);
            if constexpr (SP2) {
            PG8_LDB(B0, 0, 0); PG8_LDB(B1, 0, 1); PG8_SCHED; PG8_LDA(At, 0, 0); PG8_STAGE(PG8_SA(1, 1), a1 + hstepA, voffA);
            PG8_WAIT_V(8); PG8_WAIT_L(0); PG8_BAR; PG8_MMA(0, 0, At, B0); PG8_MMA(0, 1, At, B1); PG8_BAR; PG8_SCHED;
            PG8_LDA(At, 0, 1); PG8_STAGE(PG8_SB(0, 0), b2, voffB); PG8_STAGE(PG8_SB(0, 1), b2 + hstepB, voffB); PG8_STAGE(PG8_SA(0, 0), a2, voffA);
            PG8_WAIT_V(8); PG8_WAIT_L(0); PG8_BAR; PG8_MMA(1, 0, At, B0); PG8_MMA(1, 1, At, B1); PG8_BAR; PG8_SCHED;
            PG8_LDB(B0, 1, 0); PG8_LDB(B1, 1, 1); PG8_SCHED; PG8_LDA(At, 1, 0); PG8_STAGE(PG8_SA(0, 1), a2 + hstepA, voffA);
            PG8_WAIT_V(8); PG8_WAIT_L(0); PG8_BAR; PG8_MMA(0, 0, At, B0); PG8_MMA(0, 1, At, B1); PG8_BAR; PG8_SCHED;
            PG8_LDA(At, 1, 1); PG8_STAGE(PG8_SB(1, 0), b3, voffB); PG8_STAGE(PG8_SB(1, 1), b3 + hstepB, voffB); PG8_STAGE(PG8_SA(1, 0), a3, voffA);
            PG8_WAIT_V(8); PG8_WAIT_L(0); PG8_BAR; PG8_MMA(1, 0, At, B0); PG8_MMA(1, 1, At, B1); PG8_BAR; PG8_SCHED;
            } else {
            PG8_LDB(B0, 0, 0); PG8_SCHED; PG8_LDA(At, 0, 0); PG8_STAGE(PG8_SA(1, 1), a1 + hstepA, voffA);
            PG8_WAIT_L(8); PG8_BAR; PG8_WAIT_L(0); PG8_MMA(0, 0, At, B0); PG8_BAR; PG8_SCHED;
            PG8_LDB(B1, 0, 1); PG8_STAGE(PG8_SB(0, 0), b2, voffB);
            PG8_BAR; PG8_WAIT_L(0); PG8_MMA(0, 1, At, B1); PG8_BAR;
            PG8_LDA(At, 0, 1); PG8_STAGE(PG8_SA(0, 0), a2, voffA);
            PG8_BAR; PG8_WAIT_L(0); PG8_MMA(1, 0, At, B0); PG8_BAR; PG8_SCHED;
            PG8_STAGE(PG8_SB(0, 1), b2 + hstepB, voffB);
            PG8_WAIT_V(6); PG8_BAR; PG8_MMA(1, 1, At, B1); PG8_BAR;
            PG8_LDB(B0, 1, 0); PG8_SCHED; PG8_LDA(At, 1, 0); PG8_STAGE(PG8_SA(0, 1), a2 + hstepA, voffA);
            PG8_WAIT_L(8); PG8_BAR; PG8_WAIT_L(0); PG8_MMA(0, 0, At, B0); PG8_BAR; PG8_SCHED;
            PG8_LDB(B1, 1, 1); PG8_STAGE(PG8_SB(1, 0), b3, voffB);
            PG8_BAR; PG8_WAIT_L(0); PG8_MMA(0, 1, At, B1); PG8_BAR;
            PG8_LDA(At, 1, 1); PG8_STAGE(PG8_SA(1, 0), a3, voffA);
            PG8_BAR; PG8_WAIT_L(0); PG8_MMA(1, 0, At, B0); PG8_BAR; PG8_SCHED;
            PG8_STAGE(PG8_SB(1, 1), b3 + hstepB, voffB);
            PG8_WAIT_V(6); PG8_BAR; PG8_MMA(1, 1, At, B1); PG8_BAR;
            }
        }
        if constexpr (ALIGN_EPI) { if (wr == 0) PG8_BAR; }
        if constexpr (!Epi::AFTER_DRAIN) { E(acc, cur, wr, wc, fr, fq); S.done(cur); }
        if (!has_next) break;
#pragma unroll
        for (int a = 0; a < 2; ++a)
#pragma unroll
            for (int b = 0; b < 2; ++b)
#pragma unroll
                for (int m = 0; m < 4; ++m)
#pragma unroll
                    for (int n = 0; n < 2; ++n) acc[a][b][m][n] = (f32x4){0.f, 0.f, 0.f, 0.f};
        cur = nxt; cA = nA; cB = nB; ++ui;
        if constexpr (ALIGN_EPI) { if (wr == 1) PG8_BAR; }
    }
    PG8_WAIT_V(0);
    if constexpr (!ALIGN_EPI) { if (wr == 0) PG8_BAR; }
    PG8_BAR;
    if constexpr (Epi::AFTER_DRAIN) { E.fused(acc, cur, wr, wc, fr, fq, lds, wid, lane); S.done(cur); }
#undef PG8_SA
#undef PG8_SB
#undef PG8_STAGE
#undef PG8_LDA
#undef PG8_LDB
#undef PG8_MMA
#undef PG8_WAIT_V
#undef PG8_WAIT_L
#undef PG8_BAR
#undef PG8_SCHED
}
}
#define LAS __attribute__((address_space(3)))
typedef unsigned short bf16;
using pg8::f32x4; using pg8::bf16x8; using pg8::u32x4; using pg8::Unit; using pg8::cvt_pk_bf16;
typedef float f32x16 __attribute__((ext_vector_type(16)));
typedef unsigned u32x2 __attribute__((ext_vector_type(2)));
typedef short s16x4 __attribute__((ext_vector_type(4)));

constexpr int NB = 8, SEQ = 8192, T = NB * SEQ, DM = 1024, FF = 2816;
constexpr int HE_LD = 1792;
constexpr int HE_CQ = 0, HE_CKV = 384, HE_KPE = 640, HE_Q = 672, HE_KC = 1184, HE_VC = 1312, HE_KS = 1440, HE_KW = 1568, HE_GT = 1696;
constexpr float LOG2E = 1.4426950408889634f;
constexpr float DN_ALPHA = 1.4142135623730951f;
constexpr float NEGB = -1e30f;

constexpr size_t MiB = 1u << 20;
constexpr size_t WS_CTL = 0;
constexpr size_t WS_W = 1 * MiB;
constexpr size_t WS_PT = 256 * 1024;
constexpr size_t WS_ST = 512 * 1024;
constexpr size_t WE_GU = 0;
constexpr size_t WE_D = WE_GU + 4ull * 5632 * 1024;
constexpr size_t WE_E1 = WE_D + 4ull * 1024 * 2816;
constexpr size_t WE_E2 = WE_E1 + 1792ull * 1024;
constexpr size_t WE_UQ = WE_E2 + 256ull * 1024;
constexpr size_t WE_UK = WE_UQ + 768ull * 384;
constexpr size_t WE_UV = WE_UK + 512ull * 256;
constexpr size_t WE_C1K = WE_UV + 512ull * 256;
constexpr size_t WE_C1V = WE_C1K + 256ull * 2048;
constexpr size_t WE_C2K = WE_C1V + 256ull * 2048;
constexpr size_t WE_C2V = WE_C2K + 256ull * 256;
constexpr size_t WE_OE = WE_C2V + 256ull * 256;
constexpr size_t WE_O1 = WE_OE + 1024ull * 1024;
constexpr size_t WE_O2 = WE_O1 + 3072ull * 1024;
constexpr size_t WE_OO = WE_O2 + 1536ull * 1024;
constexpr size_t WE_END = WE_OO + 1024ull * 512;
static_assert(WE_END * 2 <= 95 * MiB, "weights fit");
constexpr size_t WS_CB = 96 * MiB;
constexpr size_t WS_XB = 97 * MiB;
constexpr size_t WS_R = 225 * MiB;
constexpr size_t R_H = WS_R;
constexpr size_t R_HE = WS_R;
constexpr size_t R_VT = WS_R + 224 * MiB;
constexpr size_t R_QM = WS_R + 256 * MiB;
constexpr size_t R_KN = WS_R + 352 * MiB;
constexpr size_t R_VMT = WS_R + 416 * MiB;
constexpr size_t R_OE = WS_R + 480 * MiB;
constexpr size_t R_KROT = WS_R + 608 * MiB;
constexpr size_t R_RT = WS_R + 612 * MiB;
constexpr size_t R_GT = WS_R + 620 * MiB;
constexpr size_t R_RSTD = WS_R + 628 * MiB;
constexpr size_t R_HC = WS_R + 629 * MiB;
constexpr size_t R_KCC = WS_R + 645 * MiB;
constexpr size_t R_VCT = WS_R + 647 * MiB;
constexpr size_t R_QK = WS_R;
constexpr size_t R_VOT = WS_R + 384 * MiB;
constexpr size_t R_OG = WS_R + 576 * MiB;
constexpr size_t R_LSE = WS_R + 768 * MiB;
constexpr size_t R_OO = WS_R;
constexpr size_t WS_NEED = WS_R + 772 * MiB;
static_assert(WS_NEED <= 1024 * MiB, "ws");

constexpr int LDS_BYTES = 147456;

__device__ __forceinline__ float fast_exp2(float x) { return __builtin_amdgcn_exp2f(x); }
__device__ __forceinline__ float fast_rcp(float x) { return __builtin_amdgcn_rcpf(x); }
__device__ __forceinline__ float bf2f(bf16 v) { return __uint_as_float(((unsigned)v) << 16); }
__device__ __forceinline__ float wave_sum(float v) {
#pragma unroll
    for (int o = 1; o < 64; o <<= 1) v += __shfl_xor(v, o);
    return v;
}

struct EpiStore {
    static constexpr bool PERM = true, AFTER_DRAIN = false;
    bf16* O; int ldc; const float* rscale; const float* cscale; const float* bias; int act; int ncv; int nrv; int zrow; int zcol;
    __device__ __forceinline__ void operator()(const f32x4 (&acc)[2][2][4][2], const Unit& u, int wr, int wc, int fr, int fq) const {
#pragma unroll
        for (int bj = 0; bj < 2; ++bj) {
            const int col = u.pn * 256 + bj * 128 + wc * 32 + 8 * fq;
            if (col < ncv) {
                float cs[8], bs[8];
#pragma unroll
                for (int e = 0; e < 8; ++e) { cs[e] = cscale ? cscale[col + e] : 1.f; bs[e] = bias ? bias[col + e] : 0.f; }
#pragma unroll
                for (int ai = 0; ai < 2; ++ai)
#pragma unroll
                    for (int m = 0; m < 4; ++m) {
                        const int row = u.pm * 256 + ai * 128 + wr * 64 + m * 16 + fr;
                        if (row < nrv) {
                            const float rs = rscale ? rscale[row] : 1.f;
                            const f32x4 v0 = acc[ai][bj][m][0], v1 = acc[ai][bj][m][1];
                            float v[8] = {v0[0], v0[1], v0[2], v0[3], v1[0], v1[1], v1[2], v1[3]};
                            const bool zr = zrow && ((row & 511) == 511);
#pragma unroll
                            for (int e = 0; e < 8; ++e) {
                                float x = v[e] + bs[e];
                                if (act == 1) { const float y = 0.7978845608028654f * (x + 0.044715f * x * x * x); x = x * fast_rcp(1.f + fast_exp2(-2.f * LOG2E * y)); }
                                x *= rs * cs[e];
                                if (zr || (zcol && (((col + e) & 511) == 511))) x = 0.f;
                                v[e] = x;
                            }
                            u32x4 w; w.x = cvt_pk_bf16(v[0], v[1]); w.y = cvt_pk_bf16(v[2], v[3]); w.z = cvt_pk_bf16(v[4], v[5]); w.w = cvt_pk_bf16(v[6], v[7]);
                            *(u32x4*)(O + (size_t)row * ldc + col) = w;
                        }
                    }
            }
        }
    }
};
struct EpiSwiglu {
    static constexpr bool PERM = true, AFTER_DRAIN = false;
    bf16* H; int ldh;
    __device__ __forceinline__ void operator()(const f32x4 (&acc)[2][2][4][2], const Unit& u, int wr, int wc, int fr, int fq) const {
        const int col = u.pn * 128 + wc * 32 + 8 * fq;
#pragma unroll
        for (int ai = 0; ai < 2; ++ai)
#pragma unroll
            for (int m = 0; m < 4; ++m) {
                const int row = u.pm * 256 + ai * 128 + wr * 64 + m * 16 + fr;
                const f32x4 g0 = acc[ai][0][m][0], g1 = acc[ai][0][m][1], u0 = acc[ai][1][m][0], u1 = acc[ai][1][m][1];
                float g[8] = {g0[0], g0[1], g0[2], g0[3], g1[0], g1[1], g1[2], g1[3]};
                float uu[8] = {u0[0], u0[1], u0[2], u0[3], u1[0], u1[1], u1[2], u1[3]};
#pragma unroll
                for (int e = 0; e < 8; ++e) g[e] = g[e] * fast_rcp(1.f + fast_exp2(-LOG2E * g[e])) * uu[e];
                u32x4 w; w.x = cvt_pk_bf16(g[0], g[1]); w.y = cvt_pk_bf16(g[2], g[3]); w.z = cvt_pk_bf16(g[4], g[5]); w.w = cvt_pk_bf16(g[6], g[7]);
                *(u32x4*)(H + (size_t)row * ldh + col) = w;
            }
    }
};
template <bool LN>
struct EpiResidT {
    static constexpr bool PERM = true, AFTER_DRAIN = false;
    const float* Xin; float* Xout; unsigned char* ws; int gi, bi, goff; float alpha, beta;
    __device__ __forceinline__ void operator()(const f32x4 (&acc)[2][2][4][2], const Unit& u, int wr, int wc, int fr, int fq) const {
        constexpr int ldx = 1024;
        const float* st = (const float*)(ws + WS_ST); const float* gam = nullptr; const float* bet = nullptr;
        if (LN) { const float* const* PT = (const float* const*)(ws + WS_PT); gam = PT[gi] + goff; bet = PT[bi] + goff; }
#pragma unroll
        for (int bj = 0; bj < 2; ++bj) {
            const int col = u.pn * 256 + bj * 128 + wc * 32 + 8 * fq;
            f32x4 g0, g1, b0, b1;
            if (LN) { g0 = *(const f32x4*)(gam + col); g1 = *(const f32x4*)(gam + col + 4); b0 = *(const f32x4*)(bet + col); b1 = *(const f32x4*)(bet + col + 4); }
#pragma unroll
            for (int ai = 0; ai < 2; ++ai) {
                f32x4 x0[4], x1[4]; float mean[4], rstd[4];
#pragma unroll
                for (int m = 0; m < 4; ++m) {
                    const int row = u.pm * 256 + ai * 128 + wr * 64 + m * 16 + fr;
                    const size_t off = (size_t)row * ldx + col;
                    x0[m] = *(const f32x4*)(Xin + off); x1[m] = *(const f32x4*)(Xin + off + 4);
                    if (LN) { mean[m] = st[2 * row]; rstd[m] = st[2 * row + 1]; }
                }
#pragma unroll
                for (int m = 0; m < 4; ++m) {
                    const int row = u.pm * 256 + ai * 128 + wr * 64 + m * 16 + fr;
                    const size_t off = (size_t)row * ldx + col;
                    f32x4 a0 = x0[m], a1 = x1[m];
                    if (LN) { a0 = (a0 - mean[m]) * rstd[m] * g0 + b0; a1 = (a1 - mean[m]) * rstd[m] * g1 + b1; }
                    *(f32x4*)(Xout + off) = a0 * alpha + acc[ai][bj][m][0] * beta;
                    *(f32x4*)(Xout + off + 4) = a1 * alpha + acc[ai][bj][m][1] * beta;
                }
            }
        }
    }
};
struct EpiRopeQ {
    static constexpr bool PERM = true, AFTER_DRAIN = false;
    bf16* Q; int ldq; const float* rstd; const float* RT; float qscale;
    __device__ __forceinline__ void operator()(const f32x4 (&acc)[2][2][4][2], const Unit& u, int wr, int wc, int fr, int fq) const {
#pragma unroll
        for (int bj = 0; bj < 2; ++bj) {
            const int grp = u.pn * 8 + bj * 4 + wc; const bool is_rope = (grp % 3) == 2;
            const int col = u.pn * 256 + bj * 128 + wc * 32 + 8 * fq;
#pragma unroll
            for (int ai = 0; ai < 2; ++ai)
#pragma unroll
                for (int m = 0; m < 4; ++m) {
                    const int row = u.pm * 256 + ai * 128 + wr * 64 + m * 16 + fr;
                    const float rs = rstd[row] * qscale;
                    f32x4 v0 = acc[ai][bj][m][0] * rs, v1 = acc[ai][bj][m][1] * rs;
                    if (is_rope) {
                        const f32x4 c01 = *(const f32x4*)(RT + (size_t)row * 32 + 8 * fq), c23 = *(const f32x4*)(RT + (size_t)row * 32 + 8 * fq + 4);
                        const float cs[4] = {c01[0], c01[2], c23[0], c23[2]}, sn[4] = {c01[1], c01[3], c23[1], c23[3]};
                        f32x4 o1, o2;
#pragma unroll
                        for (int e = 0; e < 4; ++e) { o1[e] = v0[e] * cs[e] - v1[e] * sn[e]; o2[e] = v1[e] * cs[e] + v0[e] * sn[e]; }
                        v0 = o1; v1 = o2;
                    }
                    u32x4 w; w.x = cvt_pk_bf16(v0[0], v0[1]); w.y = cvt_pk_bf16(v0[2], v0[3]); w.z = cvt_pk_bf16(v1[0], v1[1]); w.w = cvt_pk_bf16(v1[2], v1[3]);
                    *(u32x4*)(Q + (size_t)row * ldq + col) = w;
                }
        }
    }
};
#define XB_TMO      128
#define XB_XCNT(j)  (256  + 64 * (j))
#define XB_XSUB(j)  (1280 + 64 * (j))
#define XB_XGEN(j)  (2304 + 64 * (j))
#define XB_TOP      3328
#define XB_TOPGEN   3392
#define XCD_BAR_WORDS 3456
#define XB_SPIN_CAP (1u << 18)

__device__ __forceinline__ unsigned xb_ld(unsigned* p)              { return __hip_atomic_load(p, __ATOMIC_RELAXED, __HIP_MEMORY_SCOPE_AGENT); }
__device__ __forceinline__ unsigned xb_add(unsigned* p, unsigned v) { return __hip_atomic_fetch_add(p, v, __ATOMIC_RELAXED, __HIP_MEMORY_SCOPE_AGENT); }
__device__ __forceinline__ unsigned xb_xcc_id() { return (unsigned)__builtin_amdgcn_s_getreg((3 << 11) | 20) & 0xFu; }
#define XB_SPIN(cond, bar) do { unsigned _sp = 0; while (cond) { __builtin_amdgcn_s_sleep(1); \
    if ((++_sp & 255u) == 0u) { if (xb_ld(&(bar)[XB_TMO])) break; if (_sp > XB_SPIN_CAP) { atomicAdd(&(bar)[XB_TMO], 1u); break; } } } } while (0)

struct XcdBarrier {
    unsigned* bar; unsigned x;
    volatile LAS unsigned* st;
};

__device__ __forceinline__ XcdBarrier xcd_barrier_post(unsigned* bar, volatile LAS unsigned* st) {
    XcdBarrier b; b.bar = bar; b.x = xb_xcc_id(); b.st = st;
    if (threadIdx.x == 0) (void)xb_add(&bar[XB_XCNT(b.x)], 1u);
    return b;
}
__device__ __forceinline__ void xcd_barrier_complete(unsigned* bar, unsigned x, unsigned& nloc, unsigned& nx) {
    const unsigned G = gridDim.x * gridDim.y * gridDim.z;
    unsigned sum, cnt, mine, sp = 0u;
    for (;;) {
        sum = 0u; cnt = 0u; mine = 0u;
#pragma unroll
        for (unsigned j = 0; j < 16; ++j) { const unsigned c = xb_ld(&bar[XB_XCNT(j)]); sum += c; cnt += (c > 0u) ? 1u : 0u; mine = (j == x) ? c : mine; }
        if (sum == G) break;
        __builtin_amdgcn_s_sleep(1);
        if ((++sp & 255u) == 0u) { if (xb_ld(&bar[XB_TMO])) break; if (sp > XB_SPIN_CAP) { atomicAdd(&bar[XB_TMO], 1u); break; } }
    }
    nloc = mine > 0u ? mine : 1u; nx = cnt > 0u ? cnt : 1u;
}

__device__ __forceinline__ void xcd_barrier(const XcdBarrier& b) {
    asm volatile("s_waitcnt vmcnt(0)" ::: "memory");
    __syncthreads();
    if (threadIdx.x == 0) {
        unsigned* bar = b.bar;
        __builtin_amdgcn_s_waitcnt(0);
        unsigned nloc = b.st[0], nx = b.st[1];
        if (nloc == 0u) { xcd_barrier_complete(bar, b.x, nloc, nx); b.st[0] = nloc; b.st[1] = nx; }
        const unsigned old = xb_add(&bar[XB_XSUB(b.x)], 1u);
        const unsigned gen = old / nloc;
        if (old + 1u == (gen + 1u) * nloc) {
            __builtin_amdgcn_fence(__ATOMIC_RELEASE, "agent");
            asm volatile("s_waitcnt vmcnt(0)" ::: "memory");
            const unsigned og = xb_add(&bar[XB_TOP], 1u);
            const unsigned tg = og / nx;
            if (og + 1u == (tg + 1u) * nx) xb_add(&bar[XB_TOPGEN], 1u);
            else XB_SPIN(xb_ld(&bar[XB_TOPGEN]) == tg, bar);
            __builtin_amdgcn_fence(__ATOMIC_ACQUIRE, "agent");
            xb_add(&bar[XB_XGEN(b.x)], 1u);
            asm volatile("s_waitcnt vmcnt(0)" ::: "memory");
        } else {
            XB_SPIN(xb_ld(&bar[XB_XGEN(b.x)]) == gen, bar);
            __builtin_amdgcn_fence(__ATOMIC_ACQUIRE, "agent");
            asm volatile("s_waitcnt vmcnt(0)" ::: "memory");
        }
    }
    __syncthreads();
}
struct KP {
    float* out; unsigned char* ws; const int* pos;
    __device__ __forceinline__ const int* pos_local() const { int one = 1; asm volatile("" : "+s"(one)); return (const int*)(((const float* const*)(ws + WS_PT))[one]); }
#define KP_ACC(T_, NAME, OFF) __device__ __forceinline__ T_* NAME() const { return (T_*)(ws + (OFF)); }
    KP_ACC(bf16, WB, WS_W) KP_ACC(bf16, XB, WS_XB) KP_ACC(bf16, H, R_H) KP_ACC(bf16, HE, R_HE) KP_ACC(bf16, VT, R_VT) KP_ACC(bf16, QM, R_QM)
    KP_ACC(bf16, KN, R_KN) KP_ACC(bf16, VMT, R_VMT) KP_ACC(bf16, OE, R_OE) KP_ACC(bf16, KROT, R_KROT) KP_ACC(bf16, HC, R_HC) KP_ACC(bf16, KCC, R_KCC)
    KP_ACC(bf16, VCT, R_VCT) KP_ACC(bf16, QK, R_QK) KP_ACC(bf16, VOT, R_VOT) KP_ACC(bf16, OG, R_OG) KP_ACC(bf16, OO, R_OO)
    KP_ACC(float, RT, R_RT) KP_ACC(float, GT, R_GT) KP_ACC(float, RSTD, R_RSTD) KP_ACC(float, LSE, R_LSE) KP_ACC(float, CB, WS_CB) KP_ACC(unsigned, CTL, WS_CTL)
};

__device__ __forceinline__ int crow(int v, int hi) { return (v & 3) + 8 * (v >> 2) + 4 * hi; }
__device__ __forceinline__ float xhalf_max(float x) { auto rr = __builtin_amdgcn_permlane32_swap(__float_as_uint(x), __float_as_uint(x), false, false); return fmaxf(__uint_as_float(rr[0]), __uint_as_float(rr[1])); }
__device__ __forceinline__ float xhalf_sum(float x) { auto rr = __builtin_amdgcn_permlane32_swap(__float_as_uint(x), __float_as_uint(x), false, false); return __uint_as_float(rr[0]) + __uint_as_float(rr[1]); }
__device__ __forceinline__ float max16(const f32x16& s) {
    float a = fmaxf(fmaxf(s[0], s[1]), s[2]), b = fmaxf(fmaxf(s[3], s[4]), s[5]);
    a = fmaxf(fmaxf(a, s[6]), s[7]); b = fmaxf(fmaxf(b, s[8]), s[9]); a = fmaxf(fmaxf(a, s[10]), s[11]); b = fmaxf(fmaxf(b, s[12]), s[13]);
    return fmaxf(fmaxf(a, b), fmaxf(s[14], s[15])); }

template <int DK16>
__device__ __forceinline__ f32x16 qk_sub(const LAS unsigned char* Kt, int ks, int sub, const bf16x8 (&qf)[DK16], int r32, int hi) {
    f32x16 s;
#pragma unroll
    for (int v = 0; v < 16; ++v) s[v] = 0.f;
    const LAS unsigned char* p = Kt + (sub * 32 + r32) * ks + hi * 16;
#pragma unroll
    for (int dk = 0; dk < DK16; ++dk) { const bf16x8 kf = *(const LAS bf16x8*)(p + dk * 32); s = __builtin_amdgcn_mfma_f32_32x32x16_bf16(kf, qf[dk], s, 0, 0, 0); }
    return s;
}
template <int DV32>
__device__ __forceinline__ void pv_sub(f32x16 (&o)[DV32], const LAS unsigned char* Vt, int vs, int sub, const f32x16& p, int r32, int hi) {
#pragma unroll
    for (int kb = 0; kb < 2; ++kb) {
        u32x4 pw; pw.x = cvt_pk_bf16(p[8 * kb + 0], p[8 * kb + 1]); pw.y = cvt_pk_bf16(p[8 * kb + 2], p[8 * kb + 3]); pw.z = cvt_pk_bf16(p[8 * kb + 4], p[8 * kb + 5]); pw.w = cvt_pk_bf16(p[8 * kb + 6], p[8 * kb + 7]);
        const bf16x8 pf = __builtin_bit_cast(bf16x8, pw);
#pragma unroll
        for (int i = 0; i < DV32; ++i) {
            const LAS unsigned char* vp = Vt + (32 * i + r32) * vs + (sub * 32 + 16 * kb + 4 * hi) * 2;
            const s16x4 lo = *(const LAS s16x4*)vp, hh = *(const LAS s16x4*)(vp + 16);
            const bf16x8 vf = (bf16x8){lo[0], lo[1], lo[2], lo[3], hh[0], hh[1], hh[2], hh[3]};
            o[i] = __builtin_amdgcn_mfma_f32_32x32x16_bf16(vf, pf, o[i], 0, 0, 0);
        }
    }
}
template <int DV32>
__device__ __forceinline__ void pv_packed(f32x16 (&o)[DV32], const LAS unsigned char* Vt, int vs, int sub, const u32x4& pk0, const u32x4& pk1, int r32, int hi) {
#pragma unroll
    for (int kb = 0; kb < 2; ++kb) {
        const bf16x8 pf = __builtin_bit_cast(bf16x8, kb == 0 ? pk0 : pk1);
#pragma unroll
        for (int i = 0; i < DV32; ++i) {
            const LAS unsigned char* vp = Vt + (32 * i + r32) * vs + (sub * 32 + 16 * kb + 4 * hi) * 2;
            const s16x4 lo = *(const LAS s16x4*)vp, hh = *(const LAS s16x4*)(vp + 16);
            const bf16x8 vf = (bf16x8){lo[0], lo[1], lo[2], lo[3], hh[0], hh[1], hh[2], hh[3]};
            o[i] = __builtin_amdgcn_mfma_f32_32x32x16_bf16(vf, pf, o[i], 0, 0, 0);
        }
    }
}
__device__ __forceinline__ u32x4 pack8(const f32x16& p, int kb) {
    u32x4 pw; pw.x = cvt_pk_bf16(p[8 * kb + 0], p[8 * kb + 1]); pw.y = cvt_pk_bf16(p[8 * kb + 2], p[8 * kb + 3]); pw.z = cvt_pk_bf16(p[8 * kb + 4], p[8 * kb + 5]); pw.w = cvt_pk_bf16(p[8 * kb + 6], p[8 * kb + 7]); return pw; }
template <int D, int DV, int MODE, bool HASBIAS, bool JOINT, bool DEFER, class KA, class VA, class PF, class BF, class VF, class NM, class WS, class CB>
__device__ __forceinline__ void fa_loop(LAS unsigned char* lds, int nt, const KA& ka, const VA& va, const PF& pf, const BF& bf, const VF& vf, const NM& nm, const WS& wskip, const CB& cb, float c1,
                                        const bf16x8 (&qf)[D / 16], float& m, float& l, f32x16 (&o)[DV / 32], int tid_in, int r32, int hi) {
    int tid = tid_in; asm volatile("" : "+v"(tid));
    constexpr int KS = D * 2 + 16, VS = 144, KCH = D / 8, NKR = (64 * KCH + 511) / 512, NVR = (DV * 8) / 512, NVS = DEFER ? 3 : 2, KOFF = 0, VOFF = 2 * 64 * KS, POFF = VOFF + NVS * DV * VS;
    constexpr bool NEEDV = (MODE != 1);
    u32x4 kregA[NKR], kregB[NKR]; u32x4 vregA[NVR], vregB[NVR]; float pregA = 0.f, pregB = 0.f;
    if (nt <= 0) return;
#define FA_LOAD(t_, KR, VR, PR) do { \
    _Pragma("unroll") for (int r_ = 0; r_ < NKR; ++r_) { const int idx_ = tid + 512 * r_; if (idx_ < 64 * KCH) { const int row_ = idx_ / KCH, ch_ = idx_ % KCH; KR[r_] = *(const u32x4*)ka((t_), row_, ch_); } } \
    if (NEEDV) { _Pragma("unroll") for (int r_ = 0; r_ < NVR; ++r_) { const int idx_ = tid + 512 * r_; const int d_ = idx_ >> 3, ch_ = idx_ & 7; VR[r_] = *(const u32x4*)va((t_), d_, ch_); } } \
    if (HASBIAS) { if (tid < 64) PR = pf((t_), tid); } } while (0)
#define FA_STORE(tt_, KR, VR, PR) do { LAS unsigned char* kb_ = lds + KOFF + ((tt_) & 1) * (64 * KS); LAS unsigned char* vb_ = lds + VOFF + ((tt_) % NVS) * (DV * VS); \
    _Pragma("unroll") for (int r_ = 0; r_ < NKR; ++r_) { const int idx_ = tid + 512 * r_; if (idx_ < 64 * KCH) { const int row_ = idx_ / KCH, ch_ = idx_ % KCH; *(LAS u32x4*)(kb_ + row_ * KS + ch_ * 16) = KR[r_]; } } \
    if (NEEDV) { _Pragma("unroll") for (int r_ = 0; r_ < NVR; ++r_) { const int idx_ = tid + 512 * r_; const int d_ = idx_ >> 3, ch_ = idx_ & 7; *(LAS u32x4*)(vb_ + d_ * VS + ch_ * 16) = VR[r_]; } } \
    if (HASBIAS) { if (tid < 64) *(LAS float*)(lds + POFF + ((tt_) & 1) * 256 + tid * 4) = PR; } } while (0)
    const bool defer_wave = DEFER && (tid_in >= 256);
    u32x4 pp0 = {0u, 0u, 0u, 0u}, pp1 = pp0, pp2 = pp0, pp3 = pp0; int pend = -1;
    auto compute = [&](int t, int bufi) __attribute__((always_inline)) {
        const LAS unsigned char* cur = lds + KOFF + (t & 1) * (64 * KS);
        const int vslot = t % NVS; const LAS unsigned char* curv = lds + VOFF + vslot * (DV * VS);
        const LAS float* kp = (const LAS float*)(lds + POFF + (t & 1) * 256);
        if (DEFER) { if (pend >= 0) { const LAS unsigned char* pv_ = lds + VOFF + pend * (DV * VS); pv_packed<DV / 32>(o, pv_, VS, 0, pp0, pp1, r32, hi); pv_packed<DV / 32>(o, pv_, VS, 1, pp2, pp3, r32, hi); pend = -1; } }
        const bool sk0 = wskip(t, 0), sk1 = wskip(t, 1);
        if (JOINT && MODE != 2 && !sk0 && !sk1) {
            f32x16 s0 = qk_sub<D / 16>(cur, KS, 0, qf, r32, hi); if (DEFER) __builtin_amdgcn_sched_barrier(0); f32x16 s1 = qk_sub<D / 16>(cur, KS, 1, qf, r32, hi);
            if (HASBIAS) {
#pragma unroll
                for (int a4 = 0; a4 < 4; ++a4) { const int kin0 = 8 * a4 + 4 * hi; const f32x4 kq0 = *(const LAS f32x4*)(kp + kin0), kq1 = *(const LAS f32x4*)(kp + 32 + kin0);
#pragma unroll
                    for (int e = 0; e < 4; ++e) { s0[4 * a4 + e] = s0[4 * a4 + e] * c1 + bf(t, kin0 + e, kq0[e]); s1[4 * a4 + e] = s1[4 * a4 + e] * c1 + bf(t, 32 + kin0 + e, kq1[e]); } }
            }
            const bool masked = nm(t, 0) || nm(t, 1);
            if (masked) {
#pragma unroll
                for (int v = 0; v < 16; ++v) { const int kin = crow(v, hi); if (!vf(t, kin)) s0[v] = NEGB; if (!vf(t, 32 + kin)) s1[v] = NEGB; }
            }
            float mx = xhalf_max(fmaxf(max16(s0), max16(s1)));
            const float mn = fmaxf(m, mx); float sum0 = 0.f, sum1 = 0.f;
            if (masked) {
#pragma unroll
                for (int v = 0; v < 16; ++v) { const float p0 = s0[v] > -1e29f ? fast_exp2(s0[v] - mn) : 0.f, p1 = s1[v] > -1e29f ? fast_exp2(s1[v] - mn) : 0.f; s0[v] = p0; s1[v] = p1; sum0 += p0; sum1 += p1; }
            } else {
#pragma unroll
                for (int v = 0; v < 16; ++v) { const float p0 = fast_exp2(s0[v] - mn), p1 = fast_exp2(s1[v] - mn); s0[v] = p0; s1[v] = p1; sum0 += p0; sum1 += p1; }
            }
            if (__any(mn > m)) {
                const float alpha = fast_exp2(m - mn); l *= alpha;
                if (MODE == 0) {
#pragma unroll
                    for (int i = 0; i < DV / 32; ++i)
#pragma unroll
                        for (int v = 0; v < 16; ++v) o[i][v] *= alpha;
                }
            }
            l += sum0 + sum1; m = mn;
            if (MODE == 0) {
                if (defer_wave) { pp0 = pack8(s0, 0); pp1 = pack8(s0, 1); pp2 = pack8(s1, 0); pp3 = pack8(s1, 1); pend = vslot; }
                else { pv_sub<DV / 32>(o, curv, VS, 0, s0, r32, hi); pv_sub<DV / 32>(o, curv, VS, 1, s1, r32, hi); }
            }
        } else
#pragma unroll
        for (int sub = 0; sub < 2; ++sub) {
            if (!wskip(t, sub)) {
                f32x16 s = qk_sub<D / 16>(cur, KS, sub, qf, r32, hi);
                if (HASBIAS) {
#pragma unroll
                    for (int a4 = 0; a4 < 4; ++a4) { const int kin0 = sub * 32 + 8 * a4 + 4 * hi; const f32x4 kq = *(const LAS f32x4*)(kp + kin0);
#pragma unroll
                        for (int e = 0; e < 4; ++e) s[4 * a4 + e] = s[4 * a4 + e] * c1 + bf(t, kin0 + e, kq[e]); }
                }
                const bool masked = nm(t, sub);
                if (masked) {
#pragma unroll
                    for (int v = 0; v < 16; ++v) { const int kin = sub * 32 + crow(v, hi); if (!vf(t, kin)) s[v] = NEGB; }
                }
                if (MODE == 2) {
                    if (masked) {
#pragma unroll
                        for (int v = 0; v < 16; ++v) s[v] = s[v] > -1e29f ? fast_exp2(s[v] - m) * l : 0.f;
                    } else {
#pragma unroll
                        for (int v = 0; v < 16; ++v) s[v] = fast_exp2(s[v] - m) * l;
                    }
                    cb(t, sub, s);
                    pv_sub<DV / 32>(o, curv, VS, sub, s, r32, hi);
                } else {
                    float mx0 = fmaxf(fmaxf(s[0], s[1]), s[2]), mx1 = fmaxf(fmaxf(s[3], s[4]), s[5]);
                    mx0 = fmaxf(fmaxf(mx0, s[6]), s[7]); mx1 = fmaxf(fmaxf(mx1, s[8]), s[9]); mx0 = fmaxf(fmaxf(mx0, s[10]), s[11]); mx1 = fmaxf(fmaxf(mx1, s[12]), s[13]);
                    float mx = fmaxf(fmaxf(mx0, mx1), fmaxf(s[14], s[15]));
                    mx = xhalf_max(mx);
                    const float mn = fmaxf(m, mx); float sum = 0.f;
                    if (masked) {
#pragma unroll
                        for (int v = 0; v < 16; ++v) { const float p = s[v] > -1e29f ? fast_exp2(s[v] - mn) : 0.f; s[v] = p; sum += p; }
                    } else {
#pragma unroll
                        for (int v = 0; v < 16; ++v) { const float p = fast_exp2(s[v] - mn); s[v] = p; sum += p; }
                    }
                    if (__any(mn > m)) {
                        const float alpha = fast_exp2(m - mn); l *= alpha;
                        if (MODE == 0) {
#pragma unroll
                            for (int i = 0; i < DV / 32; ++i)
#pragma unroll
                                for (int v = 0; v < 16; ++v) o[i][v] *= alpha;
                        }
                    }
                    l += sum; m = mn;
                    if (MODE == 0) pv_sub<DV / 32>(o, curv, VS, sub, s, r32, hi);
                }
            }
        }
    };
    if (DEFER) {
        FA_LOAD(0, kregA, vregA, pregA); FA_STORE(0, kregA, vregA, pregA); __syncthreads();
        for (int t = 0; t < nt; ++t) {
            asm volatile("" : "+v"(tid));
            if (t + 1 < nt) FA_LOAD(t + 1, kregA, vregA, pregA);
            compute(t, 0);
            asm volatile("" : "+v"(tid));
            if (t + 1 < nt) FA_STORE(t + 1, kregA, vregA, pregA);
            __syncthreads();
        }
    } else {
    FA_LOAD(0, kregA, vregA, pregA); FA_STORE(0, kregA, vregA, pregA); if (nt > 1) FA_LOAD(1, kregB, vregB, pregB); __syncthreads();
    for (int t = 0; t < nt; t += 2) {
        if (t + 2 < nt) FA_LOAD(t + 2, kregA, vregA, pregA);
        compute(t, 0);
        if (t + 1 < nt) FA_STORE(t + 1, kregB, vregB, pregB);
        __syncthreads();
        if (t + 1 < nt) {
            if (t + 3 < nt) FA_LOAD(t + 3, kregB, vregB, pregB);
            compute(t + 1, 1);
            if (t + 2 < nt) FA_STORE(t + 2, kregA, vregA, pregA);
            __syncthreads();
        }
    }
    }
    if (DEFER) { if (pend >= 0) { const LAS unsigned char* pv_ = lds + VOFF + pend * (DV * VS); pv_packed<DV / 32>(o, pv_, VS, 0, pp0, pp1, r32, hi); pv_packed<DV / 32>(o, pv_, VS, 1, pp2, pp3, r32, hi); }
        __syncthreads(); }
#undef FA_LOAD
#undef FA_STORE
}
template <int NV>
__device__ __forceinline__ void store_o(bf16* op, const f32x16 (&o)[NV], float sc, int hi) {
#pragma unroll
    for (int i = 0; i < NV; ++i)
#pragma unroll
        for (int a = 0; a < 4; ++a) {
            u32x2 wv; wv.x = cvt_pk_bf16(o[i][4 * a] * sc, o[i][4 * a + 1] * sc); wv.y = cvt_pk_bf16(o[i][4 * a + 2] * sc, o[i][4 * a + 3] * sc);
            *(u32x2*)(op + 32 * i + 8 * a + 4 * hi) = wv;
        }
}
struct NoCb { __device__ __forceinline__ void operator()(int, int, const f32x16&) const {} };

__device__ __forceinline__ void mla_unit(const KP& P, LAS unsigned char* lds, int b, int h, int qb, int tid_u) {
    int tid = tid_u; asm volatile("" : "+v"(tid));
    const int* const posp = P.pos_local();
    const int lane = tid & 63, w = __builtin_amdgcn_readfirstlane(tid >> 6), r32 = lane & 31, hi = lane >> 5;
    const int q0 = qb * 256, tq = q0 + 32 * w + r32; const size_t bS = (size_t)b * SEQ, tok = bS + tq;
    bf16x8 qf[6];
#pragma unroll
    for (int dk = 0; dk < 6; ++dk) qf[dk] = *(const bf16x8*)(P.QM() + tok * 768 + h * 96 + dk * 16 + hi * 8);
    const int nt = (q0 + 256) / 64;
    auto ka = [&](int t, int row, int ch) -> const bf16* { const size_t tk = bS + 64 * t + row; return ch < 8 ? P.KN() + tk * 512 + h * 64 + ch * 8 : P.KROT() + tk * 32 + (ch - 8) * 8; };
    auto va = [&](int t, int d, int ch) -> const bf16* { return P.VMT() + (size_t)(h * 64 + d) * T + bS + 64 * t + ch * 8; };
    auto pf = [&](int, int) -> float { return 0.f; };
    auto bf = [&](int, int, float) -> float { return 0.f; };
    auto vf = [&](int t, int kin) -> bool { return 64 * t + kin <= tq; };
    const int wq_lo = q0 + 32 * w, wq_hi = wq_lo + 31;
    auto nm = [&](int t, int sub) -> bool { return 64 * t + 32 * sub + 31 > wq_lo; };
    auto ws = [&](int t, int sub) -> bool { return 64 * t + 32 * sub > wq_hi; };
    float m = NEGB, l = 0.f; f32x16 o[2];
#pragma unroll
    for (int i = 0; i < 2; ++i)
#pragma unroll
        for (int v = 0; v < 16; ++v) o[i][v] = 0.f;
    fa_loop<96, 64, 0, false, true, false>(lds, nt, ka, va, pf, bf, vf, nm, ws, NoCb(), 1.f, qf, m, l, o, tid, r32, hi);
    l = xhalf_sum(l); const float inv = l > 0.f ? 1.f / l : 0.f;
    store_o<2>(P.OE() + tok * 1024 + h * 64, o, inv, hi);
}

constexpr int NSA_GL = 40960, NSA_SELM = NSA_GL + 8 * 2 * 8 * 132 * 4, NSA_BU = NSA_SELM + 1024, NSA_TL = NSA_BU + 32;
__device__ __forceinline__ void nsa_unit(const KP& P, LAS unsigned char* lds, int b, int c, int g, int tid_u) {
    int tid = tid_u; asm volatile("" : "+v"(tid));
    const int* const posp = P.pos_local();
    const int lane = tid & 63, w = __builtin_amdgcn_readfirstlane(tid >> 6), r32 = lane & 31, hi = lane >> 5;
    const int n = r32 >> 3, qi = r32 & 7, hh = g * 4 + n;
    const int tq = 64 * c + 8 * w + qi; const size_t bS = (size_t)b * SEQ, tok = bS + tq;
    const float slope2 = fast_exp2(-(float)(hh + 1)) * LOG2E, c1 = 0.125f * LOG2E;
    const float pq = (float)posp[tok], nbq = -slope2 * pq;
    bf16x8 qf[4];
#pragma unroll
    for (int dk = 0; dk < 4; ++dk) qf[dk] = *(const bf16x8*)(P.HE() + tok * HE_LD + HE_Q + hh * 64 + dk * 16 + hi * 8);
    LAS float* GLw = (LAS float*)(lds + NSA_GL) + w * (2 * 8 * 132);
    LAS unsigned long long* SELM = (LAS unsigned long long*)(lds + NSA_SELM);
    LAS unsigned* BU = (LAS unsigned*)(lds + NSA_BU);
    LAS int* TL = (LAS int*)(lds + NSA_TL);
    for (int i = tid; i < 8 * 2 * 8 * 132; i += 512) ((LAS float*)(lds + NSA_GL))[i] = 0.f;
    if (tid < 8) BU[tid] = 0u;
    __syncthreads();
    const int wq_lo = 64 * c + 8 * w, wq_hi = wq_lo + 7;
    f32x16 o[2];
#pragma unroll
    for (int i = 0; i < 2; ++i)
#pragma unroll
        for (int v = 0; v < 16; ++v) o[i][v] = 0.f;
    LAS float* stash = (LAS float*)(lds + NSA_GL) + tid;
    {
        const int nt1 = (4 * c + 3 + 63) >> 6;
        auto ka1 = [&](int t, int row, int ch) -> const bf16* { return P.KCC() + ((size_t)b * 512 + 64 * t + row) * 128 + g * 64 + ch * 8; };
        auto va1 = [&](int t, int d, int ch) -> const bf16* { return P.VCT() + (size_t)(g * 64 + d) * 8192 + b * 512 + 64 * t + ch * 8; };
        auto pf1 = [&](int t, int i) -> float { int j = 64 * t + i; j = j > 510 ? 510 : j; return (float)posp[bS + 31 + 16 * j]; };
        auto bf1 = [&](int, int, float kp) -> float { return kp * slope2 + nbq; };
        auto vf1 = [&](int t, int kin) -> bool { const int j = 64 * t + kin; return 16 * j + 31 <= tq; };
        auto nm1 = [&](int t, int sub) -> bool { return 16 * (64 * t + 32 * sub + 31) + 31 > wq_lo; };
        auto ws1 = [&](int t, int sub) -> bool { return 16 * (64 * t + 32 * sub) + 31 > wq_hi; };
        float m1 = NEGB, l1 = 0.f;
        fa_loop<64, 64, 1, true, false, false>(lds, nt1, ka1, va1, pf1, bf1, vf1, nm1, ws1, NoCb(), c1, qf, m1, l1, o, tid, r32, hi);
        l1 = xhalf_sum(l1); float invl = l1 > 0.f ? 1.f / l1 : 0.f;
        auto cb1 = [&](int t, int sub, const f32x16& p) {
#pragma unroll
            for (int a = 0; a < 4; ++a) {
                float gsum = (p[4 * a] + p[4 * a + 1]) + (p[4 * a + 2] + p[4 * a + 3]), last = p[4 * a + 3];
                gsum += __shfl_xor(gsum, 8); gsum += __shfl_xor(gsum, 16); last += __shfl_xor(last, 8); last += __shfl_xor(last, 16);
                const int u = (64 * t + 32 * sub) / 4 + 2 * a + hi;
                if (r32 < 8) { GLw[qi * 132 + u] = gsum; GLw[8 * 132 + qi * 132 + u + 1] = last; }
            }
        };
        fa_loop<64, 64, 2, true, false, false>(lds, nt1, ka1, va1, pf1, bf1, vf1, nm1, ws1, cb1, c1, qf, m1, invl, o, tid, r32, hi);
        const float gtc = P.GT()[tok * 24 + hh];
#pragma unroll
        for (int i = 0; i < 2; ++i)
#pragma unroll
            for (int v = 0; v < 16; ++v) o[i][v] *= gtc;
    }
    unsigned long long wu0 = 0ull, wu1 = 0ull;
    {
        const int ncand = c - 1 > 0 ? c - 1 : 0, need = 16 - (c == 0 ? 1 : 2);
        for (int q = 0; q < 8; ++q) {
            const int s0 = lane, s1 = lane + 64;
            const bool c0 = (s0 >= 1) && (s0 <= c - 1), cc1 = (s1 <= c - 1);
            const float f0 = c0 ? GLw[q * 132 + s0] + GLw[8 * 132 + q * 132 + s0] : 0.f;
            const float f1 = cc1 ? GLw[q * 132 + s1] + GLw[8 * 132 + q * 132 + s1] : 0.f;
            const unsigned b0 = __float_as_uint(f0), b1 = __float_as_uint(f1);
            unsigned long long sel0, sel1;
            if (ncand <= need) { sel0 = __ballot(c0); sel1 = __ballot(cc1); }
            else {
                unsigned x = 0u;
                for (int bit = 30; bit >= 0; --bit) {
                    const unsigned tt = x | (1u << bit);
                    const int cnt = __popcll(__ballot(c0 && b0 >= tt)) + __popcll(__ballot(cc1 && b1 >= tt));
                    if (cnt >= need) x = tt;
                }
                sel0 = __ballot(c0 && b0 > x); sel1 = __ballot(cc1 && b1 > x);
                int rem = need - (__popcll(sel0) + __popcll(sel1));
                unsigned long long e0 = __ballot(c0 && b0 == x), e1 = __ballot(cc1 && b1 == x);
                while (rem > 0 && e0) { const unsigned long long low = e0 & (~e0 + 1ull); sel0 |= low; e0 ^= low; --rem; }
                while (rem > 0 && e1) { const unsigned long long low = e1 & (~e1 + 1ull); sel1 |= low; e1 ^= low; --rem; }
            }
            sel0 |= 1ull; if (c < 64) sel0 |= 1ull << c; else sel1 |= 1ull << (c - 64);
            if (lane == 0) { SELM[(w * 8 + q) * 2] = sel0; SELM[(w * 8 + q) * 2 + 1] = sel1; }
            wu0 |= sel0; wu1 |= sel1;
        }
        if (lane == 0) { atomicOr((unsigned*)&BU[0], (unsigned)wu0); atomicOr((unsigned*)&BU[1], (unsigned)(wu0 >> 32)); atomicOr((unsigned*)&BU[2], (unsigned)wu1); atomicOr((unsigned*)&BU[3], (unsigned)(wu1 >> 32)); }
    }
    __syncthreads();
#pragma unroll
    for (int i = 0; i < 2; ++i)
#pragma unroll
        for (int v = 0; v < 16; ++v) { stash[(i * 16 + v) * 512] = o[i][v]; o[i][v] = 0.f; }
    if (tid < 128) {
        const unsigned u0 = BU[0], u1 = BU[1], u2 = BU[2], u3 = BU[3];
        const int k = tid >> 5; const unsigned wk = k == 0 ? u0 : (k == 1 ? u1 : (k == 2 ? u2 : u3));
        if ((wk >> (tid & 31)) & 1u) {
            int pos = __popc(wk & ((1u << (tid & 31)) - 1u));
            if (k > 0) pos += __popc(u0); if (k > 1) pos += __popc(u1); if (k > 2) pos += __popc(u2);
            TL[pos] = tid;
        }
        if (tid == 0) BU[4] = __popc(u0) + __popc(u1) + __popc(u2) + __popc(u3);
    }
    __syncthreads();
    const unsigned long long ms0 = SELM[(w * 8 + qi) * 2], ms1 = SELM[(w * 8 + qi) * 2 + 1];
    {
        const int nsel = (int)BU[4];
        auto ka2 = [&](int t, int row, int ch) -> const bf16* { const int sb = TL[t]; return P.HE() + (bS + 64 * sb + row) * HE_LD + HE_KS + g * 64 + ch * 8; };
        auto va2 = [&](int t, int d, int ch) -> const bf16* { const int sb = TL[t]; return P.VT() + (size_t)(g * 64 + d) * T + bS + 64 * sb + ch * 8; };
        auto pf2 = [&](int t, int i) -> float { const int sb = TL[t]; return (float)posp[bS + 64 * sb + i]; };
        auto bf2 = [&](int, int, float kp) -> float { return kp * slope2 + nbq; };
        auto vf2 = [&](int t, int kin) -> bool { const int sb = TL[t]; const bool selb = (((sb < 64 ? ms0 : ms1) >> (sb & 63)) & 1ull) != 0ull; return selb && (64 * sb + kin <= tq); };
        auto nm2 = [&](int t, int) -> bool { const int sb = TL[t]; const bool selb = (((sb < 64 ? ms0 : ms1) >> (sb & 63)) & 1ull) != 0ull; return sb == c || !__all(selb); };
        auto ws2 = [&](int t, int) -> bool { const int sb = TL[t]; return (((sb < 64 ? wu0 : wu1) >> (sb & 63)) & 1ull) == 0ull; };
        float m2 = NEGB, l2 = 0.f;
        fa_loop<64, 64, 0, true, false, false>(lds, nsel, ka2, va2, pf2, bf2, vf2, nm2, ws2, NoCb(), c1, qf, m2, l2, o, tid, r32, hi);
        l2 = xhalf_sum(l2); const float gts = P.GT()[tok * 24 + 8 + hh]; const float sc = l2 > 0.f ? gts / l2 : 0.f;
#pragma unroll
        for (int i = 0; i < 2; ++i)
#pragma unroll
            for (int v = 0; v < 16; ++v) { stash[(i * 16 + v) * 512] += o[i][v] * sc; o[i][v] = 0.f; }
    }
    {
        const int first = c < 8 ? 8 - c : 0, nt3 = 9 - first, base3 = 64 * c - 512 + 64 * first;
        auto ka3 = [&](int t, int row, int ch) -> const bf16* { return P.HE() + (bS + base3 + 64 * t + row) * HE_LD + HE_KW + g * 64 + ch * 8; };
        auto va3 = [&](int t, int d, int ch) -> const bf16* { return P.VT() + (size_t)(128 + g * 64 + d) * T + bS + base3 + 64 * t + ch * 8; };
        auto pf3 = [&](int t, int i) -> float { return (float)posp[bS + base3 + 64 * t + i]; };
        auto bf3 = [&](int, int, float kp) -> float { return kp * slope2 + nbq; };
        auto vf3 = [&](int t, int kin) -> bool { const int df = tq - (base3 + 64 * t + kin); return df >= 0 && df < 512; };
        auto nm3 = [&](int t, int sub) -> bool { const int k0 = base3 + 64 * t + 32 * sub; return k0 + 31 > wq_lo || k0 < wq_hi - 511; };
        auto ws3 = [&](int t, int sub) -> bool { const int k0 = base3 + 64 * t + 32 * sub; return k0 > wq_hi || k0 + 31 < wq_lo - 511; };
        float m3 = NEGB, l3 = 0.f;
        fa_loop<64, 64, 0, true, false, false>(lds, nt3, ka3, va3, pf3, bf3, vf3, nm3, ws3, NoCb(), c1, qf, m3, l3, o, tid, r32, hi);
        l3 = xhalf_sum(l3); const float gtw = P.GT()[tok * 24 + 16 + hh]; const float sc = l3 > 0.f ? gtw / l3 : 0.f;
#pragma unroll
        for (int i = 0; i < 2; ++i)
#pragma unroll
            for (int v = 0; v < 16; ++v) o[i][v] = o[i][v] * sc + stash[(i * 16 + v) * 512];
    }
    store_o<2>(P.OE() + tok * 1024 + 512 + hh * 64, o, 1.f, hi);
}

__device__ __forceinline__ void dil_unit(const KP& P, LAS unsigned char* lds, int b, int g, int h, int rj, int tid_u) {
    int tid = tid_u; asm volatile("" : "+v"(tid));
    const int* const posp = P.pos_local();
    const int lane = tid & 63, w = __builtin_amdgcn_readfirstlane(tid >> 6), r32 = lane & 31, hi = lane >> 5;
    const int dil = g == 0 ? 1 : (g == 1 ? 4 : 16), per = 32 / dil, r = rj / per, jt = rj % per, clen = SEQ / dil;
    const int J = 256 * jt + 32 * w + r32; const size_t bS = (size_t)b * SEQ, tok = bS + r + dil * J;
    const float slope2 = fast_exp2(-8.f * (float)(g * 4 + h + 1) / 12.f) * LOG2E, c1 = 0.08838834764831845f * LOG2E;
    const float pq = (float)posp[tok], nbq = -slope2 * pq;
    bf16x8 qf[8];
#pragma unroll
    for (int dk = 0; dk < 8; ++dk) qf[dk] = *(const bf16x8*)(P.QK() + tok * 3072 + g * 512 + h * 128 + dk * 16 + hi * 8);
    const int first = jt == 0 ? 2 : 0, nt = 6 - first, I00 = 256 * jt - 128 + 64 * first;
    auto ka = [&](int t, int row, int ch) -> const bf16* { return P.QK() + (bS + r + (size_t)dil * (I00 + 64 * t + row)) * 3072 + 1536 + g * 512 + h * 128 + ch * 8; };
    auto va = [&](int t, int d, int ch) -> const bf16* { return P.VOT() + (size_t)(g * 512 + h * 128 + d) * T + bS + (size_t)r * clen + I00 + 64 * t + ch * 8; };
    auto pf = [&](int t, int i) -> float { return (float)posp[bS + r + dil * (I00 + 64 * t + i)]; };
    auto bf = [&](int, int, float kp) -> float { return kp * slope2 + nbq; };
    auto vf = [&](int t, int kin) -> bool { const int df = J - (I00 + 64 * t + kin); return df >= 0 && df <= 128; };
    const int Jw = 256 * jt + 32 * w;
    auto nm = [&](int t, int sub) -> bool { const int i0 = I00 + 64 * t + 32 * sub; return i0 + 31 > Jw || i0 < Jw + 31 - 128; };
    auto ws = [&](int t, int sub) -> bool { const int i0 = I00 + 64 * t + 32 * sub; return i0 > Jw + 31 || i0 + 31 < Jw - 128; };
    float m = NEGB, l = 0.f; f32x16 o[4];
#pragma unroll
    for (int i = 0; i < 4; ++i)
#pragma unroll
        for (int v = 0; v < 16; ++v) o[i][v] = 0.f;
    fa_loop<128, 128, 0, true, false, false>(lds, nt, ka, va, pf, bf, vf, nm, ws, NoCb(), c1, qf, m, l, o, tid, r32, hi);
    l = xhalf_sum(l); const float inv = l > 0.f ? 1.f / l : 0.f;
    store_o<4>(P.OG() + ((size_t)g * T + tok) * 512 + h * 128, o, inv, hi);
    if (hi == 0) P.LSE()[((size_t)g * T + tok) * 4 + h] = m + __log2f(l);
}
struct Args { const float* in[28]; float* out; unsigned char* ws; int ph_lo, ph_hi; };

enum { WM_ID = 0, WM_SWIGLU = 1, WM_E1 = 2, WM_E2 = 3, WM_UQ = 4 };
struct WSpec { const float* W; const float* W2; const float* gk; bf16* WT; int K, Nsrc, Ndst, mode, soff, nvalid; };
__device__ __forceinline__ void transpose_item(const WSpec& s, LAS float* scr, int item, int lane) {
    const int nblk = s.Ndst / 32, kb = item / nblk, nb = item % nblk, k0 = 128 * kb, n0 = 32 * nb;
    const int R = n0 + (lane & 31); int sc; const float* Wp = s.W;
    if (s.mode == WM_ID) sc = R < s.nvalid ? R + s.soff : -1;
    else if (s.mode == WM_SWIGLU) { sc = (R >> 8) * 128 + (R & 127); if ((R >> 7) & 1) Wp = s.W2; }
    else if (s.mode == WM_E1) sc = R < 1568 ? R : (R < 1696 ? R + 128 : (R < 1720 ? R + 256 : -1));
    else if (s.mode == WM_E2) sc = R < 128 ? 1568 + R : 1824 + (R - 128);
    else { const int h = R / 96, wq = R % 96; if (wq < 64) sc = R; else { const int p = wq - 64, fq = p >> 3, sub = p & 7; sc = 96 * h + 64 + (sub < 4 ? 4 * fq + sub : 16 + 4 * fq + (sub - 4)); } }
    if (s.mode != WM_UQ) {
        const int c4 = (lane & 7) * 4, R4 = n0 + c4; int sc4; const float* Wq = s.W;
        if (s.mode == WM_ID) sc4 = R4 < s.nvalid ? R4 + s.soff : -1;
        else if (s.mode == WM_SWIGLU) { sc4 = (R4 >> 8) * 128 + (R4 & 127); if ((R4 >> 7) & 1) Wq = s.W2; }
        else if (s.mode == WM_E1) sc4 = R4 < 1568 ? R4 : (R4 < 1696 ? R4 + 128 : (R4 < 1720 ? R4 + 256 : -1));
        else sc4 = R4 < 128 ? 1568 + R4 : 1824 + (R4 - 128);
#pragma unroll
        for (int i = 0; i < 16; ++i) { const int kk = 8 * i + (lane >> 3);
            f32x4 v = {0.f, 0.f, 0.f, 0.f}; if (sc4 >= 0) v = *(const f32x4*)(Wq + (size_t)(k0 + kk) * s.Nsrc + sc4);
            if (s.gk) v = v * s.gk[k0 + kk];
            scr[kk * 33 + c4] = v[0]; scr[kk * 33 + c4 + 1] = v[1]; scr[kk * 33 + c4 + 2] = v[2]; scr[kk * 33 + c4 + 3] = v[3]; }
    } else {
#pragma unroll
    for (int i = 0; i < 64; ++i) { const int kk = 2 * i + (lane >> 5); float v = sc >= 0 ? Wp[(size_t)(k0 + kk) * s.Nsrc + sc] : 0.f; if (s.gk) v *= s.gk[k0 + kk]; scr[kk * 33 + (lane & 31)] = v; }
    }
    asm volatile("s_waitcnt lgkmcnt(0)" ::: "memory");
    const int c = lane & 15;
#pragma unroll
    for (int j = 0; j < 8; ++j) { const int nn = (lane >> 4) + 4 * j; const LAS float* sp = scr + (8 * c) * 33 + nn;
        u32x4 o; o.x = cvt_pk_bf16(sp[0 * 33], sp[1 * 33]); o.y = cvt_pk_bf16(sp[2 * 33], sp[3 * 33]); o.z = cvt_pk_bf16(sp[4 * 33], sp[5 * 33]); o.w = cvt_pk_bf16(sp[6 * 33], sp[7 * 33]);
        *(u32x4*)(s.WT + (size_t)(n0 + nn) * s.K + k0 + 8 * c) = o; }
    asm volatile("s_waitcnt lgkmcnt(0)" ::: "memory");
}
__device__ __forceinline__ const float* ffn_w(const Args& a, int f, int which) {
    const int L = f >> 1; const bool second = (f & 1) != 0;
    const float* base = which == 0 ? (second ? a.in[23] : a.in[4]) : (which == 1 ? (second ? a.in[24] : a.in[5]) : (second ? a.in[25] : a.in[6]));
    return base + (size_t)L * 1024 * 2816;
}
__device__ __forceinline__ void p0_prologue(const Args& a, const KP& P, LAS unsigned char* lds, int tid, int gw, int NGW) {
    const int lane = tid & 63, w = tid >> 6;
    LAS float* scr = (LAS float*)(lds + w * 17408);
    int cum = 0;
    for (int wi = 0; wi < 21; ++wi) {
        WSpec s; s.W2 = nullptr; s.gk = nullptr; s.mode = WM_ID; s.soff = 0;
        if (wi < 4) { s.W = ffn_w(a, wi, 0); s.W2 = ffn_w(a, wi, 1); s.K = 1024; s.Nsrc = 2816; s.Ndst = 5632; s.mode = WM_SWIGLU; s.WT = P.WB() + WE_GU + (size_t)wi * 5632 * 1024; }
        else if (wi < 8) { s.W = ffn_w(a, wi - 4, 2); s.K = 2816; s.Nsrc = 1024; s.Ndst = 1024; s.WT = P.WB() + WE_D + (size_t)(wi - 4) * 1024 * 2816; }
        else if (wi == 8) { s.W = a.in[7]; s.K = 1024; s.Nsrc = 1976; s.Ndst = 1792; s.mode = WM_E1; s.WT = P.WB() + WE_E1; }
        else if (wi == 9) { s.W = a.in[7]; s.K = 1024; s.Nsrc = 1976; s.Ndst = 256; s.mode = WM_E2; s.WT = P.WB() + WE_E2; }
        else if (wi == 10) { s.W = a.in[10]; s.gk = a.in[8]; s.K = 384; s.Nsrc = 768; s.Ndst = 768; s.mode = WM_UQ; s.WT = P.WB() + WE_UQ; }
        else if (wi == 11) { s.W = a.in[11]; s.gk = a.in[9]; s.K = 256; s.Nsrc = 512; s.Ndst = 512; s.WT = P.WB() + WE_UK; }
        else if (wi == 12) { s.W = a.in[12]; s.gk = a.in[9]; s.K = 256; s.Nsrc = 512; s.Ndst = 512; s.WT = P.WB() + WE_UV; }
        else if (wi == 13) { s.W = a.in[14]; s.K = 2048; s.Nsrc = 256; s.Ndst = 256; s.WT = P.WB() + WE_C1K; }
        else if (wi == 14) { s.W = a.in[16]; s.K = 2048; s.Nsrc = 256; s.Ndst = 256; s.WT = P.WB() + WE_C1V; }
        else if (wi == 15) { s.W = a.in[15]; s.K = 256; s.Nsrc = 64; s.Ndst = 256; s.WT = P.WB() + WE_C2K; }
        else if (wi == 16) { s.W = a.in[17]; s.K = 256; s.Nsrc = 64; s.Ndst = 256; s.WT = P.WB() + WE_C2V; }
        else if (wi == 17) { s.W = a.in[18]; s.K = 1024; s.Nsrc = 1024; s.Ndst = 1024; s.WT = P.WB() + WE_OE; }
        else if (wi == 18) { s.W = a.in[19]; s.K = 1024; s.Nsrc = 4608; s.Ndst = 3072; s.WT = P.WB() + WE_O1; }
        else if (wi == 19) { s.W = a.in[19]; s.K = 1024; s.Nsrc = 4608; s.Ndst = 1536; s.soff = 3072; s.WT = P.WB() + WE_O2; }
        else { s.W = a.in[20]; s.K = 512; s.Nsrc = 1024; s.Ndst = 1024; s.WT = P.WB() + WE_OO; }
        s.nvalid = (wi == 15 || wi == 16) ? 64 : s.Ndst;
        const int nitems = (s.K / 128) * (s.Ndst / 32);
        { int it0 = (gw - cum) % NGW; if (it0 < 0) it0 += NGW; for (int it = it0; it < nitems; it += NGW) transpose_item(s, scr, it, lane); cum = (cum + nitems) % NGW; }
    }
    { const float* x = a.in[0]; const size_t n8 = (size_t)T * DM / 8; const size_t gt = (size_t)gw * 64 + lane, NT_ = (size_t)NGW * 64;
#pragma unroll 4
      for (size_t i = gt; i < n8; i += NT_) { const f32x4 v0 = *(const f32x4*)(x + i * 8), v1 = *(const f32x4*)(x + i * 8 + 4);
          u32x4 o; o.x = cvt_pk_bf16(v0[0], v0[1]); o.y = cvt_pk_bf16(v0[2], v0[3]); o.z = cvt_pk_bf16(v1[0], v1[1]); o.w = cvt_pk_bf16(v1[2], v1[3]); *(u32x4*)(P.XB() + i * 8) = o; } }
    if (gw < 512) { const int kv = gw >> 8, nn = gw & 255; const float* w1 = kv ? a.in[16] : a.in[14]; const float* cp = a.in[13]; float sacc = 0.f;
        for (int i = 0; i < 32; ++i) { const int kk = lane + 64 * i; sacc += cp[kk] * w1[(size_t)kk * 256 + nn]; }
        sacc = wave_sum(sacc); if (lane == 0) P.CB()[kv * 256 + nn] = sacc; }
    if (gw == 0) { P.CTL()[lane] = 0u; if (lane < 28) ((const float**)(P.ws + WS_PT))[lane] = a.in[lane]; }
}
__device__ __forceinline__ void ln_pass(const KP& P, const float* gam, const float* bet, bool write_x, int lane, int gw, int NGW) {
    float* ST = (float*)(P.ws + WS_ST);
    f32x4 gv[4], bv[4];
#pragma unroll
    for (int j = 0; j < 4; ++j) { gv[j] = *(const f32x4*)(gam + 4 * lane + 256 * j); bv[j] = *(const f32x4*)(bet + 4 * lane + 256 * j); }
    for (int row = gw; row < T; row += 2 * NGW) {
        const int row2 = row + NGW; const bool has2 = row2 < T;
        float* xr = P.out + (size_t)row * DM + 4 * lane; float* xr2 = P.out + (size_t)(has2 ? row2 : row) * DM + 4 * lane;
        f32x4 v[4], u[4]; float s = 0.f, t = 0.f;
#pragma unroll
        for (int j = 0; j < 4; ++j) { v[j] = *(const f32x4*)(xr + 256 * j); u[j] = *(const f32x4*)(xr2 + 256 * j); }
#pragma unroll
        for (int j = 0; j < 4; ++j) { s += (v[j][0] + v[j][1]) + (v[j][2] + v[j][3]); t += (u[j][0] + u[j][1]) + (u[j][2] + u[j][3]); }
        const float mean = wave_sum(s) * (1.f / DM), mean2 = wave_sum(t) * (1.f / DM); float s2 = 0.f, t2 = 0.f;
#pragma unroll
        for (int j = 0; j < 4; ++j) { v[j] = v[j] - mean; s2 += (v[j][0] * v[j][0] + v[j][1] * v[j][1]) + (v[j][2] * v[j][2] + v[j][3] * v[j][3]);
                                      u[j] = u[j] - mean2; t2 += (u[j][0] * u[j][0] + u[j][1] * u[j][1]) + (u[j][2] * u[j][2] + u[j][3] * u[j][3]); }
        const float rstd = 1.f / sqrtf(wave_sum(s2) * (1.f / DM) + 1e-5f), rstd2 = 1.f / sqrtf(wave_sum(t2) * (1.f / DM) + 1e-5f);
        bf16* xb = P.XB() + (size_t)row * DM + 4 * lane; bf16* xb2 = P.XB() + (size_t)row2 * DM + 4 * lane;
#pragma unroll
        for (int j = 0; j < 4; ++j) { const f32x4 y = v[j] * rstd * gv[j] + bv[j]; if (write_x) *(f32x4*)(xr + 256 * j) = y;
            u32x2 o; o.x = cvt_pk_bf16(y[0], y[1]); o.y = cvt_pk_bf16(y[2], y[3]); *(u32x2*)(xb + 256 * j) = o; }
        if (lane == 0) { ST[2 * row] = mean; ST[2 * row + 1] = rstd; if (has2) { ST[2 * row2] = mean2; ST[2 * row2 + 1] = rstd2; } }
        if (has2) {
#pragma unroll
            for (int j = 0; j < 4; ++j) { const f32x4 y = u[j] * rstd2 * gv[j] + bv[j]; if (write_x) *(f32x4*)(xr2 + 256 * j) = y;
                u32x2 o; o.x = cvt_pk_bf16(y[0], y[1]); o.y = cvt_pk_bf16(y[2], y[3]); *(u32x2*)(xb2 + 256 * j) = o; }
        }
    }
}
__device__ __forceinline__ void small_pass(const KP& P, int lane, int gw, int NGW) {
    for (int tok = gw; tok < T; tok += NGW) {
        const bf16* he = P.HE() + (size_t)tok * HE_LD; float sq = 0.f, skv = 0.f;
        if (lane < 48) { const u32x4 v = *(const u32x4*)(he + lane * 8);
#pragma unroll
            for (int e = 0; e < 4; ++e) { const float a0 = __uint_as_float(v[e] << 16), a1 = __uint_as_float(v[e] & 0xffff0000u); sq += a0 * a0 + a1 * a1; } }
        if (lane < 32) { const u32x4 v = *(const u32x4*)(he + HE_CKV + lane * 8);
#pragma unroll
            for (int e = 0; e < 4; ++e) { const float a0 = __uint_as_float(v[e] << 16), a1 = __uint_as_float(v[e] & 0xffff0000u); skv += a0 * a0 + a1 * a1; } }
        sq = wave_sum(sq); skv = wave_sum(skv);
        if (lane == 0) { P.RSTD()[tok] = 1.f / sqrtf(sq * (1.f / 384.f) + 1e-6f); P.RSTD()[T + tok] = 1.f / sqrtf(skv * (1.f / 256.f) + 1e-6f); }
        if (lane < 16) {
            double inv = 1.0; for (int k = 0; k < lane; ++k) inv *= 0.5623413251903491;
            const double rev = (double)P.pos[tok] * inv * 0.15915494309189535; const float fr = (float)(rev - floor(rev));
            const float sn = __builtin_amdgcn_sinf(fr), cs = __builtin_amdgcn_cosf(fr);
            P.RT()[(size_t)tok * 32 + 2 * lane] = cs; P.RT()[(size_t)tok * 32 + 2 * lane + 1] = sn;
            const float x1 = bf2f(he[HE_KPE + lane]), x2 = bf2f(he[HE_KPE + 16 + lane]);
            const int p1 = 8 * (lane >> 2) + (lane & 3);
            const unsigned o1 = cvt_pk_bf16(x1 * cs - x2 * sn, 0.f), o2 = cvt_pk_bf16(x2 * cs + x1 * sn, 0.f);
            P.KROT()[(size_t)tok * 32 + p1] = (bf16)(o1 & 0xffffu); P.KROT()[(size_t)tok * 32 + p1 + 4] = (bf16)(o2 & 0xffffu);
        }
        if (lane >= 32 && lane < 56) { const int j = lane - 32; const float x = bf2f(he[HE_GT + j]); P.GT()[(size_t)tok * 24 + j] = fast_rcp(1.f + fast_exp2(-LOG2E * x)); }
    }
}
__device__ __forceinline__ void merge_pass(const KP& P, int lane, int gw, int NGW) {
    const size_t n = (size_t)T * 64, gt = (size_t)gw * 64 + lane, NT_ = (size_t)NGW * 64;
    for (size_t idx = gt; idx < n; idx += NT_) {
        const size_t tok = idx >> 6; const int col = (int)(idx & 63) * 8, h = col >> 7;
        const float l0 = P.LSE()[tok * 4 + h], l1 = P.LSE()[((size_t)T + tok) * 4 + h], l2 = P.LSE()[((size_t)2 * T + tok) * 4 + h];
        const float mx = fmaxf(l0, fmaxf(l1, l2)); float w0 = fast_exp2(l0 - mx), w1 = fast_exp2(l1 - mx), w2 = fast_exp2(l2 - mx);
        const float inv = 1.f / (w0 + w1 + w2); w0 *= inv; w1 *= inv; w2 *= inv;
        const u32x4 a = *(const u32x4*)(P.OG() + tok * 512 + col), b = *(const u32x4*)(P.OG() + ((size_t)T + tok) * 512 + col), c = *(const u32x4*)(P.OG() + ((size_t)2 * T + tok) * 512 + col);
        u32x4 o;
#pragma unroll
        for (int e = 0; e < 4; ++e) {
            const float lo = w0 * __uint_as_float(a[e] << 16) + w1 * __uint_as_float(b[e] << 16) + w2 * __uint_as_float(c[e] << 16);
            const float hi = w0 * __uint_as_float(a[e] & 0xffff0000u) + w1 * __uint_as_float(b[e] & 0xffff0000u) + w2 * __uint_as_float(c[e] & 0xffff0000u);
            o[e] = cvt_pk_bf16(lo, hi);
        }
        *(u32x4*)(P.OO() + tok * 512 + col) = o;
    }
}

#define ONE_LAUNCH 1
#define PROBE_F1 0
#define PROBE_O12 0
#define PROBE_EFRONT 0
#define PROBE_F2 0
#define USE_XBAR 1
#define PROBE_P0 0
#define PROBE_SYNC 0
#define PROBE_ATTE 0
#define PROBE_ATTO 0
#define PROBE_MLA_ONLY 0

enum { K_P0, K_F1, K_F2, K_LN, K_E12, K_SMALL, K_E345, K_C2, K_ATTE, K_OUTE, K_O12, K_ATTO, K_MERGE, K_OUTO };
constexpr int NPH = 25;
#define GEMM_CALL(EPI, g_, E_, off_) do { pg8::StaticOrder S_; S_.init((g_).M, (g_).N, (int)gridDim.x, (int)((blockIdx.x + (off_)) % gridDim.x)); \
    pg8::gemm_phase<EPI, pg8::StaticOrder, true, true>(lds, (g_), S_, (E_)); } while (0)

__global__ void __launch_bounds__(512, 2) mega(Args a) {
    extern __shared__ __attribute__((aligned(16))) unsigned char lds_raw[];
    LAS unsigned char* lds = (LAS unsigned char*)lds_raw;
    cg::grid_group grid = cg::this_grid();
    const int wv = __builtin_amdgcn_readfirstlane((int)threadIdx.x >> 6);
    const int G = gridDim.x, gw = blockIdx.x * 8 + wv, NGW = G * 8;
    KP P; unsigned char* ws = a.ws;
    P.out = a.out; P.ws = ws; P.pos = (const int*)a.in[1];
    LAS int* su = (LAS int*)(lds + LDS_BYTES - 64);
    volatile LAS unsigned* bst = (volatile LAS unsigned*)(lds + LDS_BYTES - 32);
    if (threadIdx.x < 2) bst[threadIdx.x] = 0u;
    __syncthreads();
    XcdBarrier bar = xcd_barrier_post((unsigned*)(a.ws + WS_CTL) + 4096, bst);

    if (a.ph_lo == 0) {
 p0_prologue(a, P, lds, threadIdx.x, gw, NGW);
#if PROBE_P0
 p0_prologue(a, P, lds, threadIdx.x, gw, NGW);
#endif
 if (a.ph_hi > 1) {
#if USE_XBAR
        if (a.ph_hi < 0) grid.sync();
        xcd_barrier(bar);
#else
        grid.sync();
#endif
    } }
#define IN(k) (((const float* const*)(P.ws + WS_PT))[k])
    for (int ph = (a.ph_lo == 0 ? 1 : a.ph_lo); ph < a.ph_hi; ++ph) {
        int tid = threadIdx.x; asm volatile("" : "+v"(tid));
        const int lane = tid & 63;
        { unsigned char* ws_i = a.ws; float* out_i = a.out; asm volatile("" : "+s"(ws_i), "+s"(out_i)); P.ws = ws_i; P.out = out_i; P.pos = (const int*)IN(1); }
        int kind, f = 0, lns = 0, layer = 0;
        switch (ph) {
            case 1: kind = K_F1; f = 0; break;  case 2: kind = K_F2; f = 0; break;  case 3: kind = K_LN; lns = 0; layer = 0; break;
            case 4: kind = K_E12; break; case 5: kind = K_SMALL; break; case 6: kind = K_E345; break; case 7: kind = K_C2; break; case 8: kind = K_ATTE; break; case 9: kind = K_OUTE; break;
            case 10: kind = K_LN; lns = 1; layer = 0; break;
            case 11: kind = K_F1; f = 1; break; case 12: kind = K_F2; f = 1; break; case 13: kind = K_LN; lns = 2; layer = 0; break;
            case 14: kind = K_F1; f = 2; break; case 15: kind = K_F2; f = 2; break; case 16: kind = K_LN; lns = 0; layer = 1; break;
            case 17: kind = K_O12; break; case 18: kind = K_ATTO; break; case 19: kind = K_MERGE; break; case 20: kind = K_OUTO; break;
            case 21: kind = K_LN; lns = 1; layer = 1; break;
            case 22: kind = K_F1; f = 3; break; case 23: kind = K_F2; f = 3; break; default: kind = K_LN; lns = 2; layer = 1; break;
        }
        if (kind == K_F1) {
            pg8::Gemm g{P.XB(), P.WB() + WE_GU + (size_t)f * 5632 * 1024, T, 5632, 1024, 1024, 1024, 128, 0}; EpiSwiglu E{P.H(), FF};
            GEMM_CALL(EpiSwiglu, g, E, 0);
#if PROBE_F1
            GEMM_CALL(EpiSwiglu, g, E, 0);
#endif
        }
        else if (kind == K_F2) {
            pg8::Gemm g{P.H(), P.WB() + WE_D + (size_t)f * 1024 * 2816, T, 1024, FF, FF, FF, 128, 0};
            if (f == 0) { EpiResidT<false> E{IN(0), P.out, P.ws, 0, 0, 0, DN_ALPHA, 0.5f}; GEMM_CALL(EpiResidT<false>, g, E, 0); }
            else {
#if PROBE_F2
                { EpiResidT<true> E{P.out, (float*)(P.ws + WS_R + 352 * MiB), P.ws, (f == 2 ? 26 : 21), (f == 2 ? 27 : 22), (f == 3 ? DM : 0), DN_ALPHA, 0.5f}; GEMM_CALL(EpiResidT<true>, g, E, 0); }
#endif
 EpiResidT<true> E{P.out, P.out, P.ws, (f == 2 ? 26 : 21), (f == 2 ? 27 : 22), (f == 3 ? DM : 0), DN_ALPHA, 0.5f}; GEMM_CALL(EpiResidT<true>, g, E, 0); }
        }
        else if (kind == K_OUTE) {
            pg8::Gemm g{P.OE(), P.WB() + WE_OE, T, 1024, 1024, 1024, 1024, 128, 0}; EpiResidT<true> E{P.out, P.out, P.ws, 2, 3, 0, DN_ALPHA, 1.f};
            GEMM_CALL(EpiResidT<true>, g, E, 0);
        }
        else if (kind == K_OUTO) {
            pg8::Gemm g{P.OO(), P.WB() + WE_OO, T, 1024, 512, 512, 512, 128, 0}; EpiResidT<true> E{P.out, P.out, P.ws, 2, 3, DM, DN_ALPHA, 1.f};
            GEMM_CALL(EpiResidT<true>, g, E, 0);
        }
        else if (kind == K_LN) {
            const float* gam = (lns == 0 ? IN(2) : (lns == 1 ? IN(21) : IN(26))) + layer * DM;
            const float* bet = (lns == 0 ? IN(3) : (lns == 1 ? IN(22) : IN(27))) + layer * DM;

#ifndef DIS_LN
 ln_pass(P, gam, bet, ph == NPH - 1, lane, gw, NGW);
#endif

        }
        else if (kind == K_SMALL) {
#ifndef DIS_SMALL
 small_pass(P, lane, gw, NGW);
#endif
 }
        else if (kind == K_MERGE) {
#ifndef DIS_MERGE
 merge_pass(P, lane, gw, NGW);
#endif
 }
        else if (kind == K_E12) {
            { pg8::Gemm g{P.XB(), P.WB() + WE_E1, T, 1792, 1024, 1024, 1024, 128, 0}; EpiStore E{P.HE(), HE_LD, nullptr, nullptr, nullptr, 0, 1792, T, 0, 0}; GEMM_CALL(EpiStore, g, E, 0); }
            { pg8::Gemm g{P.WB() + WE_E2, P.XB(), 256, T, 1024, 1024, 1024, 128, 0}; EpiStore E{P.VT(), T, nullptr, nullptr, nullptr, 0, T, 256, 0, 0}; GEMM_CALL(EpiStore, g, E, 0); }
        }
        else if (kind == K_E345) {
            for (int j = 0; j < 4; ++j) { const int kv = j >> 1, gg = j & 1;
                pg8::Gemm g{P.HE() + (kv ? HE_VC : HE_KC) + gg * 64, P.WB() + (kv ? WE_C1V : WE_C1K), 8192, 256, 2048, 16 * HE_LD, 2048, HE_LD * 2, 0};
                EpiStore E{P.HC() + (size_t)j * 8192 * 256, 256, nullptr, nullptr, P.CB() + kv * 256, 1, 256, 8192, 0, 0}; GEMM_CALL(EpiStore, g, E, 32 * j); }
            { pg8::Gemm g{P.HE() + HE_CQ, P.WB() + WE_UQ, T, 768, 384, HE_LD, 384, 128, 0}; EpiRopeQ E{P.QM(), 768, P.RSTD(), P.RT(), 0.10206207261596575f * LOG2E}; GEMM_CALL(EpiRopeQ, g, E, 128); }
            { pg8::Gemm g{P.HE() + HE_CKV, P.WB() + WE_UK, T, 512, 256, HE_LD, 256, 128, 0}; EpiStore E{P.KN(), 512, P.RSTD() + T, nullptr, nullptr, 0, 512, T, 0, 0}; GEMM_CALL(EpiStore, g, E, 128); }
            { pg8::Gemm g{P.WB() + WE_UV, P.HE() + HE_CKV, 512, T, 256, 256, HE_LD, 128, 0}; EpiStore E{P.VMT(), T, nullptr, P.RSTD() + T, nullptr, 0, T, 512, 0, 0}; GEMM_CALL(EpiStore, g, E, 128); }
        }
        else if (kind == K_C2) {
            for (int gg = 0; gg < 2; ++gg) { pg8::Gemm g{P.HC() + (size_t)gg * 8192 * 256, P.WB() + WE_C2K, 8192, 256, 256, 256, 256, 128, 0};
                EpiStore E{P.KCC() + gg * 64, 128, nullptr, nullptr, nullptr, 0, 64, 8192, 1, 0}; GEMM_CALL(EpiStore, g, E, 32 * gg); }
            for (int gg = 0; gg < 2; ++gg) { pg8::Gemm g{P.WB() + WE_C2V, P.HC() + (size_t)(2 + gg) * 8192 * 256, 256, 8192, 256, 256, 256, 128, 0};
                EpiStore E{P.VCT() + (size_t)gg * 64 * 8192, 8192, nullptr, nullptr, nullptr, 0, 8192, 64, 0, 1}; GEMM_CALL(EpiStore, g, E, 64 + 32 * gg); }
        }
        else if (kind == K_O12) {
            { pg8::Gemm g{P.XB(), P.WB() + WE_O1, T, 3072, 1024, 1024, 1024, 128, 0}; EpiStore E{P.QK(), 3072, nullptr, nullptr, nullptr, 0, 3072, T, 0, 0}; GEMM_CALL(EpiStore, g, E, 0); }
            for (int gg = 0; gg < 3; ++gg) { const int dil = gg == 0 ? 1 : (gg == 1 ? 4 : 16);
                pg8::Gemm g{P.WB() + WE_O2 + (size_t)gg * 512 * 1024, P.XB(), 512, T, 1024, 1024, dil * 1024, 128, dil};
                EpiStore E{P.VOT() + (size_t)gg * 512 * T, T, nullptr, nullptr, nullptr, 0, T, 512, 0, 0}; GEMM_CALL(EpiStore, g, E, 0); }
        }
        else if (kind == K_ATTE) {
            __syncthreads();
            for (int rep = 0; rep < (PROBE_ATTE ? 2 : 1); ++rep)
            for (;;) {
                if (tid == 0) *su = (int)atomicAdd(&P.CTL()[0 + 2 * rep], 1u);
                __syncthreads(); const int u = *su; __syncthreads();
                if (u >= 4096) break;
                if (PROBE_MLA_ONLY && rep == 1 && u >= 2048) break;
                if (u < 2048) { const int qb = 31 - (u >> 6), bh = u & 63;
#ifndef DIS_MLA
 mla_unit(P, lds, bh >> 3, bh & 7, qb, tid);
#endif
 }
                else { const int v = u - 2048, c = 127 - (v >> 4), bg = v & 15;
#ifndef DIS_NSA
 nsa_unit(P, lds, bg >> 1, c, bg & 1, tid);
#endif
 }
            }
        }
        else if (kind == K_ATTO) {
            __syncthreads();
            for (int rep = 0; rep < (PROBE_ATTO ? 2 : 1); ++rep)
            for (;;) {
                if (tid == 0) *su = (int)atomicAdd(&P.CTL()[1 + 2 * rep], 1u);
                __syncthreads(); const int u = *su; __syncthreads();
                if (u >= 3072) break;
                const int rj = u & 31, rest = u >> 5, h = rest & 3, g = (rest >> 2) % 3, b = rest / 12;

#ifndef DIS_DIL
 dil_unit(P, lds, b, g, h, rj, tid);
#endif

            }
        }
        if (ph + 1 < a.ph_hi) {
#if USE_XBAR
            xcd_barrier(bar);
#else
            grid.sync();
#endif
        }
#if PROBE_SYNC
        if (ph + 1 < a.ph_hi) { grid.sync(); grid.sync(); }
#endif
    }
}

#ifndef ONE_LAUNCH_X
#define ONE_LAUNCH 1
#endif
extern "C" void kernel_launch(void* const* d_in, const int* in_sizes, int n_in, void* d_out, int out_size, void* d_ws, size_t ws_size, hipStream_t stream) {
    static int grid = 0;
    if (grid == 0) {
        if (n_in != 28 || ws_size < WS_NEED) { fprintf(stderr, "kernel_launch: unexpected n_in %d / ws %zu\n", n_in, ws_size); grid = -1; return; }
        int dev = 0, cus = 0, per_cu = 0;
        hipGetDevice(&dev); hipDeviceGetAttribute(&cus, hipDeviceAttributeMultiprocessorCount, dev);
        if (hipFuncSetAttribute((const void*)mega, hipFuncAttributeMaxDynamicSharedMemorySize, LDS_BYTES) != hipSuccess) { fprintf(stderr, "hipFuncSetAttribute failed\n"); grid = -1; return; }
        hipOccupancyMaxActiveBlocksPerMultiprocessor(&per_cu, (const void*)mega, 512, LDS_BYTES);
        if (per_cu < 1) per_cu = 1;
        grid = cus * 1;
        (void)hipGetLastError();
    }
    if (grid < 0) return;
    if (hipMemsetAsync((char*)d_ws + WS_CTL, 0, 65536, stream) != hipSuccess) { fprintf(stderr, "memset failed\n"); return; }
    Args a{};
    for (int i = 0; i < 28; ++i) a.in[i] = (const float*)d_in[i];
    a.out = (float*)d_out; a.ws = (unsigned char*)d_ws;
#if ONE_LAUNCH
    a.ph_lo = 0; a.ph_hi = NPH;
    void* args[] = {&a};
    hipError_t e = hipLaunchCooperativeKernel((const void*)mega, dim3(grid), dim3(512), args, LDS_BYTES, stream);
    if (e != hipSuccess) fprintf(stderr, "cooperative launch failed: %s (grid %d)\n", hipGetErrorString(e), grid);
#else
    for (int ph = 0; ph < NPH; ++ph) { a.ph_lo = ph; a.ph_hi = ph + 1; hipLaunchKernelGGL(mega, dim3(grid), dim3(512), LDS_BYTES, stream, a); }
#endif
}
```

```cpp
#include <hip/hip_runtime.h>
#include <hip/hip_cooperative_groups.h>
#include <cstdio>
#include <cstdint>
namespace cg = cooperative_groups;
namespace pg8 {
#define PG8_LAS __attribute__((address_space(3)))
typedef unsigned short bf16_t;
typedef short bf16x8 __attribute__((ext_vector_type(8)));
typedef float f32x4 __attribute__((ext_vector_type(4)));
typedef unsigned u32x4 __attribute__((ext_vector_type(4)));
constexpr int BM = 256, BK = 64, HALF = 128, HTB = HALF * BK * 2  , STAGE_BYTES = 8 * HTB, NXCD = 8, WGM = 8;

__host__ __device__ __forceinline__ int lds_byte(int r, int c) { const int st = (r >> 4) * 2 + (c >> 5), rr = r & 15, cc = c & 31, ob = rr * 64 + cc * 2; return st * 1024 + (ob ^ (((ob >> 9) & 1) << 5)); }
__host__ __device__ __forceinline__ void stage_rc(int b, int& R, int& C) { const int st = b / 1024, sb = b % 1024, swz = sb ^ (((sb >> 9) & 1) << 5); R = (st >> 1) * 16 + swz / 64; C = (st & 1) * 32 + (swz % 64) / 2; }
__host__ __device__ __forceinline__ int perm32(int rho) { const int n = rho >> 4, i = rho & 15; return 8 * (i >> 2) + 4 * n + (i & 3); }

struct Unit { int pm, pn; };
struct Gemm { const bf16_t* A; const bf16_t* Bt; int M, N, K; int lda, ldb, kstepA, bdil;
    __device__ __forceinline__ size_t aoff(int pm) const { return (size_t)pm * 256 * lda * 2; }
    __device__ __forceinline__ size_t boff(int pn) const {
        if (bdil == 0) return (size_t)pn * 256 * ldb * 2;
        const int per = 32 / bdil, b = pn >> 5, rem = pn & 31, r = rem / per, jt = rem % per;
        return ((size_t)b * 8192 + r + (size_t)bdil * 256 * jt) * 1024 * 2; } };

struct StaticOrder {
    int nM, nN, nwg, G, c;
    __host__ __device__ void init(int M, int N, int G_, int c_) { nM = M / BM; nN = N / BM; nwg = nM * nN; G = G_; c = c_; }
    __host__ __device__ bool next(int i, Unit& u) const {
        const long L = (long)i * G + c; if (L >= nwg) return false;
        int wgid = (int)L; { const int q = nwg / NXCD, r = nwg % NXCD, xcd = wgid % NXCD, off = wgid / NXCD; wgid = (xcd < r ? xcd * (q + 1) : r * (q + 1) + (xcd - r) * q) + off; }
        const int nig = WGM * nN, gid = wgid / nig, fm = gid * WGM, gsz = (nM - fm) < WGM ? (nM - fm) : WGM;
        u.pm = fm + ((wgid % nig) % gsz); u.pn = (wgid % nig) / gsz; return true;
    }
    __device__ __forceinline__ void a_ready(const Unit&) const {}
    __device__ __forceinline__ void done(const Unit&) const {}
};

__device__ __forceinline__ unsigned cvt_pk_bf16(float lo, float hi) { unsigned r; asm volatile("v_cvt_pk_bf16_f32 %0, %1, %2" : "=v"(r) : "v"(lo), "v"(hi)); return r; }
typedef float f32x2 __attribute__((ext_vector_type(2)));
template <class Epi, class Sched, bool ALIGN_EPI = false, bool SP2 = false>
__device__ __forceinline__ void gemm_phase(PG8_LAS unsigned char* lds, const Gemm g, const Sched& S, const Epi& E) {
    int tid_o = threadIdx.x; asm volatile("" : "+v"(tid_o)); const int tid = tid_o, wid = __builtin_amdgcn_readfirstlane(tid >> 6), lane = tid & 63, wr = wid >> 2, wc = wid & 3, fr = lane & 15, fq = lane >> 4;
    const int K = g.K, nt = K / BK;
    unsigned voffA[2], voffB[2];
#pragma unroll
    for (int i = 0; i < 2; ++i) { int R, C; stage_rc(tid * 16 + i * 8192, R, C); const int Rb = Epi::PERM ? ((R & ~31) + perm32(R & 31)) : R;
        voffA[i] = (unsigned)(R * g.lda + C) * 2u; voffB[i] = (unsigned)(Rb * g.ldb + C) * 2u; }
    const size_t kstepB = (size_t)(BK * 2), kstepA = (size_t)g.kstepA;
    const size_t hstepA = (size_t)HALF * g.lda * 2, hstepB = (size_t)HALF * g.ldb * 2;
    const unsigned ldsw = (unsigned)wid * 1024u;
    const int aoff = lds_byte(wr * 64 + fr, fq * 8), boff = lds_byte(wc * 32 + fr, fq * 8);
#define PG8_SA(b, h) (((b) * 2 + (h)) * HTB)
#define PG8_SB(b, h) ((4 + (b) * 2 + (h)) * HTB)
#define PG8_STAGE(bufoff, gbase, voff) do { _Pragma("unroll") for (int _i = 0; _i < 2; ++_i) \
        __builtin_amdgcn_global_load_lds((const unsigned*)((const char*)(gbase) + (voff)[_i]), (PG8_LAS unsigned*)(lds + (bufoff) + ldsw + _i * 8192), 16, 0, 0); } while (0)
#define PG8_LDA(dst, b, h) do { _Pragma("unroll") for (int m = 0; m < 4; ++m) _Pragma("unroll") for (int k = 0; k < 2; ++k) dst[m][k] = *(const PG8_LAS bf16x8*)(lds + PG8_SA(b, h) + aoff + m * 2048 + k * 1024); } while (0)
#define PG8_LDB(dst, b, h) do { _Pragma("unroll") for (int n = 0; n < 2; ++n) _Pragma("unroll") for (int k = 0; k < 2; ++k) dst[n][k] = *(const PG8_LAS bf16x8*)(lds + PG8_SB(b, h) + boff + n * 2048 + k * 1024); } while (0)
#define PG8_MMA(ai, bj, At, Bt) do { __builtin_amdgcn_s_setprio(1); _Pragma("unroll") for (int m = 0; m < 4; ++m) _Pragma("unroll") for (int n = 0; n < 2; ++n) _Pragma("unroll") for (int k = 0; k < 2; ++k) \
        acc[ai][bj][m][n] = __builtin_amdgcn_mfma_f32_16x16x32_bf16(Bt[n][k], At[m][k], acc[ai][bj][m][n], 0, 0, 0); __builtin_amdgcn_s_setprio(0); } while (0)
#define PG8_WAIT_V(n) asm volatile("s_waitcnt vmcnt(" #n ")" ::: "memory")
#define PG8_WAIT_L(n) asm volatile("s_waitcnt lgkmcnt(" #n ")" ::: "memory")
#define PG8_BAR __builtin_amdgcn_s_barrier()
#define PG8_SCHED __builtin_amdgcn_sched_barrier(0)
    Unit cur, nxt; int ui = 0;
    if (!S.next(0, cur)) return;
    f32x4 acc[2][2][4][2];
#pragma unroll
    for (int a = 0; a < 2; ++a)
#pragma unroll
        for (int b = 0; b < 2; ++b)
#pragma unroll
            for (int m = 0; m < 4; ++m)
#pragma unroll
                for (int n = 0; n < 2; ++n) acc[a][b][m][n] = (f32x4){0.f, 0.f, 0.f, 0.f};
    bf16x8 At[4][2], B0[2][2], B1[2][2];
    const char* cA = (const char*)g.A + g.aoff(cur.pm); const char* cB = (const char*)g.Bt + g.boff(cur.pn);
    S.a_ready(cur);
    if constexpr (SP2) {
        PG8_STAGE(PG8_SB(0, 0), cB, voffB); PG8_STAGE(PG8_SB(0, 1), cB + hstepB, voffB); PG8_STAGE(PG8_SA(0, 0), cA, voffA); PG8_STAGE(PG8_SA(0, 1), cA + hstepA, voffA);
        if (wr == 1) PG8_BAR;
        PG8_WAIT_V(2); PG8_BAR;
        PG8_STAGE(PG8_SB(1, 0), cB + kstepB, voffB); PG8_STAGE(PG8_SA(1, 0), cA + kstepA, voffA); PG8_STAGE(PG8_SB(1, 1), cB + hstepB + kstepB, voffB);
        PG8_WAIT_V(6); PG8_BAR;
    } else {
        PG8_STAGE(PG8_SB(0, 0), cB, voffB); PG8_STAGE(PG8_SA(0, 0), cA, voffA); PG8_STAGE(PG8_SB(0, 1), cB + hstepB, voffB); PG8_STAGE(PG8_SA(0, 1), cA + hstepA, voffA);
        if (wr == 1) PG8_BAR;
        PG8_WAIT_V(4); PG8_BAR;
        PG8_STAGE(PG8_SB(1, 0), cB + kstepB, voffB); PG8_STAGE(PG8_SA(1, 0), cA + kstepA, voffA); PG8_STAGE(PG8_SB(1, 1), cB + hstepB + kstepB, voffB);
        PG8_WAIT_V(6); PG8_BAR;
    }
    for (;;) {
        const bool has_next = S.next(ui + 1, nxt);
        const char* nA = has_next ? (const char*)g.A + g.aoff(nxt.pm) : cA; const char* nB = has_next ? (const char*)g.Bt + g.boff(nxt.pn) : cB;
        _Pragma("clang loop unroll(disable)") for (int t = 0; t < nt; t += 2) {
            const bool last = (t == nt - 2);
            const char* a1 = cA + (size_t)(t + 1) * kstepA;
            const char* a2 = last ? nA : cA + (size_t)(t + 2) * kstepA; const char* b2 = last ? nB : cB + (size_t)(t + 2) * kstepB;
            const char* a3 = a2 + kstepA; const char* b3 = b2 + kstepB;
            if (last && has_next) S.a_ready(nxt);
            if constexpr (SP2) {
            PG8_LDB(B0, 0, 0); PG8_LDB(B1, 0, 1); PG8_SCHED; PG8_LDA(At, 0, 0); PG8_STAGE(PG8_SA(1, 1), a1 + hstepA, voffA);
            PG8_WAIT_V(8); PG8_WAIT_L(0); PG8_BAR; PG8_MMA(0, 0, At, B0); PG8_MMA(0, 1, At, B1); PG8_BAR; PG8_SCHED;
            PG8_LDA(At, 0, 1); PG8_STAGE(PG8_SB(0, 0), b2, voffB); PG8_STAGE(PG8_SB(0, 1), b2 + hstepB, voffB); PG8_STAGE(PG8_SA(0, 0), a2, voffA);
            PG8_WAIT_V(8); PG8_WAIT_L(0); PG8_BAR; PG8_MMA(1, 0, At, B0); PG8_MMA(1, 1, At, B1); PG8_BAR; PG8_SCHED;
            PG8_LDB(B0, 1, 0); PG8_LDB(B1, 1, 1); PG8_SCHED; PG8_LDA(At, 1, 0); PG8_STAGE(PG8_SA(0, 1), a2 + hstepA, voffA);
            PG8_WAIT_V(8); PG8_WAIT_L(0); PG8_BAR; PG8_MMA(0, 0, At, B0); PG8_MMA(0, 1, At, B1); PG8_BAR; PG8_SCHED;
            PG8_LDA(At, 1, 1); PG8_STAGE(PG8_SB(1, 0), b3, voffB); PG8_STAGE(PG8_SB(1, 1), b3 + hstepB, voffB); PG8_STAGE(PG8_SA(1, 0), a3, voffA);
            PG8_WAIT_V(8); PG8_WAIT_L(0); PG8_BAR; PG8_MMA(1, 0, At, B0); PG8_MMA(1, 1, At, B1); PG8_BAR; PG8_SCHED;
            } else {
            PG8_LDB(B0, 0, 0); PG8_SCHED; PG8_LDA(At, 0, 0); PG8_STAGE(PG8_SA(1, 1), a1 + hstepA, voffA);
            PG8_WAIT_L(8); PG8_BAR; PG8_WAIT_L(0); PG8_MMA(0, 0, At, B0); PG8_BAR; PG8_SCHED;
            PG8_LDB(B1, 0, 1); PG8_STAGE(PG8_SB(0, 0), b2, voffB);
            PG8_BAR; PG8_WAIT_L(0); PG8_MMA(0, 1, At, B1); PG8_BAR;
            PG8_LDA(At, 0, 1); PG8_STAGE(PG8_SA(0, 0), a2, voffA);
            PG8_BAR; PG8_WAIT_L(0); PG8_MMA(1, 0, At, B0); PG8_BAR; PG8_SCHED;
            PG8_STAGE(PG8_SB(0, 1), b2 + hstepB, voffB);
            PG8_WAIT_V(6); PG8_BAR; PG8_MMA(1, 1, At, B1); PG8_BAR;
            PG8_LDB(B0, 1, 0); PG8_SCHED; PG8_LDA(At, 1, 0); PG8_STAGE(PG8_SA(0, 1), a2 + hstepA, voffA);
            PG8_WAIT_L(8); PG8_BAR; PG8_WAIT_L(0); PG8_MMA(0, 0, At, B0); PG8_BAR; PG8_SCHED;
            PG8_LDB(B1, 1, 1); PG8_STAGE(PG8_SB(1, 0), b3, voffB);
            PG8_BAR; PG8_WAIT_L(0); PG8_MMA(0, 1, At, B1); PG8_BAR;
            PG8_LDA(At, 1, 1); PG8_STAGE(PG8_SA(1, 0), a3, voffA);
            PG8_BAR; PG8_WAIT_L(0); PG8_MMA(1, 0, At, B0); PG8_BAR; PG8_SCHED;
            PG8_STAGE(PG8_SB(1, 1), b3 + hstepB, voffB);
            PG8_WAIT_V(6); PG8_BAR; PG8_MMA(1, 1, At, B1); PG8_BAR;
            }
        }
        if constexpr (ALIGN_EPI) { if (wr == 0) PG8_BAR; }
        if constexpr (!Epi::AFTER_DRAIN) { E(acc, cur, wr, wc, fr, fq); S.done(cur); }
        if (!has_next) break;
#pragma unroll
        for (int a = 0; a < 2; ++a)
#pragma unroll
            for (int b = 0; b < 2; ++b)
#pragma unroll
                for (int m = 0; m < 4; ++m)
#pragma unroll
                    for (int n = 0; n < 2; ++n) acc[a][b][m][n] = (f32x4){0.f, 0.f, 0.f, 0.f};
        cur = nxt; cA = nA; cB = nB; ++ui;
        if constexpr (ALIGN_EPI) { if (wr == 1) PG8_BAR; }
    }
    PG8_WAIT_V(0);
    if constexpr (!ALIGN_EPI) { if (wr == 0) PG8_BAR; }
    PG8_BAR;
    if constexpr (Epi::AFTER_DRAIN) { E.fused(acc, cur, wr, wc, fr, fq, lds, wid, lane); S.done(cur); }
#undef PG8_SA
#undef PG8_SB
#undef PG8_STAGE
#undef PG8_LDA
#undef PG8_LDB
#undef PG8_MMA
#undef PG8_WAIT_V
#undef PG8_WAIT_L
#undef PG8_BAR
#undef PG8_SCHED
}
}
#define LAS __attribute__((address_space(3)))
typedef unsigned short bf16;
using pg8::f32x4; using pg8::bf16x8; using pg8::u32x4; using pg8::Unit; using pg8::cvt_pk_bf16;
typedef float f32x16 __attribute__((ext_vector_type(16)));
typedef unsigned u32x2 __attribute__((ext_vector_type(2)));
typedef short s16x4 __attribute__((ext_vector_type(4)));

constexpr int NB = 8, SEQ = 8192, T = NB * SEQ, DM = 1024, FF = 2816;
constexpr int HE_LD = 1792;
constexpr int HE_CQ = 0, HE_CKV = 384, HE_KPE = 640, HE_Q = 672, HE_KC = 1184, HE_VC = 1312, HE_KS = 1440, HE_KW = 1568, HE_GT = 1696;
constexpr float LOG2E = 1.4426950408889634f;
constexpr float DN_ALPHA = 1.4142135623730951f;
constexpr float NEGB = -1e30f;

constexpr size_t MiB = 1u << 20;
constexpr size_t WS_CTL = 0;
constexpr size_t WS_W = 1 * MiB;
constexpr size_t WS_PT = 256 * 1024;
constexpr size_t WS_ST = 512 * 1024;
constexpr size_t WE_GU = 0;
constexpr size_t WE_D = WE_GU + 4ull * 5632 * 1024;
constexpr size_t WE_E1 = WE_D + 4ull * 1024 * 2816;
constexpr size_t WE_E2 = WE_E1 + 1792ull * 1024;
constexpr size_t WE_UQ = WE_E2 + 256ull * 1024;
constexpr size_t WE_UK = WE_UQ + 768ull * 384;
constexpr size_t WE_UV = WE_UK + 512ull * 256;
constexpr size_t WE_C1K = WE_UV + 512ull * 256;
constexpr size_t WE_C1V = WE_C1K + 256ull * 2048;
constexpr size_t WE_C2K = WE_C1V + 256ull * 2048;
constexpr size_t WE_C2V = WE_C2K + 256ull * 256;
constexpr size_t WE_OE = WE_C2V + 256ull * 256;
constexpr size_t WE_O1 = WE_OE + 1024ull * 1024;
constexpr size_t WE_O2 = WE_O1 + 3072ull * 1024;
constexpr size_t WE_OO = WE_O2 + 1536ull * 1024;
constexpr size_t WE_END = WE_OO + 1024ull * 512;
static_assert(WE_END * 2 <= 95 * MiB, "weights fit");
constexpr size_t WS_CB = 96 * MiB;
constexpr size_t WS_XB = 97 * MiB;
constexpr size_t WS_R = 225 * MiB;
constexpr size_t R_H = WS_R;
constexpr size_t R_HE = WS_R;
constexpr size_t R_VT = WS_R + 224 * MiB;
constexpr size_t R_QM = WS_R + 256 * MiB;
constexpr size_t R_KN = WS_R + 352 * MiB;
constexpr size_t R_VMT = WS_R + 416 * MiB;
constexpr size_t R_OE = WS_R + 480 * MiB;
constexpr size_t R_KROT = WS_R + 608 * MiB;
constexpr size_t R_RT = WS_R + 612 * MiB;
constexpr size_t R_GT = WS_R + 620 * MiB;
constexpr size_t R_RSTD = WS_R + 628 * MiB;
constexpr size_t R_HC = WS_R + 629 * MiB;
constexpr size_t R_KCC = WS_R + 645 * MiB;
constexpr size_t R_VCT = WS_R + 647 * MiB;
constexpr size_t R_QK = WS_R;
constexpr size_t R_VOT = WS_R + 384 * MiB;
constexpr size_t R_OG = WS_R + 576 * MiB;
constexpr size_t R_LSE = WS_R + 768 * MiB;
constexpr size_t R_OO = WS_R;
constexpr size_t WS_NEED = WS_R + 772 * MiB;
static_assert(WS_NEED <= 1024 * MiB, "ws");

constexpr int LDS_BYTES = 147456;

__device__ __forceinline__ float fast_exp2(float x) { return __builtin_amdgcn_exp2f(x); }
__device__ __forceinline__ float fast_rcp(float x) { return __builtin_amdgcn_rcpf(x); }
__device__ __forceinline__ float bf2f(bf16 v) { return __uint_as_float(((unsigned)v) << 16); }
__device__ __forceinline__ float wave_sum(float v) {
#pragma unroll
    for (int o = 1; o < 64; o <<= 1) v += __shfl_xor(v, o);
    return v;
}

struct EpiStore {
    static constexpr bool PERM = true, AFTER_DRAIN = false;
    bf16* O; int ldc; const float* rscale; const float* cscale; const float* bias; int act; int ncv; int nrv; int zrow; int zcol;
    __device__ __forceinline__ void operator()(const f32x4 (&acc)[2][2][4][2], const Unit& u, int wr, int wc, int fr, int fq) const {
#pragma unroll
        for (int bj = 0; bj < 2; ++bj) {
            const int col = u.pn * 256 + bj * 128 + wc * 32 + 8 * fq;
            if (col < ncv) {
                float cs[8], bs[8];
#pragma unroll
                for (int e = 0; e < 8; ++e) { cs[e] = cscale ? cscale[col + e] : 1.f; bs[e] = bias ? bias[col + e] : 0.f; }
#pragma unroll
                for (int ai = 0; ai < 2; ++ai)
#pragma unroll
                    for (int m = 0; m < 4; ++m) {
                        const int row = u.pm * 256 + ai * 128 + wr * 64 + m * 16 + fr;
                        if (row < nrv) {
                            const float rs = rscale ? rscale[row] : 1.f;
                            const f32x4 v0 = acc[ai][bj][m][0], v1 = acc[ai][bj][m][1];
                            float v[8] = {v0[0], v0[1], v0[2], v0[3], v1[0], v1[1], v1[2], v1[3]};
                            const bool zr = zrow && ((row & 511) == 511);
#pragma unroll
                            for (int e = 0; e < 8; ++e) {
                                float x = v[e] + bs[e];
                                if (act == 1) { const float y = 0.7978845608028654f * (x + 0.044715f * x * x * x); x = x * fast_rcp(1.f + fast_exp2(-2.f * LOG2E * y)); }
                                x *= rs * cs[e];
                                if (zr || (zcol && (((col + e) & 511) == 511))) x = 0.f;
                                v[e] = x;
                            }
                            u32x4 w; w.x = cvt_pk_bf16(v[0], v[1]); w.y = cvt_pk_bf16(v[2], v[3]); w.z = cvt_pk_bf16(v[4], v[5]); w.w = cvt_pk_bf16(v[6], v[7]);
                            *(u32x4*)(O + (size_t)row * ldc + col) = w;
                        }
                    }
            }
        }
    }
};
struct EpiSwiglu {
    static constexpr bool PERM = true, AFTER_DRAIN = false;
    bf16* H; int ldh;
    __device__ __forceinline__ void operator()(const f32x4 (&acc)[2][2][4][2], const Unit& u, int wr, int wc, int fr, int fq) const {
        const int col = u.pn * 128 + wc * 32 + 8 * fq;
#pragma unroll
        for (int ai = 0; ai < 2; ++ai)
#pragma unroll
            for (int m = 0; m < 4; ++m) {
                const int row = u.pm * 256 + ai * 128 + wr * 64 + m * 16 + fr;
                const f32x4 g0 = acc[ai][0][m][0], g1 = acc[ai][0][m][1], u0 = acc[ai][1][m][0], u1 = acc[ai][1][m][1];
                float g[8] = {g0[0], g0[1], g0[2], g0[3], g1[0], g1[1], g1[2], g1[3]};
                float uu[8] = {u0[0], u0[1], u0[2], u0[3], u1[0], u1[1], u1[2], u1[3]};
#pragma unroll
                for (int e = 0; e < 8; ++e) g[e] = g[e] * fast_rcp(1.f + fast_exp2(-LOG2E * g[e])) * uu[e];
                u32x4 w; w.x = cvt_pk_bf16(g[0], g[1]); w.y = cvt_pk_bf16(g[2], g[3]); w.z = cvt_pk_bf16(g[4], g[5]); w.w = cvt_pk_bf16(g[6], g[7]);
                *(u32x4*)(H + (size_t)row * ldh + col) = w;
            }
    }
};
template <bool LN>
struct EpiResidT {
    static constexpr bool PERM = true, AFTER_DRAIN = false;
    const float* Xin; float* Xout; unsigned char* ws; int gi, bi, goff; float alpha, beta;
    __device__ __forceinline__ void operator()(const f32x4 (&acc)[2][2][4][2], const Unit& u, int wr, int wc, int fr, int fq) const {
        constexpr int ldx = 1024;
        const float* st = (const float*)(ws + WS_ST); const float* gam = nullptr; const float* bet = nullptr;
        if (LN) { const float* const* PT = (const float* const*)(ws + WS_PT); gam = PT[gi] + goff; bet = PT[bi] + goff; }
#pragma unroll
        for (int bj = 0; bj < 2; ++bj) {
            const int col = u.pn * 256 + bj * 128 + wc * 32 + 8 * fq;
            f32x4 g0, g1, b0, b1;
            if (LN) { g0 = *(const f32x4*)(gam + col); g1 = *(const f32x4*)(gam + col + 4); b0 = *(const f32x4*)(bet + col); b1 = *(const f32x4*)(bet + col + 4); }
#pragma unroll
            for (int ai = 0; ai < 2; ++ai) {
                f32x4 x0[4], x1[4]; float mean[4], rstd[4];
#pragma unroll
                for (int m = 0; m < 4; ++m) {
                    const int row = u.pm * 256 + ai * 128 + wr * 64 + m * 16 + fr;
                    const size_t off = (size_t)row * ldx + col;
                    x0[m] = *(const f32x4*)(Xin + off); x1[m] = *(const f32x4*)(Xin + off + 4);
                    if (LN) { mean[m] = st[2 * row]; rstd[m] = st[2 * row + 1]; }
                }
#pragma unroll
                for (int m = 0; m < 4; ++m) {
                    const int row = u.pm * 256 + ai * 128 + wr * 64 + m * 16 + fr;
                    const size_t off = (size_t)row * ldx + col;
                    f32x4 a0 = x0[m], a1 = x1[m];
                    if (LN) { a0 = (a0 - mean[m]) * rstd[m] * g0 + b0; a1 = (a1 - mean[m]) * rstd[m] * g1 + b1; }
                    *(f32x4*)(Xout + off) = a0 * alpha + acc[ai][bj][m][0] * beta;
                    *(f32x4*)(Xout + off + 4) = a1 * alpha + acc[ai][bj][m][1] * beta;
                }
            }
        }
    }
};
struct EpiRopeQ {
    static constexpr bool PERM = true, AFTER_DRAIN = false;
    bf16* Q; int ldq; const float* rstd; const float* RT; float qscale;
    __device__ __forceinline__ void operator()(const f32x4 (&acc)[2][2][4][2], const Unit& u, int wr, int wc, int fr, int fq) const {
#pragma unroll
        for (int bj = 0; bj < 2; ++bj) {
            const int grp = u.pn * 8 + bj * 4 + wc; const bool is_rope = (grp % 3) == 2;
            const int col = u.pn * 256 + bj * 128 + wc * 32 + 8 * fq;
#pragma unroll
            for (int ai = 0; ai < 2; ++ai)
#pragma unroll
                for (int m = 0; m < 4; ++m) {
                    const int row = u.pm * 256 + ai * 128 + wr * 64 + m * 16 + fr;
                    const float rs = rstd[row] * qscale;
                    f32x4 v0 = acc[ai][bj][m][0] * rs, v1 = acc[ai][bj][m][1] * rs;
                    if (is_rope) {
                        const f32x4 c01 = *(const f32x4*)(RT + (size_t)row * 32 + 8 * fq), c23 = *(const f32x4*)(RT + (size_t)row * 32 + 8 * fq + 4);
                        const float cs[4] = {c01[0], c01[2], c23[0], c23[2]}, sn[4] = {c01[1], c01[3], c23[1], c23[3]};
                        f32x4 o1, o2;
#pragma unroll
                        for (int e = 0; e < 4; ++e) { o1[e] = v0[e] * cs[e] - v1[e] * sn[e]; o2[e] = v1[e] * cs[e] + v0[e] * sn[e]; }
                        v0 = o1; v1 = o2;
                    }
                    u32x4 w; w.x = cvt_pk_bf16(v0[0], v0[1]); w.y = cvt_pk_bf16(v0[2], v0[3]); w.z = cvt_pk_bf16(v1[0], v1[1]); w.w = cvt_pk_bf16(v1[2], v1[3]);
                    *(u32x4*)(Q + (size_t)row * ldq + col) = w;
                }
        }
    }
};
#define XB_TMO      128
#define XB_XCNT(j)  (256  + 64 * (j))
#define XB_XSUB(j)  (1280 + 64 * (j))
#define XB_XGEN(j)  (2304 + 64 * (j))
#define XB_TOP      3328
#define XB_TOPGEN   3392
#define XCD_BAR_WORDS 3456
#define XB_SPIN_CAP (1u << 18)

__device__ __forceinline__ unsigned xb_ld(unsigned* p)              { return __hip_atomic_load(p, __ATOMIC_RELAXED, __HIP_MEMORY_SCOPE_AGENT); }
__device__ __forceinline__ unsigned xb_add(unsigned* p, unsigned v) { return __hip_atomic_fetch_add(p, v, __ATOMIC_RELAXED, __HIP_MEMORY_SCOPE_AGENT); }
__device__ __forceinline__ unsigned xb_xcc_id() { return (unsigned)__builtin_amdgcn_s_getreg((3 << 11) | 20) & 0xFu; }
#define XB_SPIN(cond, bar) do { unsigned _sp = 0; while (cond) { __builtin_amdgcn_s_sleep(1); \
    if ((++_sp & 255u) == 0u) { if (xb_ld(&(bar)[XB_TMO])) break; if (_sp > XB_SPIN_CAP) { atomicAdd(&(bar)[XB_TMO], 1u); break; } } } } while (0)

struct XcdBarrier {
    unsigned* bar; unsigned x;
    volatile LAS unsigned* st;
};

__device__ __forceinline__ XcdBarrier xcd_barrier_post(unsigned* bar, volatile LAS unsigned* st) {
    XcdBarrier b; b.bar = bar; b.x = xb_xcc_id(); b.st = st;
    if (threadIdx.x == 0) (void)xb_add(&bar[XB_XCNT(b.x)], 1u);
    return b;
}
__device__ __forceinline__ void xcd_barrier_complete(unsigned* bar, unsigned x, unsigned& nloc, unsigned& nx) {
    const unsigned G = gridDim.x * gridDim.y * gridDim.z;
    unsigned sum, cnt, mine, sp = 0u;
    for (;;) {
        sum = 0u; cnt = 0u; mine = 0u;
#pragma unroll
        for (unsigned j = 0; j < 16; ++j) { const unsigned c = xb_ld(&bar[XB_XCNT(j)]); sum += c; cnt += (c > 0u) ? 1u : 0u; mine = (j == x) ? c : mine; }
        if (sum == G) break;
        __builtin_amdgcn_s_sleep(1);
        if ((++sp & 255u) == 0u) { if (xb_ld(&bar[XB_TMO])) break; if (sp > XB_SPIN_CAP) { atomicAdd(&bar[XB_TMO], 1u); break; } }
    }
    nloc = mine > 0u ? mine : 1u; nx = cnt > 0u ? cnt : 1u;
}

__device__ __forceinline__ void xcd_barrier(const XcdBarrier& b) {
    asm volatile("s_waitcnt vmcnt(0)" ::: "memory");
    __syncthreads();
    if (threadIdx.x == 0) {
        unsigned* bar = b.bar;
        __builtin_amdgcn_s_waitcnt(0);
        unsigned nloc = b.st[0], nx = b.st[1];
        if (nloc == 0u) { xcd_barrier_complete(bar, b.x, nloc, nx); b.st[0] = nloc; b.st[1] = nx; }
        const unsigned old = xb_add(&bar[XB_XSUB(b.x)], 1u);
        const unsigned gen = old / nloc;
        if (old + 1u == (gen + 1u) * nloc) {
            __builtin_amdgcn_fence(__ATOMIC_RELEASE, "agent");
            asm volatile("s_waitcnt vmcnt(0)" ::: "memory");
            const unsigned og = xb_add(&bar[XB_TOP], 1u);
            const unsigned tg = og / nx;
            if (og + 1u == (tg + 1u) * nx) xb_add(&bar[XB_TOPGEN], 1u);
            else XB_SPIN(xb_ld(&bar[XB_TOPGEN]) == tg, bar);
            __builtin_amdgcn_fence(__ATOMIC_ACQUIRE, "agent");
            xb_add(&bar[XB_XGEN(b.x)], 1u);
            asm volatile("s_waitcnt vmcnt(0)" ::: "memory");
        } else {
            XB_SPIN(xb_ld(&bar[XB_XGEN(b.x)]) == gen, bar);
            __builtin_amdgcn_fence(__ATOMIC_ACQUIRE, "agent");
            asm volatile("s_waitcnt vmcnt(0)" ::: "memory");
        }
    }
    __syncthreads();
}
struct KP {
    float* out; unsigned char* ws; const int* pos;
    __device__ __forceinline__ const int* pos_local() const { int one = 1; asm volatile("" : "+s"(one)); return (const int*)(((const float* const*)(ws + WS_PT))[one]); }
#define KP_ACC(T_, NAME, OFF) __device__ __forceinline__ T_* NAME() const { return (T_*)(ws + (OFF)); }
    KP_ACC(bf16, WB, WS_W) KP_ACC(bf16, XB, WS_XB) KP_ACC(bf16, H, R_H) KP_ACC(bf16, HE, R_HE) KP_ACC(bf16, VT, R_VT) KP_ACC(bf16, QM, R_QM)
    KP_ACC(bf16, KN, R_KN) KP_ACC(bf16, VMT, R_VMT) KP_ACC(bf16, OE, R_OE) KP_ACC(bf16, KROT, R_KROT) KP_ACC(bf16, HC, R_HC) KP_ACC(bf16, KCC, R_KCC)
    KP_ACC(bf16, VCT, R_VCT) KP_ACC(bf16, QK, R_QK) KP_ACC(bf16, VOT, R_VOT) KP_ACC(bf16, OG, R_OG) KP_ACC(bf16, OO, R_OO)
    KP_ACC(float, RT, R_RT) KP_ACC(float, GT, R_GT) KP_ACC(float, RSTD, R_RSTD) KP_ACC(float, LSE, R_LSE) KP_ACC(float, CB, WS_CB) KP_ACC(unsigned, CTL, WS_CTL)
};

__device__ __forceinline__ int crow(int v, int hi) { return (v & 3) + 8 * (v >> 2) + 4 * hi; }
__device__ __forceinline__ float xhalf_max(float x) { auto rr = __builtin_amdgcn_permlane32_swap(__float_as_uint(x), __float_as_uint(x), false, false); return fmaxf(__uint_as_float(rr[0]), __uint_as_float(rr[1])); }
__device__ __forceinline__ float xhalf_sum(float x) { auto rr = __builtin_amdgcn_permlane32_swap(__float_as_uint(x), __float_as_uint(x), false, false); return __uint_as_float(rr[0]) + __uint_as_float(rr[1]); }
__device__ __forceinline__ float max16(const f32x16& s) {
    float a = fmaxf(fmaxf(s[0], s[1]), s[2]), b = fmaxf(fmaxf(s[3], s[4]), s[5]);
    a = fmaxf(fmaxf(a, s[6]), s[7]); b = fmaxf(fmaxf(b, s[8]), s[9]); a = fmaxf(fmaxf(a, s[10]), s[11]); b = fmaxf(fmaxf(b, s[12]), s[13]);
    return fmaxf(fmaxf(a, b), fmaxf(s[14], s[15])); }

template <int DK16>
__device__ __forceinline__ f32x16 qk_sub(const LAS unsigned char* Kt, int ks, int sub, const bf16x8 (&qf)[DK16], int r32, int hi) {
    f32x16 s;
#pragma unroll
    for (int v = 0; v < 16; ++v) s[v] = 0.f;
    const LAS unsigned char* p = Kt + (sub * 32 + r32) * ks + hi * 16;
#pragma unroll
    for (int dk = 0; dk < DK16; ++dk) { const bf16x8 kf = *(const LAS bf16x8*)(p + dk * 32); s = __builtin_amdgcn_mfma_f32_32x32x16_bf16(kf, qf[dk], s, 0, 0, 0); }
    return s;
}
template <int DV32>
__device__ __forceinline__ void pv_sub(f32x16 (&o)[DV32], const LAS unsigned char* Vt, int vs, int sub, const f32x16& p, int r32, int hi) {
#pragma unroll
    for (int kb = 0; kb < 2; ++kb) {
        u32x4 pw; pw.x = cvt_pk_bf16(p[8 * kb + 0], p[8 * kb + 1]); pw.y = cvt_pk_bf16(p[8 * kb + 2], p[8 * kb + 3]); pw.z = cvt_pk_bf16(p[8 * kb + 4], p[8 * kb + 5]); pw.w = cvt_pk_bf16(p[8 * kb + 6], p[8 * kb + 7]);
        const bf16x8 pf = __builtin_bit_cast(bf16x8, pw);
#pragma unroll
        for (int i = 0; i < DV32; ++i) {
            const LAS unsigned char* vp = Vt + (32 * i + r32) * vs + (sub * 32 + 16 * kb + 4 * hi) * 2;
            const s16x4 lo = *(const LAS s16x4*)vp, hh = *(const LAS s16x4*)(vp + 16);
            const bf16x8 vf = (bf16x8){lo[0], lo[1], lo[2], lo[3], hh[0], hh[1], hh[2], hh[3]};
            o[i] = __builtin_amdgcn_mfma_f32_32x32x16_bf16(vf, pf, o[i], 0, 0, 0);
        }
    }
}
template <int DV32>
__device__ __forceinline__ void pv_packed(f32x16 (&o)[DV32], const LAS unsigned char* Vt, int vs, int sub, const u32x4& pk0, const u32x4& pk1, int r32, int hi) {
#pragma unroll
    for (int kb = 0; kb < 2; ++kb) {
        const bf16x8 pf = __builtin_bit_cast(bf16x8, kb == 0 ? pk0 : pk1);
#pragma unroll
        for (int i = 0; i < DV32; ++i) {
            const LAS unsigned char* vp = Vt + (32 * i + r32) * vs + (sub * 32 + 16 * kb + 4 * hi) * 2;
            const s16x4 lo = *(const LAS s16x4*)vp, hh = *(const LAS s16x4*)(vp + 16);
            const bf16x8 vf = (bf16x8){lo[0], lo[1], lo[2], lo[3], hh[0], hh[1], hh[2], hh[3]};
            o[i] = __builtin_amdgcn_mfma_f32_32x32x16_bf16(vf, pf, o[i], 0, 0, 0);
        }
    }
}
__device__ __forceinline__ u32x4 pack8(const f32x16& p, int kb) {
    u32x4 pw; pw.x = cvt_pk_bf16(p[8 * kb + 0], p[8 * kb + 1]); pw.y = cvt_pk_bf16(p[8 * kb + 2], p[8 * kb + 3]); pw.z = cvt_pk_bf16(p[8 * kb + 4], p[8 * kb + 5]); pw.w = cvt_pk_bf16(p[8 * kb + 6], p[8 * kb + 7]); return pw; }
template <int D, int DV, int MODE, bool HASBIAS, bool JOINT, bool DEFER, class KA, class VA, class PF, class BF, class VF, class NM, class WS, class CB>
__device__ __forceinline__ void fa_loop(LAS unsigned char* lds, int nt, const KA& ka, const VA& va, const PF& pf, const BF& bf, const VF& vf, const NM& nm, const WS& wskip, const CB& cb, float c1,
                                        const bf16x8 (&qf)[D / 16], float& m, float& l, f32x16 (&o)[DV / 32], int tid_in, int r32, int hi) {
    int tid = tid_in; asm volatile("" : "+v"(tid));
    constexpr int KS = D * 2 + 16, VS = 136  , KCH = D / 8, NKR = (64 * KCH + 511) / 512, NVR = (DV * 8) / 512, NVS = DEFER ? 3 : 2, KOFF = 0, VOFF = 2 * 64 * KS, POFF = VOFF + NVS * DV * VS;
    constexpr bool NEEDV = (MODE != 1);
    u32x4 kregA[NKR], kregB[NKR]; u32x4 vregA[NVR], vregB[NVR]; float pregA = 0.f, pregB = 0.f;
    if (nt <= 0) return;
#define FA_LOAD(t_, KR, VR, PR) do { \
    _Pragma("unroll") for (int r_ = 0; r_ < NKR; ++r_) { const int idx_ = tid + 512 * r_; if (idx_ < 64 * KCH) { const int row_ = idx_ / KCH, ch_ = idx_ % KCH; KR[r_] = *(const u32x4*)ka((t_), row_, ch_); } } \
    if (NEEDV) { _Pragma("unroll") for (int r_ = 0; r_ < NVR; ++r_) { const int idx_ = tid + 512 * r_; const int d_ = idx_ >> 3, ch_ = idx_ & 7; VR[r_] = *(const u32x4*)va((t_), d_, ch_); } } \
    if (HASBIAS) { if (tid < 64) PR = pf((t_), tid); } } while (0)
#define FA_STORE(tt_, KR, VR, PR) do { LAS unsigned char* kb_ = lds + KOFF + ((tt_) & 1) * (64 * KS); LAS unsigned char* vb_ = lds + VOFF + ((tt_) % NVS) * (DV * VS); \
    _Pragma("unroll") for (int r_ = 0; r_ < NKR; ++r_) { const int idx_ = tid + 512 * r_; if (idx_ < 64 * KCH) { const int row_ = idx_ / KCH, ch_ = idx_ % KCH; *(LAS u32x4*)(kb_ + row_ * KS + ch_ * 16) = KR[r_]; } } \
    if (NEEDV) { _Pragma("unroll") for (int r_ = 0; r_ < NVR; ++r_) { const int idx_ = tid + 512 * r_; const int d_ = idx_ >> 3, ch_ = idx_ & 7; LAS u32x2* q_ = (LAS u32x2*)(vb_ + d_ * VS + ch_ * 16); q_[0] = (u32x2){VR[r_].x, VR[r_].y}; q_[1] = (u32x2){VR[r_].z, VR[r_].w}; } } \
    if (HASBIAS) { if (tid < 64) *(LAS float*)(lds + POFF + ((tt_) & 1) * 256 + tid * 4) = PR; } } while (0)
    const bool defer_wave = DEFER && (tid_in >= 256);
    u32x4 pp0 = {0u, 0u, 0u, 0u}, pp1 = pp0, pp2 = pp0, pp3 = pp0; int pend = -1;
    auto compute = [&](int t, int bufi) __attribute__((always_inline)) {
        const LAS unsigned char* cur = lds + KOFF + (t & 1) * (64 * KS);
        const int vslot = t % NVS; const LAS unsigned char* curv = lds + VOFF + vslot * (DV * VS);
        const LAS float* kp = (const LAS float*)(lds + POFF + (t & 1) * 256);
        if (DEFER) { if (pend >= 0) { const LAS unsigned char* pv_ = lds + VOFF + pend * (DV * VS); pv_packed<DV / 32>(o, pv_, VS, 0, pp0, pp1, r32, hi); pv_packed<DV / 32>(o, pv_, VS, 1, pp2, pp3, r32, hi); pend = -1; } }
        const bool sk0 = wskip(t, 0), sk1 = wskip(t, 1);
        if (JOINT && MODE != 2 && !sk0 && !sk1) {
            f32x16 s0 = qk_sub<D / 16>(cur, KS, 0, qf, r32, hi); if (DEFER) __builtin_amdgcn_sched_barrier(0); f32x16 s1 = qk_sub<D / 16>(cur, KS, 1, qf, r32, hi);
            if (HASBIAS) {
#pragma unroll
                for (int a4 = 0; a4 < 4; ++a4) { const int kin0 = 8 * a4 + 4 * hi; const f32x4 kq0 = *(const LAS f32x4*)(kp + kin0), kq1 = *(const LAS f32x4*)(kp + 32 + kin0);
#pragma unroll
                    for (int e = 0; e < 4; ++e) { s0[4 * a4 + e] = s0[4 * a4 + e] * c1 + bf(t, kin0 + e, kq0[e]); s1[4 * a4 + e] = s1[4 * a4 + e] * c1 + bf(t, 32 + kin0 + e, kq1[e]); } }
            }
            const bool masked = nm(t, 0) || nm(t, 1);
            if (masked) {
#pragma unroll
                for (int v = 0; v < 16; ++v) { const int kin = crow(v, hi); if (!vf(t, kin)) s0[v] = NEGB; if (!vf(t, 32 + kin)) s1[v] = NEGB; }
            }
            float mx = xhalf_max(fmaxf(max16(s0), max16(s1)));
            const float mn = fmaxf(m, mx); float sum0 = 0.f, sum1 = 0.f;
            if (masked) {
#pragma unroll
                for (int v = 0; v < 16; ++v) { const float p0 = s0[v] > -1e29f ? fast_exp2(s0[v] - mn) : 0.f, p1 = s1[v] > -1e29f ? fast_exp2(s1[v] - mn) : 0.f; s0[v] = p0; s1[v] = p1; sum0 += p0; sum1 += p1; }
            } else {
#pragma unroll
                for (int v = 0; v < 16; ++v) { const float p0 = fast_exp2(s0[v] - mn), p1 = fast_exp2(s1[v] - mn); s0[v] = p0; s1[v] = p1; sum0 += p0; sum1 += p1; }
            }
            if (__any(mn > m)) {
                const float alpha = fast_exp2(m - mn); l *= alpha;
                if (MODE == 0) {
#pragma unroll
                    for (int i = 0; i < DV / 32; ++i)
#pragma unroll
                        for (int v = 0; v < 16; ++v) o[i][v] *= alpha;
                }
            }
            l += sum0 + sum1; m = mn;
            if (MODE == 0) {
                if (defer_wave) { pp0 = pack8(s0, 0); pp1 = pack8(s0, 1); pp2 = pack8(s1, 0); pp3 = pack8(s1, 1); pend = vslot; }
                else { pv_sub<DV / 32>(o, curv, VS, 0, s0, r32, hi); pv_sub<DV / 32>(o, curv, VS, 1, s1, r32, hi); }
            }
        } else
#pragma unroll
        for (int sub = 0; sub < 2; ++sub) {
            if (!wskip(t, sub)) {
                f32x16 s = qk_sub<D / 16>(cur, KS, sub, qf, r32, hi);
                if (HASBIAS) {
#pragma unroll
                    for (int a4 = 0; a4 < 4; ++a4) { const int kin0 = sub * 32 + 8 * a4 + 4 * hi; const f32x4 kq = *(const LAS f32x4*)(kp + kin0);
#pragma unroll
                        for (int e = 0; e < 4; ++e) s[4 * a4 + e] = s[4 * a4 + e] * c1 + bf(t, kin0 + e, kq[e]); }
                }
                const bool masked = nm(t, sub);
                if (masked) {
#pragma unroll
                    for (int v = 0; v < 16; ++v) { const int kin = sub * 32 + crow(v, hi); if (!vf(t, kin)) s[v] = NEGB; }
                }
                if (MODE == 2) {
                    if (masked) {
#pragma unroll
                        for (int v = 0; v < 16; ++v) s[v] = s[v] > -1e29f ? fast_exp2(s[v] - m) * l : 0.f;
                    } else {
#pragma unroll
                        for (int v = 0; v < 16; ++v) s[v] = fast_exp2(s[v] - m) * l;
                    }
                    cb(t, sub, s);
                    pv_sub<DV / 32>(o, curv, VS, sub, s, r32, hi);
                } else {
                    float mx0 = fmaxf(fmaxf(s[0], s[1]), s[2]), mx1 = fmaxf(fmaxf(s[3], s[4]), s[5]);
                    mx0 = fmaxf(fmaxf(mx0, s[6]), s[7]); mx1 = fmaxf(fmaxf(mx1, s[8]), s[9]); mx0 = fmaxf(fmaxf(mx0, s[10]), s[11]); mx1 = fmaxf(fmaxf(mx1, s[12]), s[13]);
                    float mx = fmaxf(fmaxf(mx0, mx1), fmaxf(s[14], s[15]));
                    mx = xhalf_max(mx);
                    const float mn = fmaxf(m, mx); float sum = 0.f;
                    if (masked) {
#pragma unroll
                        for (int v = 0; v < 16; ++v) { const float p = s[v] > -1e29f ? fast_exp2(s[v] - mn) : 0.f; s[v] = p; sum += p; }
                    } else {
#pragma unroll
                        for (int v = 0; v < 16; ++v) { const float p = fast_exp2(s[v] - mn); s[v] = p; sum += p; }
                    }
                    if (__any(mn > m)) {
                        const float alpha = fast_exp2(m - mn); l *= alpha;
                        if (MODE == 0) {
#pragma unroll
                            for (int i = 0; i < DV / 32; ++i)
#pragma unroll
                                for (int v = 0; v < 16; ++v) o[i][v] *= alpha;
                        }
                    }
                    l += sum; m = mn;
                    if (MODE == 0) pv_sub<DV / 32>(o, curv, VS, sub, s, r32, hi);
                }
            }
        }
    };
    if (DEFER) {
        FA_LOAD(0, kregA, vregA, pregA); FA_STORE(0, kregA, vregA, pregA); __syncthreads();
        for (int t = 0; t < nt; ++t) {
            asm volatile("" : "+v"(tid));
            if (t + 1 < nt) FA_LOAD(t + 1, kregA, vregA, pregA);
            compute(t, 0);
            asm volatile("" : "+v"(tid));
            if (t + 1 < nt) FA_STORE(t + 1, kregA, vregA, pregA);
            __syncthreads();
        }
    } else {
    FA_LOAD(0, kregA, vregA, pregA); FA_STORE(0, kregA, vregA, pregA); if (nt > 1) FA_LOAD(1, kregB, vregB, pregB); __syncthreads();
    for (int t = 0; t < nt; t += 2) {
        if (t + 2 < nt) FA_LOAD(t + 2, kregA, vregA, pregA);
        compute(t, 0);
        if (t + 1 < nt) FA_STORE(t + 1, kregB, vregB, pregB);
        __syncthreads();
        if (t + 1 < nt) {
            if (t + 3 < nt) FA_LOAD(t + 3, kregB, vregB, pregB);
            compute(t + 1, 1);
            if (t + 2 < nt) FA_STORE(t + 2, kregA, vregA, pregA);
            __syncthreads();
        }
    }
    }
    if (DEFER) { if (pend >= 0) { const LAS unsigned char* pv_ = lds + VOFF + pend * (DV * VS); pv_packed<DV / 32>(o, pv_, VS, 0, pp0, pp1, r32, hi); pv_packed<DV / 32>(o, pv_, VS, 1, pp2, pp3, r32, hi); }
        __syncthreads(); }
#undef FA_LOAD
#undef FA_STORE
}
template <int NV>
__device__ __forceinline__ void store_o(bf16* op, const f32x16 (&o)[NV], float sc, int hi) {
#pragma unroll
    for (int i = 0; i < NV; ++i)
#pragma unroll
        for (int a = 0; a < 4; ++a) {
            u32x2 wv; wv.x = cvt_pk_bf16(o[i][4 * a] * sc, o[i][4 * a + 1] * sc); wv.y = cvt_pk_bf16(o[i][4 * a + 2] * sc, o[i][4 * a + 3] * sc);
            *(u32x2*)(op + 32 * i + 8 * a + 4 * hi) = wv;
        }
}
struct NoCb { __device__ __forceinline__ void operator()(int, int, const f32x16&) const {} };

__device__ __forceinline__ void mla_unit(const KP& P, LAS unsigned char* lds, int b, int h, int qb, int tid_u) {
    int tid = tid_u; asm volatile("" : "+v"(tid));
    const int* const posp = P.pos_local();
    const int lane = tid & 63, w = __builtin_amdgcn_readfirstlane(tid >> 6), r32 = lane & 31, hi = lane >> 5;
    const int q0 = qb * 256, tq = q0 + 32 * w + r32; const size_t bS = (size_t)b * SEQ, tok = bS + tq;
    bf16x8 qf[6];
#pragma unroll
    for (int dk = 0; dk < 6; ++dk) qf[dk] = *(const bf16x8*)(P.QM() + tok * 768 + h * 96 + dk * 16 + hi * 8);
    const int nt = (q0 + 256) / 64;
    auto ka = [&](int t, int row, int ch) -> const bf16* { const size_t tk = bS + 64 * t + row; return ch < 8 ? P.KN() + tk * 512 + h * 64 + ch * 8 : P.KROT() + tk * 32 + (ch - 8) * 8; };
    auto va = [&](int t, int d, int ch) -> const bf16* { return P.VMT() + (size_t)(h * 64 + d) * T + bS + 64 * t + ch * 8; };
    auto pf = [&](int, int) -> float { return 0.f; };
    auto bf = [&](int, int, float) -> float { return 0.f; };
    auto vf = [&](int t, int kin) -> bool { return 64 * t + kin <= tq; };
    const int wq_lo = q0 + 32 * w, wq_hi = wq_lo + 31;
    auto nm = [&](int t, int sub) -> bool { return 64 * t + 32 * sub + 31 > wq_lo; };
    auto ws = [&](int t, int sub) -> bool { return 64 * t + 32 * sub > wq_hi; };
    float m = NEGB, l = 0.f; f32x16 o[2];
#pragma unroll
    for (int i = 0; i < 2; ++i)
#pragma unroll
        for (int v = 0; v < 16; ++v) o[i][v] = 0.f;
    fa_loop<96, 64, 0, false, true, false>(lds, nt, ka, va, pf, bf, vf, nm, ws, NoCb(), 1.f, qf, m, l, o, tid, r32, hi);
    l = xhalf_sum(l); const float inv = l > 0.f ? 1.f / l : 0.f;
    store_o<2>(P.OE() + tok * 1024 + h * 64, o, inv, hi);
}

constexpr int NSA_GL = 40960, NSA_SELM = NSA_GL + 8 * 2 * 8 * 132 * 4, NSA_BU = NSA_SELM + 1024, NSA_TL = NSA_BU + 32;
__device__ __forceinline__ void nsa_unit(const KP& P, LAS unsigned char* lds, int b, int c, int g, int tid_u) {
    int tid = tid_u; asm volatile("" : "+v"(tid));
    const int* const posp = P.pos_local();
    const int lane = tid & 63, w = __builtin_amdgcn_readfirstlane(tid >> 6), r32 = lane & 31, hi = lane >> 5;
    const int n = r32 >> 3, qi = r32 & 7, hh = g * 4 + n;
    const int tq = 64 * c + 8 * w + qi; const size_t bS = (size_t)b * SEQ, tok = bS + tq;
    const float slope2 = fast_exp2(-(float)(hh + 1)) * LOG2E, c1 = 0.125f * LOG2E;
    const float pq = (float)posp[tok], nbq = -slope2 * pq;
    bf16x8 qf[4];
#pragma unroll
    for (int dk = 0; dk < 4; ++dk) qf[dk] = *(const bf16x8*)(P.HE() + tok * HE_LD + HE_Q + hh * 64 + dk * 16 + hi * 8);
    LAS float* GLw = (LAS float*)(lds + NSA_GL) + w * (2 * 8 * 132);
    LAS unsigned long long* SELM = (LAS unsigned long long*)(lds + NSA_SELM);
    LAS unsigned* BU = (LAS unsigned*)(lds + NSA_BU);
    LAS int* TL = (LAS int*)(lds + NSA_TL);
    for (int i = tid; i < 8 * 2 * 8 * 132; i += 512) ((LAS float*)(lds + NSA_GL))[i] = 0.f;
    if (tid < 8) BU[tid] = 0u;
    __syncthreads();
    const int wq_lo = 64 * c + 8 * w, wq_hi = wq_lo + 7;
    f32x16 o[2];
#pragma unroll
    for (int i = 0; i < 2; ++i)
#pragma unroll
        for (int v = 0; v < 16; ++v) o[i][v] = 0.f;
    LAS float* stash = (LAS float*)(lds + NSA_GL) + tid;
    {
        const int nt1 = (4 * c + 3 + 63) >> 6;
        auto ka1 = [&](int t, int row, int ch) -> const bf16* { return P.KCC() + ((size_t)b * 512 + 64 * t + row) * 128 + g * 64 + ch * 8; };
        auto va1 = [&](int t, int d, int ch) -> const bf16* { return P.VCT() + (size_t)(g * 64 + d) * 8192 + b * 512 + 64 * t + ch * 8; };
        auto pf1 = [&](int t, int i) -> float { int j = 64 * t + i; j = j > 510 ? 510 : j; return (float)posp[bS + 31 + 16 * j]; };
        auto bf1 = [&](int, int, float kp) -> float { return kp * slope2 + nbq; };
        auto vf1 = [&](int t, int kin) -> bool { const int j = 64 * t + kin; return 16 * j + 31 <= tq; };
        auto nm1 = [&](int t, int sub) -> bool { return 16 * (64 * t + 32 * sub + 31) + 31 > wq_lo; };
        auto ws1 = [&](int t, int sub) -> bool { return 16 * (64 * t + 32 * sub) + 31 > wq_hi; };
        float m1 = NEGB, l1 = 0.f;
        fa_loop<64, 64, 1, true, false, false>(lds, nt1, ka1, va1, pf1, bf1, vf1, nm1, ws1, NoCb(), c1, qf, m1, l1, o, tid, r32, hi);
        l1 = xhalf_sum(l1); float invl = l1 > 0.f ? 1.f / l1 : 0.f;
        auto cb1 = [&](int t, int sub, const f32x16& p) {
#pragma unroll
            for (int a = 0; a < 4; ++a) {
                float gsum = (p[4 * a] + p[4 * a + 1]) + (p[4 * a + 2] + p[4 * a + 3]), last = p[4 * a + 3];
                gsum += __shfl_xor(gsum, 8); gsum += __shfl_xor(gsum, 16); last += __shfl_xor(last, 8); last += __shfl_xor(last, 16);
                const int u = (64 * t + 32 * sub) / 4 + 2 * a + hi;
                if (r32 < 8) { GLw[qi * 132 + u] = gsum; GLw[8 * 132 + qi * 132 + u + 1] = last; }
            }
        };
        fa_loop<64, 64, 2, true, false, false>(lds, nt1, ka1, va1, pf1, bf1, vf1, nm1, ws1, cb1, c1, qf, m1, invl, o, tid, r32, hi);
        const float gtc = P.GT()[tok * 24 + hh];
#pragma unroll
        for (int i = 0; i < 2; ++i)
#pragma unroll
            for (int v = 0; v < 16; ++v) o[i][v] *= gtc;
    }
    unsigned long long wu0 = 0ull, wu1 = 0ull;
    {
        const int ncand = c - 1 > 0 ? c - 1 : 0, need = 16 - (c == 0 ? 1 : 2);
        for (int q = 0; q < 8; ++q) {
            const int s0 = lane, s1 = lane + 64;
            const bool c0 = (s0 >= 1) && (s0 <= c - 1), cc1 = (s1 <= c - 1);
            const float f0 = c0 ? GLw[q * 132 + s0] + GLw[8 * 132 + q * 132 + s0] : 0.f;
            const float f1 = cc1 ? GLw[q * 132 + s1] + GLw[8 * 132 + q * 132 + s1] : 0.f;
            const unsigned b0 = __float_as_uint(f0), b1 = __float_as_uint(f1);
            unsigned long long sel0, sel1;
            if (ncand <= need) { sel0 = __ballot(c0); sel1 = __ballot(cc1); }
            else {
                unsigned x = 0u;
                for (int bit = 30; bit >= 0; --bit) {
                    const unsigned tt = x | (1u << bit);
                    const int cnt = __popcll(__ballot(c0 && b0 >= tt)) + __popcll(__ballot(cc1 && b1 >= tt));
                    if (cnt >= need) x = tt;
                }
                sel0 = __ballot(c0 && b0 > x); sel1 = __ballot(cc1 && b1 > x);
                int rem = need - (__popcll(sel0) + __popcll(sel1));
                unsigned long long e0 = __ballot(c0 && b0 == x), e1 = __ballot(cc1 && b1 == x);
                while (rem > 0 && e0) { const unsigned long long low = e0 & (~e0 + 1ull); sel0 |= low; e0 ^= low; --rem; }
                while (rem > 0 && e1) { const unsigned long long low = e1 & (~e1 + 1ull); sel1 |= low; e1 ^= low; --rem; }
            }
            sel0 |= 1ull; if (c < 64) sel0 |= 1ull << c; else sel1 |= 1ull << (c - 64);
            if (lane == 0) { SELM[(w * 8 + q) * 2] = sel0; SELM[(w * 8 + q) * 2 + 1] = sel1; }
            wu0 |= sel0; wu1 |= sel1;
        }
        if (lane == 0) { atomicOr((unsigned*)&BU[0], (unsigned)wu0); atomicOr((unsigned*)&BU[1], (unsigned)(wu0 >> 32)); atomicOr((unsigned*)&BU[2], (unsigned)wu1); atomicOr((unsigned*)&BU[3], (unsigned)(wu1 >> 32)); }
    }
    __syncthreads();
#pragma unroll
    for (int i = 0; i < 2; ++i)
#pragma unroll
        for (int v = 0; v < 16; ++v) { stash[(i * 16 + v) * 512] = o[i][v]; o[i][v] = 0.f; }
    if (tid < 128) {
        const unsigned u0 = BU[0], u1 = BU[1], u2 = BU[2], u3 = BU[3];
        const int k = tid >> 5; const unsigned wk = k == 0 ? u0 : (k == 1 ? u1 : (k == 2 ? u2 : u3));
        if ((wk >> (tid & 31)) & 1u) {
            int pos = __popc(wk & ((1u << (tid & 31)) - 1u));
            if (k > 0) pos += __popc(u0); if (k > 1) pos += __popc(u1); if (k > 2) pos += __popc(u2);
            TL[pos] = tid;
        }
        if (tid == 0) BU[4] = __popc(u0) + __popc(u1) + __popc(u2) + __popc(u3);
    }
    __syncthreads();
    const unsigned long long ms0 = SELM[(w * 8 + qi) * 2], ms1 = SELM[(w * 8 + qi) * 2 + 1];
    {
        const int nsel = (int)BU[4];
        auto ka2 = [&](int t, int row, int ch) -> const bf16* { const int sb = TL[t]; return P.HE() + (bS + 64 * sb + row) * HE_LD + HE_KS + g * 64 + ch * 8; };
        auto va2 = [&](int t, int d, int ch) -> const bf16* { const int sb = TL[t]; return P.VT() + (size_t)(g * 64 + d) * T + bS + 64 * sb + ch * 8; };
        auto pf2 = [&](int t, int i) -> float { const int sb = TL[t]; return (float)posp[bS + 64 * sb + i]; };
        auto bf2 = [&](int, int, float kp) -> float { return kp * slope2 + nbq; };
        auto vf2 = [&](int t, int kin) -> bool { const int sb = TL[t]; const bool selb = (((sb < 64 ? ms0 : ms1) >> (sb & 63)) & 1ull) != 0ull; return selb && (64 * sb + kin <= tq); };
        auto nm2 = [&](int t, int) -> bool { const int sb = TL[t]; const bool selb = (((sb < 64 ? ms0 : ms1) >> (sb & 63)) & 1ull) != 0ull; return sb == c || !__all(selb); };
        auto ws2 = [&](int t, int) -> bool { const int sb = TL[t]; return (((sb < 64 ? wu0 : wu1) >> (sb & 63)) & 1ull) == 0ull; };
        float m2 = NEGB, l2 = 0.f;
        fa_loop<64, 64, 0, true, false, false>(lds, nsel, ka2, va2, pf2, bf2, vf2, nm2, ws2, NoCb(), c1, qf, m2, l2, o, tid, r32, hi);
        l2 = xhalf_sum(l2); const float gts = P.GT()[tok * 24 + 8 + hh]; const float sc = l2 > 0.f ? gts / l2 : 0.f;
#pragma unroll
        for (int i = 0; i < 2; ++i)
#pragma unroll
            for (int v = 0; v < 16; ++v) { stash[(i * 16 + v) * 512] += o[i][v] * sc; o[i][v] = 0.f; }
    }
    {
        const int first = c < 8 ? 8 - c : 0, nt3 = 9 - first, base3 = 64 * c - 512 + 64 * first;
        auto ka3 = [&](int t, int row, int ch) -> const bf16* { return P.HE() + (bS + base3 + 64 * t + row) * HE_LD + HE_KW + g * 64 + ch * 8; };
        auto va3 = [&](int t, int d, int ch) -> const bf16* { return P.VT() + (size_t)(128 + g * 64 + d) * T + bS + base3 + 64 * t + ch * 8; };
        auto pf3 = [&](int t, int i) -> float { return (float)posp[bS + base3 + 64 * t + i]; };
        auto bf3 = [&](int, int, float kp) -> float { return kp * slope2 + nbq; };
        auto vf3 = [&](int t, int kin) -> bool { const int df = tq - (base3 + 64 * t + kin); return df >= 0 && df < 512; };
        auto nm3 = [&](int t, int sub) -> bool { const int k0 = base3 + 64 * t + 32 * sub; return k0 + 31 > wq_lo || k0 < wq_hi - 511; };
        auto ws3 = [&](int t, int sub) -> bool { const int k0 = base3 + 64 * t + 32 * sub; return k0 > wq_hi || k0 + 31 < wq_lo - 511; };
        float m3 = NEGB, l3 = 0.f;
        fa_loop<64, 64, 0, true, false, false>(lds, nt3, ka3, va3, pf3, bf3, vf3, nm3, ws3, NoCb(), c1, qf, m3, l3, o, tid, r32, hi);
        l3 = xhalf_sum(l3); const float gtw = P.GT()[tok * 24 + 16 + hh]; const float sc = l3 > 0.f ? gtw / l3 : 0.f;
#pragma unroll
        for (int i = 0; i < 2; ++i)
#pragma unroll
            for (int v = 0; v < 16; ++v) o[i][v] = o[i][v] * sc + stash[(i * 16 + v) * 512];
    }
    store_o<2>(P.OE() + tok * 1024 + 512 + hh * 64, o, 1.f, hi);
}

__device__ __forceinline__ void dil_unit(const KP& P, LAS unsigned char* lds, int b, int g, int h, int rj, int tid_u) {
    int tid = tid_u; asm volatile("" : "+v"(tid));
    const int* const posp = P.pos_local();
    const int lane = tid & 63, w = __builtin_amdgcn_readfirstlane(tid >> 6), r32 = lane & 31, hi = lane >> 5;
    const int dil = g == 0 ? 1 : (g == 1 ? 4 : 16), per = 32 / dil, r = rj / per, jt = rj % per, clen = SEQ / dil;
    const int J = 256 * jt + 32 * w + r32; const size_t bS = (size_t)b * SEQ, tok = bS + r + dil * J;
    const float slope2 = fast_exp2(-8.f * (float)(g * 4 + h + 1) / 12.f) * LOG2E, c1 = 0.08838834764831845f * LOG2E;
    const float pq = (float)posp[tok], nbq = -slope2 * pq;
    bf16x8 qf[8];
#pragma unroll
    for (int dk = 0; dk < 8; ++dk) qf[dk] = *(const bf16x8*)(P.QK() + tok * 3072 + g * 512 + h * 128 + dk * 16 + hi * 8);
    const int first = jt == 0 ? 2 : 0, nt = 6 - first, I00 = 256 * jt - 128 + 64 * first;
    auto ka = [&](int t, int row, int ch) -> const bf16* { return P.QK() + (bS + r + (size_t)dil * (I00 + 64 * t + row)) * 3072 + 1536 + g * 512 + h * 128 + ch * 8; };
    auto va = [&](int t, int d, int ch) -> const bf16* { return P.VOT() + (size_t)(g * 512 + h * 128 + d) * T + bS + (size_t)r * clen + I00 + 64 * t + ch * 8; };
    auto pf = [&](int t, int i) -> float { return (float)posp[bS + r + dil * (I00 + 64 * t + i)]; };
    auto bf = [&](int, int, float kp) -> float { return kp * slope2 + nbq; };
    auto vf = [&](int t, int kin) -> bool { const int df = J - (I00 + 64 * t + kin); return df >= 0 && df <= 128; };
    const int Jw = 256 * jt + 32 * w;
    auto nm = [&](int t, int sub) -> bool { const int i0 = I00 + 64 * t + 32 * sub; return i0 + 31 > Jw || i0 < Jw + 31 - 128; };
    auto ws = [&](int t, int sub) -> bool { const int i0 = I00 + 64 * t + 32 * sub; return i0 > Jw + 31 || i0 + 31 < Jw - 128; };
    float m = NEGB, l = 0.f; f32x16 o[4];
#pragma unroll
    for (int i = 0; i < 4; ++i)
#pragma unroll
        for (int v = 0; v < 16; ++v) o[i][v] = 0.f;
    fa_loop<128, 128, 0, true, false, false>(lds, nt, ka, va, pf, bf, vf, nm, ws, NoCb(), c1, qf, m, l, o, tid, r32, hi);
    l = xhalf_sum(l); const float inv = l > 0.f ? 1.f / l : 0.f;
    store_o<4>(P.OG() + ((size_t)g * T + tok) * 512 + h * 128, o, inv, hi);
    if (hi == 0) P.LSE()[((size_t)g * T + tok) * 4 + h] = m + __log2f(l);
}
struct Args { const float* in[28]; float* out; unsigned char* ws; int ph_lo, ph_hi; };

enum { WM_ID = 0, WM_SWIGLU = 1, WM_E1 = 2, WM_E2 = 3, WM_UQ = 4 };
struct WSpec { const float* W; const float* W2; const float* gk; bf16* WT; int K, Nsrc, Ndst, mode, soff, nvalid; };
__device__ __forceinline__ void transpose_item(const WSpec& s, LAS float* scr, int item, int lane) {
    const int nblk = s.Ndst / 32, kb = item / nblk, nb = item % nblk, k0 = 128 * kb, n0 = 32 * nb;
    const int R = n0 + (lane & 31); int sc; const float* Wp = s.W;
    if (s.mode == WM_ID) sc = R < s.nvalid ? R + s.soff : -1;
    else if (s.mode == WM_SWIGLU) { sc = (R >> 8) * 128 + (R & 127); if ((R >> 7) & 1) Wp = s.W2; }
    else if (s.mode == WM_E1) sc = R < 1568 ? R : (R < 1696 ? R + 128 : (R < 1720 ? R + 256 : -1));
    else if (s.mode == WM_E2) sc = R < 128 ? 1568 + R : 1824 + (R - 128);
    else { const int h = R / 96, wq = R % 96; if (wq < 64) sc = R; else { const int p = wq - 64, fq = p >> 3, sub = p & 7; sc = 96 * h + 64 + (sub < 4 ? 4 * fq + sub : 16 + 4 * fq + (sub - 4)); } }
    if (s.mode != WM_UQ) {
        const int c4 = (lane & 7) * 4, R4 = n0 + c4; int sc4; const float* Wq = s.W;
        if (s.mode == WM_ID) sc4 = R4 < s.nvalid ? R4 + s.soff : -1;
        else if (s.mode == WM_SWIGLU) { sc4 = (R4 >> 8) * 128 + (R4 & 127); if ((R4 >> 7) & 1) Wq = s.W2; }
        else if (s.mode == WM_E1) sc4 = R4 < 1568 ? R4 : (R4 < 1696 ? R4 + 128 : (R4 < 1720 ? R4 + 256 : -1));
        else sc4 = R4 < 128 ? 1568 + R4 : 1824 + (R4 - 128);
        const float msk = sc4 >= 0 ? 1.f : 0.f; const int sc4c = sc4 >= 0 ? sc4 : 0;
        f32x4 vv[16];
#pragma unroll
        for (int i = 0; i < 16; ++i) { const int kk = 8 * i + (lane >> 3); vv[i] = *(const f32x4*)(Wq + (size_t)(k0 + kk) * s.Nsrc + sc4c); }
        if (s.gk) {
#pragma unroll
            for (int i = 0; i < 16; ++i) { const int kk = 8 * i + (lane >> 3); vv[i] = vv[i] * s.gk[k0 + kk]; }
        }
#pragma unroll
        for (int i = 0; i < 16; ++i) { const int kk = 8 * i + (lane >> 3); const f32x4 v = vv[i] * msk;
            scr[kk * 33 + c4] = v[0]; scr[kk * 33 + c4 + 1] = v[1]; scr[kk * 33 + c4 + 2] = v[2]; scr[kk * 33 + c4 + 3] = v[3]; }
    } else {
        float vs[64];
#pragma unroll
        for (int i = 0; i < 64; ++i) { const int kk = 2 * i + (lane >> 5); vs[i] = Wp[(size_t)(k0 + kk) * s.Nsrc + sc]; }
#pragma unroll
        for (int i = 0; i < 64; ++i) { const int kk = 2 * i + (lane >> 5); scr[kk * 33 + (lane & 31)] = vs[i] * s.gk[k0 + kk]; }
    }
    asm volatile("s_waitcnt lgkmcnt(0)" ::: "memory");
    const int c = lane & 15;
#pragma unroll
    for (int j = 0; j < 8; ++j) { const int nn = (lane >> 4) + 4 * j; const LAS float* sp = scr + (8 * c) * 33 + nn;
        u32x4 o; o.x = cvt_pk_bf16(sp[0 * 33], sp[1 * 33]); o.y = cvt_pk_bf16(sp[2 * 33], sp[3 * 33]); o.z = cvt_pk_bf16(sp[4 * 33], sp[5 * 33]); o.w = cvt_pk_bf16(sp[6 * 33], sp[7 * 33]);
        *(u32x4*)(s.WT + (size_t)(n0 + nn) * s.K + k0 + 8 * c) = o; }
    asm volatile("s_waitcnt lgkmcnt(0)" ::: "memory");
}
__device__ __forceinline__ const float* ffn_w(const Args& a, int f, int which) {
    const int L = f >> 1; const bool second = (f & 1) != 0;
    const float* base = which == 0 ? (second ? a.in[23] : a.in[4]) : (which == 1 ? (second ? a.in[24] : a.in[5]) : (second ? a.in[25] : a.in[6]));
    return base + (size_t)L * 1024 * 2816;
}
__device__ __forceinline__ void p0_prologue(const Args& a, const KP& P, LAS unsigned char* lds, int tid, int gw, int NGW) {
    const int lane = tid & 63, w = tid >> 6;
    LAS float* scr = (LAS float*)(lds + w * 17408);
    int cum = 0;
    for (int wi = 0; wi < 21; ++wi) {
        WSpec s; s.W2 = nullptr; s.gk = nullptr; s.mode = WM_ID; s.soff = 0;
        if (wi < 4) { s.W = ffn_w(a, wi, 0); s.W2 = ffn_w(a, wi, 1); s.K = 1024; s.Nsrc = 2816; s.Ndst = 5632; s.mode = WM_SWIGLU; s.WT = P.WB() + WE_GU + (size_t)wi * 5632 * 1024; }
        else if (wi < 8) { s.W = ffn_w(a, wi - 4, 2); s.K = 2816; s.Nsrc = 1024; s.Ndst = 1024; s.WT = P.WB() + WE_D + (size_t)(wi - 4) * 1024 * 2816; }
        else if (wi == 8) { s.W = a.in[7]; s.K = 1024; s.Nsrc = 1976; s.Ndst = 1792; s.mode = WM_E1; s.WT = P.WB() + WE_E1; }
        else if (wi == 9) { s.W = a.in[7]; s.K = 1024; s.Nsrc = 1976; s.Ndst = 256; s.mode = WM_E2; s.WT = P.WB() + WE_E2; }
        else if (wi == 10) { s.W = a.in[10]; s.gk = a.in[8]; s.K = 384; s.Nsrc = 768; s.Ndst = 768; s.mode = WM_UQ; s.WT = P.WB() + WE_UQ; }
        else if (wi == 11) { s.W = a.in[11]; s.gk = a.in[9]; s.K = 256; s.Nsrc = 512; s.Ndst = 512; s.WT = P.WB() + WE_UK; }
        else if (wi == 12) { s.W = a.in[12]; s.gk = a.in[9]; s.K = 256; s.Nsrc = 512; s.Ndst = 512; s.WT = P.WB() + WE_UV; }
        else if (wi == 13) { s.W = a.in[14]; s.K = 2048; s.Nsrc = 256; s.Ndst = 256; s.WT = P.WB() + WE_C1K; }
        else if (wi == 14) { s.W = a.in[16]; s.K = 2048; s.Nsrc = 256; s.Ndst = 256; s.WT = P.WB() + WE_C1V; }
        else if (wi == 15) { s.W = a.in[15]; s.K = 256; s.Nsrc = 64; s.Ndst = 256; s.WT = P.WB() + WE_C2K; }
        else if (wi == 16) { s.W = a.in[17]; s.K = 256; s.Nsrc = 64; s.Ndst = 256; s.WT = P.WB() + WE_C2V; }
        else if (wi == 17) { s.W = a.in[18]; s.K = 1024; s.Nsrc = 1024; s.Ndst = 1024; s.WT = P.WB() + WE_OE; }
        else if (wi == 18) { s.W = a.in[19]; s.K = 1024; s.Nsrc = 4608; s.Ndst = 3072; s.WT = P.WB() + WE_O1; }
        else if (wi == 19) { s.W = a.in[19]; s.K = 1024; s.Nsrc = 4608; s.Ndst = 1536; s.soff = 3072; s.WT = P.WB() + WE_O2; }
        else { s.W = a.in[20]; s.K = 512; s.Nsrc = 1024; s.Ndst = 1024; s.WT = P.WB() + WE_OO; }
        s.nvalid = (wi == 15 || wi == 16) ? 64 : s.Ndst;
        const int nitems = (s.K / 128) * (s.Ndst / 32);
        { int it0 = (gw - cum) % NGW; if (it0 < 0) it0 += NGW; for (int it = it0; it < nitems; it += NGW) transpose_item(s, scr, it, lane); cum = (cum + nitems) % NGW; }
    }
    { const float* x = a.in[0]; const size_t n8 = (size_t)T * DM / 8; const size_t gt = (size_t)gw * 64 + lane, NT_ = (size_t)NGW * 64;
#pragma unroll 4
      for (size_t i = gt; i < n8; i += NT_) { const f32x4 v0 = *(const f32x4*)(x + i * 8), v1 = *(const f32x4*)(x + i * 8 + 4);
          u32x4 o; o.x = cvt_pk_bf16(v0[0], v0[1]); o.y = cvt_pk_bf16(v0[2], v0[3]); o.z = cvt_pk_bf16(v1[0], v1[1]); o.w = cvt_pk_bf16(v1[2], v1[3]); *(u32x4*)(P.XB() + i * 8) = o; } }
    if (gw < 512) { const int kv = gw >> 8, nn = gw & 255; const float* w1 = kv ? a.in[16] : a.in[14]; const float* cp = a.in[13]; float sacc = 0.f;
        for (int i = 0; i < 32; ++i) { const int kk = lane + 64 * i; sacc += cp[kk] * w1[(size_t)kk * 256 + nn]; }
        sacc = wave_sum(sacc); if (lane == 0) P.CB()[kv * 256 + nn] = sacc; }
    if (gw == 0) { P.CTL()[lane] = 0u; if (lane < 28) ((const float**)(P.ws + WS_PT))[lane] = a.in[lane]; }
}
__device__ __forceinline__ void ln_pass(const KP& P, const float* gam, const float* bet, bool write_x, int lane, int gw, int NGW) {
    float* ST = (float*)(P.ws + WS_ST);
    f32x4 gv[4], bv[4];
#pragma unroll
    for (int j = 0; j < 4; ++j) { gv[j] = *(const f32x4*)(gam + 4 * lane + 256 * j); bv[j] = *(const f32x4*)(bet + 4 * lane + 256 * j); }
    for (int row = gw; row < T; row += 2 * NGW) {
        const int row2 = row + NGW; const bool has2 = row2 < T;
        float* xr = P.out + (size_t)row * DM + 4 * lane; float* xr2 = P.out + (size_t)(has2 ? row2 : row) * DM + 4 * lane;
        f32x4 v[4], u[4]; float s = 0.f, t = 0.f;
#pragma unroll
        for (int j = 0; j < 4; ++j) { v[j] = *(const f32x4*)(xr + 256 * j); u[j] = *(const f32x4*)(xr2 + 256 * j); }
#pragma unroll
        for (int j = 0; j < 4; ++j) { s += (v[j][0] + v[j][1]) + (v[j][2] + v[j][3]); t += (u[j][0] + u[j][1]) + (u[j][2] + u[j][3]); }
        const float mean = wave_sum(s) * (1.f / DM), mean2 = wave_sum(t) * (1.f / DM); float s2 = 0.f, t2 = 0.f;
#pragma unroll
        for (int j = 0; j < 4; ++j) { v[j] = v[j] - mean; s2 += (v[j][0] * v[j][0] + v[j][1] * v[j][1]) + (v[j][2] * v[j][2] + v[j][3] * v[j][3]);
                                      u[j] = u[j] - mean2; t2 += (u[j][0] * u[j][0] + u[j][1] * u[j][1]) + (u[j][2] * u[j][2] + u[j][3] * u[j][3]); }
        const float rstd = 1.f / sqrtf(wave_sum(s2) * (1.f / DM) + 1e-5f), rstd2 = 1.f / sqrtf(wave_sum(t2) * (1.f / DM) + 1e-5f);
        bf16* xb = P.XB() + (size_t)row * DM + 4 * lane; bf16* xb2 = P.XB() + (size_t)row2 * DM + 4 * lane;
#pragma unroll
        for (int j = 0; j < 4; ++j) { const f32x4 y = v[j] * rstd * gv[j] + bv[j]; if (write_x) *(f32x4*)(xr + 256 * j) = y;
            u32x2 o; o.x = cvt_pk_bf16(y[0], y[1]); o.y = cvt_pk_bf16(y[2], y[3]); *(u32x2*)(xb + 256 * j) = o; }
        if (lane == 0) { ST[2 * row] = mean; ST[2 * row + 1] = rstd; if (has2) { ST[2 * row2] = mean2; ST[2 * row2 + 1] = rstd2; } }
        if (has2) {
#pragma unroll
            for (int j = 0; j < 4; ++j) { const f32x4 y = u[j] * rstd2 * gv[j] + bv[j]; if (write_x) *(f32x4*)(xr2 + 256 * j) = y;
                u32x2 o; o.x = cvt_pk_bf16(y[0], y[1]); o.y = cvt_pk_bf16(y[2], y[3]); *(u32x2*)(xb2 + 256 * j) = o; }
        }
    }
}
__device__ __forceinline__ void small_pass(const KP& P, int lane, int gw, int NGW) {
    constexpr int NR = 4;
    const int lq = lane < 48 ? lane : 47, lg = lane < 32 ? 0 : (lane < 56 ? lane - 32 : 23);
    double inv = 1.0; for (int k = 0; k < (lane & 15); ++k) inv *= 0.5623413251903491;
    for (int tok0 = gw; tok0 < T; tok0 += NR * NGW) {
        u32x4 cq[NR], ck[NR]; bf16 p1[NR], p2[NR], gl[NR]; int ps[NR];
#pragma unroll
        for (int r = 0; r < NR; ++r) { const int tok = tok0 + r * NGW < T ? tok0 + r * NGW : tok0; const bf16* he = P.HE() + (size_t)tok * HE_LD;
            cq[r] = *(const u32x4*)(he + lq * 8); ck[r] = *(const u32x4*)(he + HE_CKV + (lane & 31) * 8);
            p1[r] = he[HE_KPE + (lane & 15)]; p2[r] = he[HE_KPE + 16 + (lane & 15)]; gl[r] = he[HE_GT + lg]; ps[r] = P.pos[tok]; }
#pragma unroll
        for (int r = 0; r < NR; ++r) {
            const int tok = tok0 + r * NGW; float sq = 0.f, skv = 0.f;
#pragma unroll
            for (int e2 = 0; e2 < 4; ++e2) { const float a0 = __uint_as_float(cq[r][e2] << 16), a1 = __uint_as_float(cq[r][e2] & 0xffff0000u); sq += a0 * a0 + a1 * a1;
                                             const float b0 = __uint_as_float(ck[r][e2] << 16), b1 = __uint_as_float(ck[r][e2] & 0xffff0000u); skv += b0 * b0 + b1 * b1; }
            sq = wave_sum(lane < 48 ? sq : 0.f); skv = wave_sum(lane < 32 ? skv : 0.f);
            if (tok < T) {
                if (lane == 0) { P.RSTD()[tok] = 1.f / sqrtf(sq * (1.f / 384.f) + 1e-6f); P.RSTD()[T + tok] = 1.f / sqrtf(skv * (1.f / 256.f) + 1e-6f); }
                if (lane < 16) {
                    const double rev = (double)ps[r] * inv * 0.15915494309189535; const float fr = (float)(rev - floor(rev));
                    const float sn = __builtin_amdgcn_sinf(fr), cs = __builtin_amdgcn_cosf(fr);
                    P.RT()[(size_t)tok * 32 + 2 * lane] = cs; P.RT()[(size_t)tok * 32 + 2 * lane + 1] = sn;
                    const float x1 = bf2f(p1[r]), x2 = bf2f(p2[r]);
                    const int q1 = 8 * (lane >> 2) + (lane & 3);
                    const unsigned o1 = cvt_pk_bf16(x1 * cs - x2 * sn, 0.f), o2 = cvt_pk_bf16(x2 * cs + x1 * sn, 0.f);
                    P.KROT()[(size_t)tok * 32 + q1] = (bf16)(o1 & 0xffffu); P.KROT()[(size_t)tok * 32 + q1 + 4] = (bf16)(o2 & 0xffffu);
                }
                if (lane >= 32 && lane < 56) { const float x = bf2f(gl[r]); P.GT()[(size_t)tok * 24 + (lane - 32)] = fast_rcp(1.f + fast_exp2(-LOG2E * x)); }
            }
        }
    }
}
__device__ __forceinline__ void merge_pass(const KP& P, int lane, int gw, int NGW) {
    const size_t n = (size_t)T * 64, gt = (size_t)gw * 64 + lane, NT_ = (size_t)NGW * 64;
    for (size_t idx = gt; idx < n; idx += NT_) {
        const size_t tok = idx >> 6; const int col = (int)(idx & 63) * 8, h = col >> 7;
        const float l0 = P.LSE()[tok * 4 + h], l1 = P.LSE()[((size_t)T + tok) * 4 + h], l2 = P.LSE()[((size_t)2 * T + tok) * 4 + h];
        const float mx = fmaxf(l0, fmaxf(l1, l2)); float w0 = fast_exp2(l0 - mx), w1 = fast_exp2(l1 - mx), w2 = fast_exp2(l2 - mx);
        const float inv = 1.f / (w0 + w1 + w2); w0 *= inv; w1 *= inv; w2 *= inv;
        const u32x4 a = *(const u32x4*)(P.OG() + tok * 512 + col), b = *(const u32x4*)(P.OG() + ((size_t)T + tok) * 512 + col), c = *(const u32x4*)(P.OG() + ((size_t)2 * T + tok) * 512 + col);
        u32x4 o;
#pragma unroll
        for (int e = 0; e < 4; ++e) {
            const float lo = w0 * __uint_as_float(a[e] << 16) + w1 * __uint_as_float(b[e] << 16) + w2 * __uint_as_float(c[e] << 16);
            const float hi = w0 * __uint_as_float(a[e] & 0xffff0000u) + w1 * __uint_as_float(b[e] & 0xffff0000u) + w2 * __uint_as_float(c[e] & 0xffff0000u);
            o[e] = cvt_pk_bf16(lo, hi);
        }
        *(u32x4*)(P.OO() + tok * 512 + col) = o;
    }
}

#define ONE_LAUNCH 1
#define PROBE_F1 0
#define PROBE_O12 0
#define PROBE_EFRONT 0
#define PROBE_F2 0
#define USE_XBAR 1
#define PROBE_P0 0
#define PROBE_SYNC 0
#define PROBE_ATTE 0
#define PROBE_ATTO 0
#define PROBE_MLA_ONLY 0

enum { K_P0, K_F1, K_F2, K_LN, K_E12, K_SMALL, K_E345, K_C2, K_ATTE, K_OUTE, K_O12, K_ATTO, K_MERGE, K_OUTO };
constexpr int NPH = 25;
#define GEMM_CALL(EPI, g_, E_, off_) do { pg8::StaticOrder S_; S_.init((g_).M, (g_).N, (int)gridDim.x, (int)((blockIdx.x + (off_)) % gridDim.x)); \
    pg8::gemm_phase<EPI, pg8::StaticOrder, true, true>(lds, (g_), S_, (E_)); } while (0)

__global__ void __launch_bounds__(512, 2) mega(Args a) {
    extern __shared__ __attribute__((aligned(16))) unsigned char lds_raw[];
    LAS unsigned char* lds = (LAS unsigned char*)lds_raw;
    cg::grid_group grid = cg::this_grid();
    const int wv = __builtin_amdgcn_readfirstlane((int)threadIdx.x >> 6);
    const int G = gridDim.x, gw = blockIdx.x * 8 + wv, NGW = G * 8;
    KP P; unsigned char* ws = a.ws;
    P.out = a.out; P.ws = ws; P.pos = (const int*)a.in[1];
    LAS int* su = (LAS int*)(lds + LDS_BYTES - 64);
    volatile LAS unsigned* bst = (volatile LAS unsigned*)(lds + LDS_BYTES - 32);
    if (threadIdx.x < 2) bst[threadIdx.x] = 0u;
    __syncthreads();
    XcdBarrier bar = xcd_barrier_post((unsigned*)(a.ws + WS_CTL) + 4096, bst);

    if (a.ph_lo == 0) {
 p0_prologue(a, P, lds, threadIdx.x, gw, NGW);
#if PROBE_P0
 p0_prologue(a, P, lds, threadIdx.x, gw, NGW);
#endif
 if (a.ph_hi > 1) {
#if USE_XBAR
        if (a.ph_hi < 0) grid.sync();
        xcd_barrier(bar);
#else
        grid.sync();
#endif
    } }
#define IN(k) (((const float* const*)(P.ws + WS_PT))[k])
    for (int ph = (a.ph_lo == 0 ? 1 : a.ph_lo); ph < a.ph_hi; ++ph) {
        int tid = threadIdx.x; asm volatile("" : "+v"(tid));
        const int lane = tid & 63;
        { unsigned char* ws_i = a.ws; float* out_i = a.out; asm volatile("" : "+s"(ws_i), "+s"(out_i)); P.ws = ws_i; P.out = out_i; P.pos = (const int*)IN(1); }
        int kind, f = 0, lns = 0, layer = 0;
        switch (ph) {
            case 1: kind = K_F1; f = 0; break;  case 2: kind = K_F2; f = 0; break;  case 3: kind = K_LN; lns = 0; layer = 0; break;
            case 4: kind = K_E12; break; case 5: kind = K_SMALL; break; case 6: kind = K_E345; break; case 7: kind = K_C2; break; case 8: kind = K_ATTE; break; case 9: kind = K_OUTE; break;
            case 10: kind = K_LN; lns = 1; layer = 0; break;
            case 11: kind = K_F1; f = 1; break; case 12: kind = K_F2; f = 1; break; case 13: kind = K_LN; lns = 2; layer = 0; break;
            case 14: kind = K_F1; f = 2; break; case 15: kind = K_F2; f = 2; break; case 16: kind = K_LN; lns = 0; layer = 1; break;
            case 17: kind = K_O12; break; case 18: kind = K_ATTO; break; case 19: kind = K_MERGE; break; case 20: kind = K_OUTO; break;
            case 21: kind = K_LN; lns = 1; layer = 1; break;
            case 22: kind = K_F1; f = 3; break; case 23: kind = K_F2; f = 3; break; default: kind = K_LN; lns = 2; layer = 1; break;
        }
        if (kind == K_F1) {
            pg8::Gemm g{P.XB(), P.WB() + WE_GU + (size_t)f * 5632 * 1024, T, 5632, 1024, 1024, 1024, 128, 0}; EpiSwiglu E{P.H(), FF};
            GEMM_CALL(EpiSwiglu, g, E, 0);
#if PROBE_F1
            GEMM_CALL(EpiSwiglu, g, E, 0);
#endif
        }
        else if (kind == K_F2) {
            pg8::Gemm g{P.H(), P.WB() + WE_D + (size_t)f * 1024 * 2816, T, 1024, FF, FF, FF, 128, 0};
            if (f == 0) { EpiResidT<false> E{IN(0), P.out, P.ws, 0, 0, 0, DN_ALPHA, 0.5f}; GEMM_CALL(EpiResidT<false>, g, E, 0); }
            else {
#if PROBE_F2
                { EpiResidT<true> E{P.out, (float*)(P.ws + WS_R + 352 * MiB), P.ws, (f == 2 ? 26 : 21), (f == 2 ? 27 : 22), (f == 3 ? DM : 0), DN_ALPHA, 0.5f}; GEMM_CALL(EpiResidT<true>, g, E, 0); }
#endif
 EpiResidT<true> E{P.out, P.out, P.ws, (f == 2 ? 26 : 21), (f == 2 ? 27 : 22), (f == 3 ? DM : 0), DN_ALPHA, 0.5f}; GEMM_CALL(EpiResidT<true>, g, E, 0); }
        }
        else if (kind == K_OUTE) {
            pg8::Gemm g{P.OE(), P.WB() + WE_OE, T, 1024, 1024, 1024, 1024, 128, 0}; EpiResidT<true> E{P.out, P.out, P.ws, 2, 3, 0, DN_ALPHA, 1.f};
            GEMM_CALL(EpiResidT<true>, g, E, 0);
        }
        else if (kind == K_OUTO) {
            pg8::Gemm g{P.OO(), P.WB() + WE_OO, T, 1024, 512, 512, 512, 128, 0}; EpiResidT<true> E{P.out, P.out, P.ws, 2, 3, DM, DN_ALPHA, 1.f};
            GEMM_CALL(EpiResidT<true>, g, E, 0);
        }
        else if (kind == K_LN) {
            const float* gam = (lns == 0 ? IN(2) : (lns == 1 ? IN(21) : IN(26))) + layer * DM;
            const float* bet = (lns == 0 ? IN(3) : (lns == 1 ? IN(22) : IN(27))) + layer * DM;

#ifndef DIS_LN
 ln_pass(P, gam, bet, ph == NPH - 1, lane, gw, NGW);
#endif

        }
        else if (kind == K_SMALL) {
#ifndef DIS_SMALL
 small_pass(P, lane, gw, NGW);
#endif
 }
        else if (kind == K_MERGE) {
#ifndef DIS_MERGE
 merge_pass(P, lane, gw, NGW);
#endif
 }
        else if (kind == K_E12) {
            { pg8::Gemm g{P.XB(), P.WB() + WE_E1, T, 1792, 1024, 1024, 1024, 128, 0}; EpiStore E{P.HE(), HE_LD, nullptr, nullptr, nullptr, 0, 1792, T, 0, 0}; GEMM_CALL(EpiStore, g, E, 0); }
            { pg8::Gemm g{P.WB() + WE_E2, P.XB(), 256, T, 1024, 1024, 1024, 128, 0}; EpiStore E{P.VT(), T, nullptr, nullptr, nullptr, 0, T, 256, 0, 0}; GEMM_CALL(EpiStore, g, E, 0); }
        }
        else if (kind == K_E345) {
            for (int j = 0; j < 4; ++j) { const int kv = j >> 1, gg = j & 1;
                pg8::Gemm g{P.HE() + (kv ? HE_VC : HE_KC) + gg * 64, P.WB() + (kv ? WE_C1V : WE_C1K), 8192, 256, 2048, 16 * HE_LD, 2048, HE_LD * 2, 0};
                EpiStore E{P.HC() + (size_t)j * 8192 * 256, 256, nullptr, nullptr, P.CB() + kv * 256, 1, 256, 8192, 0, 0}; GEMM_CALL(EpiStore, g, E, 32 * j); }
            { pg8::Gemm g{P.HE() + HE_CQ, P.WB() + WE_UQ, T, 768, 384, HE_LD, 384, 128, 0}; EpiRopeQ E{P.QM(), 768, P.RSTD(), P.RT(), 0.10206207261596575f * LOG2E}; GEMM_CALL(EpiRopeQ, g, E, 128); }
            { pg8::Gemm g{P.HE() + HE_CKV, P.WB() + WE_UK, T, 512, 256, HE_LD, 256, 128, 0}; EpiStore E{P.KN(), 512, P.RSTD() + T, nullptr, nullptr, 0, 512, T, 0, 0}; GEMM_CALL(EpiStore, g, E, 128); }
            { pg8::Gemm g{P.WB() + WE_UV, P.HE() + HE_CKV, 512, T, 256, 256, HE_LD, 128, 0}; EpiStore E{P.VMT(), T, nullptr, P.RSTD() + T, nullptr, 0, T, 512, 0, 0}; GEMM_CALL(EpiStore, g, E, 128); }
        }
        else if (kind == K_C2) {
            for (int gg = 0; gg < 2; ++gg) { pg8::Gemm g{P.HC() + (size_t)gg * 8192 * 256, P.WB() + WE_C2K, 8192, 256, 256, 256, 256, 128, 0};
                EpiStore E{P.KCC() + gg * 64, 128, nullptr, nullptr, nullptr, 0, 64, 8192, 1, 0}; GEMM_CALL(EpiStore, g, E, 32 * gg); }
            for (int gg = 0; gg < 2; ++gg) { pg8::Gemm g{P.WB() + WE_C2V, P.HC() + (size_t)(2 + gg) * 8192 * 256, 256, 8192, 256, 256, 256, 128, 0};
                EpiStore E{P.VCT() + (size_t)gg * 64 * 8192, 8192, nullptr, nullptr, nullptr, 0, 8192, 64, 0, 1}; GEMM_CALL(EpiStore, g, E, 64 + 32 * gg); }
        }
        else if (kind == K_O12) {
            { pg8::Gemm g{P.XB(), P.WB() + WE_O1, T, 3072, 1024, 1024, 1024, 128, 0}; EpiStore E{P.QK(), 3072, nullptr, nullptr, nullptr, 0, 3072, T, 0, 0}; GEMM_CALL(EpiStore, g, E, 0); }
            for (int gg = 0; gg < 3; ++gg) { const int dil = gg == 0 ? 1 : (gg == 1 ? 4 : 16);
                pg8::Gemm g{P.WB() + WE_O2 + (size_t)gg * 512 * 1024, P.XB(), 512, T, 1024, 1024, dil * 1024, 128, dil};
                EpiStore E{P.VOT() + (size_t)gg * 512 * T, T, nullptr, nullptr, nullptr, 0, T, 512, 0, 0}; GEMM_CALL(EpiStore, g, E, 0); }
        }
        else if (kind == K_ATTE) {
            __syncthreads();
            for (int rep = 0; rep < (PROBE_ATTE ? 2 : 1); ++rep)
            for (;;) {
                if (tid == 0) *su = (int)atomicAdd(&P.CTL()[0 + 2 * rep], 1u);
                __syncthreads(); const int u = *su; __syncthreads();
                if (u >= 4096) break;
                if (PROBE_MLA_ONLY && rep == 1 && u >= 2048) break;
                if (u < 2048) { const int qb = 31 - (u >> 6), bh = u & 63;
#ifndef DIS_MLA
 mla_unit(P, lds, bh >> 3, bh & 7, qb, tid);
#endif
 }
                else { const int v = u - 2048, c = 127 - (v >> 4), bg = v & 15;
#ifndef DIS_NSA
 nsa_unit(P, lds, bg >> 1, c, bg & 1, tid);
#endif
 }
            }
        }
        else if (kind == K_ATTO) {
            __syncthreads();
            for (int rep = 0; rep < (PROBE_ATTO ? 2 : 1); ++rep)
            for (;;) {
                if (tid == 0) *su = (int)atomicAdd(&P.CTL()[1 + 2 * rep], 1u);
                __syncthreads(); const int u = *su; __syncthreads();
                if (u >= 3072) break;
                const int rj = u & 31, rest = u >> 5, h = rest & 3, g = (rest >> 2) % 3, b = rest / 12;

#ifndef DIS_DIL
 dil_unit(P, lds, b, g, h, rj, tid);
#endif

            }
        }
        if (ph + 1 < a.ph_hi) {
#if USE_XBAR
            xcd_barrier(bar);
#else
            grid.sync();
#endif
        }
#if PROBE_SYNC
        if (ph + 1 < a.ph_hi) { grid.sync(); grid.sync(); }
#endif
    }
}

#ifndef ONE_LAUNCH_X
#define ONE_LAUNCH 1
#endif
extern "C" void kernel_launch(void* const* d_in, const int* in_sizes, int n_in, void* d_out, int out_size, void* d_ws, size_t ws_size, hipStream_t stream) {
    static int grid = 0;
    if (grid == 0) {
        if (n_in != 28 || ws_size < WS_NEED) { fprintf(stderr, "kernel_launch: unexpected n_in %d / ws %zu\n", n_in, ws_size); grid = -1; return; }
        int dev = 0, cus = 0, per_cu = 0;
        hipGetDevice(&dev); hipDeviceGetAttribute(&cus, hipDeviceAttributeMultiprocessorCount, dev);
        if (hipFuncSetAttribute((const void*)mega, hipFuncAttributeMaxDynamicSharedMemorySize, LDS_BYTES) != hipSuccess) { fprintf(stderr, "hipFuncSetAttribute failed\n"); grid = -1; return; }
        hipOccupancyMaxActiveBlocksPerMultiprocessor(&per_cu, (const void*)mega, 512, LDS_BYTES);
        if (per_cu < 1) per_cu = 1;
        grid = cus * 1;
        (void)hipGetLastError();
    }
    if (grid < 0) return;
    if (hipMemsetAsync((char*)d_ws + WS_CTL, 0, 65536, stream) != hipSuccess) { fprintf(stderr, "memset failed\n"); return; }
    Args a{};
    for (int i = 0; i < 28; ++i) a.in[i] = (const float*)d_in[i];
    a.out = (float*)d_out; a.ws = (unsigned char*)d_ws;
#if ONE_LAUNCH
    a.ph_lo = 0; a.ph_hi = NPH;
    void* args[] = {&a};
    hipError_t e = hipLaunchCooperativeKernel((const void*)mega, dim3(grid), dim3(512), args, LDS_BYTES, stream);
    if (e != hipSuccess) fprintf(stderr, "cooperative launch failed: %s (grid %d)\n", hipGetErrorString(e), grid);
#else
    for (int ph = 0; ph < NPH; ++ph) { a.ph_lo = ph; a.ph_hi = ph + 1; hipLaunchKernelGGL(mega, dim3(grid), dim3(512), LDS_BYTES, stream, a); }
#endif
}
```

```cpp
#include <hip/hip_runtime.h>
#include <hip/hip_cooperative_groups.h>
#include <cstdio>
#include <cstdint>
namespace cg = cooperative_groups;
namespace pg8 {
#define PG8_LAS __attribute__((address_space(3)))
typedef unsigned short bf16_t;
typedef short bf16x8 __attribute__((ext_vector_type(8)));
typedef float f32x4 __attribute__((ext_vector_type(4)));
typedef unsigned u32x4 __attribute__((ext_vector_type(4)));
constexpr int BM = 256, BK = 64, HALF = 128, HTB = HALF * BK * 2  , STAGE_BYTES = 8 * HTB, NXCD = 8, WGM = 8;

__host__ __device__ __forceinline__ int lds_byte(int r, int c) { const int st = (r >> 4) * 2 + (c >> 5), rr = r & 15, cc = c & 31, ob = rr * 64 + cc * 2; return st * 1024 + (ob ^ (((ob >> 9) & 1) << 5)); }
__host__ __device__ __forceinline__ void stage_rc(int b, int& R, int& C) { const int st = b / 1024, sb = b % 1024, swz = sb ^ (((sb >> 9) & 1) << 5); R = (st >> 1) * 16 + swz / 64; C = (st & 1) * 32 + (swz % 64) / 2; }
__host__ __device__ __forceinline__ int perm32(int rho) { const int n = rho >> 4, i = rho & 15; return 8 * (i >> 2) + 4 * n + (i & 3); }

struct Unit { int pm, pn; };
struct Gemm { const bf16_t* A; const bf16_t* Bt; int M, N, K; int lda, ldb, kstepA, bdil;
    __device__ __forceinline__ size_t aoff(int pm) const { return (size_t)pm * 256 * lda * 2; }
    __device__ __forceinline__ size_t boff(int pn) const {
        if (bdil == 0) return (size_t)pn * 256 * ldb * 2;
        const int per = 32 / bdil, b = pn >> 5, rem = pn & 31, r = rem / per, jt = rem % per;
        return ((size_t)b * 8192 + r + (size_t)bdil * 256 * jt) * 1024 * 2; } };

struct StaticOrder {
    int nM, nN, nwg, G, c;
    __host__ __device__ void init(int M, int N, int G_, int c_) { nM = M / BM; nN = N / BM; nwg = nM * nN; G = G_; c = c_; }
    __host__ __device__ bool next(int i, Unit& u) const {
        const long L = (long)i * G + c; if (L >= nwg) return false;
        int wgid = (int)L; { const int q = nwg / NXCD, r = nwg % NXCD, xcd = wgid % NXCD, off = wgid / NXCD; wgid = (xcd < r ? xcd * (q + 1) : r * (q + 1) + (xcd - r) * q) + off; }
        const int nig = WGM * nN, gid = wgid / nig, fm = gid * WGM, gsz = (nM - fm) < WGM ? (nM - fm) : WGM;
        u.pm = fm + ((wgid % nig) % gsz); u.pn = (wgid % nig) / gsz; return true;
    }
    __device__ __forceinline__ void a_ready(const Unit&) const {}
    __device__ __forceinline__ void done(const Unit&) const {}
};

__device__ __forceinline__ unsigned cvt_pk_bf16(float lo, float hi) { unsigned r; asm volatile("v_cvt_pk_bf16_f32 %0, %1, %2" : "=v"(r) : "v"(lo), "v"(hi)); return r; }
typedef float f32x2 __attribute__((ext_vector_type(2)));
template <class Epi, class Sched, bool ALIGN_EPI = false, bool SP2 = false>
__device__ __forceinline__ void gemm_phase(PG8_LAS unsigned char* lds, const Gemm g, const Sched& S, const Epi& E) {
    int tid_o = threadIdx.x; asm volatile("" : "+v"(tid_o)); const int tid = tid_o, wid = __builtin_amdgcn_readfirstlane(tid >> 6), lane = tid & 63, wr = wid >> 2, wc = wid & 3, fr = lane & 15, fq = lane >> 4;
    const int K = g.K, nt = K / BK;
    unsigned voffA[2], voffB[2];
#pragma unroll
    for (int i = 0; i < 2; ++i) { int R, C; stage_rc(tid * 16 + i * 8192, R, C); const int Rb = Epi::PERM ? ((R & ~31) + perm32(R & 31)) : R;
        voffA[i] = (unsigned)(R * g.lda + C) * 2u; voffB[i] = (unsigned)(Rb * g.ldb + C) * 2u; }
    const size_t kstepB = (size_t)(BK * 2), kstepA = (size_t)g.kstepA;
    const size_t hstepA = (size_t)HALF * g.lda * 2, hstepB = (size_t)HALF * g.ldb * 2;
    const unsigned ldsw = (unsigned)wid * 1024u;
    const int aoff = lds_byte(wr * 64 + fr, fq * 8), boff = lds_byte(wc * 32 + fr, fq * 8);
#define PG8_SA(b, h) (((b) * 2 + (h)) * HTB)
#define PG8_SB(b, h) ((4 + (b) * 2 + (h)) * HTB)
#define PG8_STAGE(bufoff, gbase, voff) do { _Pragma("unroll") for (int _i = 0; _i < 2; ++_i) \
        __builtin_amdgcn_global_load_lds((const unsigned*)((const char*)(gbase) + (voff)[_i]), (PG8_LAS unsigned*)(lds + (bufoff) + ldsw + _i * 8192), 16, 0, 0); } while (0)
#define PG8_LDA(dst, b, h) do { _Pragma("unroll") for (int m = 0; m < 4; ++m) _Pragma("unroll") for (int k = 0; k < 2; ++k) dst[m][k] = *(const PG8_LAS bf16x8*)(lds + PG8_SA(b, h) + aoff + m * 2048 + k * 1024); } while (0)
#define PG8_LDB(dst, b, h) do { _Pragma("unroll") for (int n = 0; n < 2; ++n) _Pragma("unroll") for (int k = 0; k < 2; ++k) dst[n][k] = *(const PG8_LAS bf16x8*)(lds + PG8_SB(b, h) + boff + n * 2048 + k * 1024); } while (0)
#define PG8_MMA(ai, bj, At, Bt) do { __builtin_amdgcn_s_setprio(1); _Pragma("unroll") for (int m = 0; m < 4; ++m) _Pragma("unroll") for (int n = 0; n < 2; ++n) _Pragma("unroll") for (int k = 0; k < 2; ++k) \
        acc[ai][bj][m][n] = __builtin_amdgcn_mfma_f32_16x16x32_bf16(Bt[n][k], At[m][k], acc[ai][bj][m][n], 0, 0, 0); __builtin_amdgcn_s_setprio(0); } while (0)
#define PG8_WAIT_V(n) asm volatile("s_waitcnt vmcnt(" #n ")" ::: "memory")
#define PG8_WAIT_L(n) asm volatile("s_waitcnt lgkmcnt(" #n ")" ::: "memory")
#define PG8_BAR __builtin_amdgcn_s_barrier()
#define PG8_SCHED __builtin_amdgcn_sched_barrier(0)
    Unit cur, nxt; int ui = 0;
    if (!S.next(0, cur)) return;
    f32x4 acc[2][2][4][2];
#pragma unroll
    for (int a = 0; a < 2; ++a)
#pragma unroll
        for (int b = 0; b < 2; ++b)
#pragma unroll
            for (int m = 0; m < 4; ++m)
#pragma unroll
                for (int n = 0; n < 2; ++n) acc[a][b][m][n] = (f32x4){0.f, 0.f, 0.f, 0.f};
    bf16x8 At[4][2], B0[2][2], B1[2][2];
    const char* cA = (const char*)g.A + g.aoff(cur.pm); const char* cB = (const char*)g.Bt + g.boff(cur.pn);
    S.a_ready(cur);
    if constexpr (SP2) {
        PG8_STAGE(PG8_SB(0, 0), cB, voffB); PG8_STAGE(PG8_SB(0, 1), cB + hstepB, voffB); PG8_STAGE(PG8_SA(0, 0), cA, voffA); PG8_STAGE(PG8_SA(0, 1), cA + hstepA, voffA);
        if (wr == 1) PG8_BAR;
        PG8_WAIT_V(2); PG8_BAR;
        PG8_STAGE(PG8_SB(1, 0), cB + kstepB, voffB); PG8_STAGE(PG8_SA(1, 0), cA + kstepA, voffA); PG8_STAGE(PG8_SB(1, 1), cB + hstepB + kstepB, voffB);
        PG8_WAIT_V(6); PG8_BAR;
    } else {
        PG8_STAGE(PG8_SB(0, 0), cB, voffB); PG8_STAGE(PG8_SA(0, 0), cA, voffA); PG8_STAGE(PG8_SB(0, 1), cB + hstepB, voffB); PG8_STAGE(PG8_SA(0, 1), cA + hstepA, voffA);
        if (wr == 1) PG8_BAR;
        PG8_WAIT_V(4); PG8_BAR;
        PG8_STAGE(PG8_SB(1, 0), cB + kstepB, voffB); PG8_STAGE(PG8_SA(1, 0), cA + kstepA, voffA); PG8_STAGE(PG8_SB(1, 1), cB + hstepB + kstepB, voffB);
        PG8_WAIT_V(6); PG8_BAR;
    }
    for (;;) {
        const bool has_next = S.next(ui + 1, nxt);
        const char* nA = has_next ? (const char*)g.A + g.aoff(nxt.pm) : cA; const char* nB = has_next ? (const char*)g.Bt + g.boff(nxt.pn) : cB;
        _Pragma("clang loop unroll(disable)") for (int t = 0; t < nt; t += 2) {
            const bool last = (t == nt - 2);
            const char* a1 = cA + (size_t)(t + 1) * kstepA;
            const char* a2 = last ? nA : cA + (size_t)(t + 2) * kstepA; const char* b2 = last ? nB : cB + (size_t)(t + 2) * kstepB;
            const char* a3 = a2 + kstepA; const char* b3 = b2 + kstepB;
            if (last && has_next) S.a_ready(nxt);
            if constexpr (SP2) {
            PG8_LDB(B0, 0, 0); PG8_LDB(B1, 0, 1); PG8_SCHED; PG8_LDA(At, 0, 0); PG8_STAGE(PG8_SA(1, 1), a1 + hstepA, voffA);
            PG8_WAIT_V(8); PG8_WAIT_L(0); PG8_BAR; PG8_MMA(0, 0, At, B0); PG8_MMA(0, 1, At, B1); PG8_BAR; PG8_SCHED;
            PG8_LDA(At, 0, 1); PG8_STAGE(PG8_SB(0, 0), b2, voffB); PG8_STAGE(PG8_SB(0, 1), b2 + hstepB, voffB); PG8_STAGE(PG8_SA(0, 0), a2, voffA);
            PG8_WAIT_V(8); PG8_WAIT_L(0); PG8_BAR; PG8_MMA(1, 0, At, B0); PG8_MMA(1, 1, At, B1); PG8_BAR; PG8_SCHED;
            PG8_LDB(B0, 1, 0); PG8_LDB(B1, 1, 1); PG8_SCHED; PG8_LDA(At, 1, 0); PG8_STAGE(PG8_SA(0, 1), a2 + hstepA, voffA);
            PG8_WAIT_V(8); PG8_WAIT_L(0); PG8_BAR; PG8_MMA(0, 0, At, B0); PG8_MMA(0, 1, At, B1); PG8_BAR; PG8_SCHED;
            PG8_LDA(At, 1, 1); PG8_STAGE(PG8_SB(1, 0), b3, voffB); PG8_STAGE(PG8_SB(1, 1), b3 + hstepB, voffB); PG8_STAGE(PG8_SA(1, 0), a3, voffA);
            PG8_WAIT_V(8); PG8_WAIT_L(0); PG8_BAR; PG8_MMA(1, 0, At, B0); PG8_MMA(1, 1, At, B1); PG8_BAR; PG8_SCHED;
            } else {
            PG8_LDB(B0, 0, 0); PG8_SCHED; PG8_LDA(At, 0, 0); PG8_STAGE(PG8_SA(1, 1), a1 + hstepA, voffA);
            PG8_WAIT_L(8); PG8_BAR; PG8_WAIT_L(0); PG8_MMA(0, 0, At, B0); PG8_BAR; PG8_SCHED;
            PG8_LDB(B1, 0, 1); PG8_STAGE(PG8_SB(0, 0), b2, voffB);
            PG8_BAR; PG8_WAIT_L(0); PG8_MMA(0, 1, At, B1); PG8_BAR;
            PG8_LDA(At, 0, 1); PG8_STAGE(PG8_SA(0, 0), a2, voffA);
            PG8_BAR; PG8_WAIT_L(0); PG8_MMA(1, 0, At, B0); PG8_BAR; PG8_SCHED;
            PG8_STAGE(PG8_SB(0, 1), b2 + hstepB, voffB);
            PG8_WAIT_V(6); PG8_BAR; PG8_MMA(1, 1, At, B1); PG8_BAR;
            PG8_LDB(B0, 1, 0); PG8_SCHED; PG8_LDA(At, 1, 0); PG8_STAGE(PG8_SA(0, 1), a2 + hstepA, voffA);
            PG8_WAIT_L(8); PG8_BAR; PG8_WAIT_L(0); PG8_MMA(0, 0, At, B0); PG8_BAR; PG8_SCHED;
            PG8_LDB(B1, 1, 1); PG8_STAGE(PG8_SB(1, 0), b3, voffB);
            PG8_BAR; PG8_WAIT_L(0); PG8_MMA(0, 1, At, B1); PG8_BAR;
            PG8_LDA(At, 1, 1); PG8_STAGE(PG8_SA(1, 0), a3, voffA);
            PG8_BAR; PG8_WAIT_L(0); PG8_MMA(1, 0, At, B0); PG8_BAR; PG8_SCHED;
            PG8_STAGE(PG8_SB(1, 1), b3 + hstepB, voffB);
            PG8_WAIT_V(6); PG8_BAR; PG8_MMA(1, 1, At, B1); PG8_BAR;
            }
        }
        if constexpr (ALIGN_EPI) { if (wr == 0) PG8_BAR; }
        if constexpr (!Epi::AFTER_DRAIN) { E(acc, cur, wr, wc, fr, fq); S.done(cur); }
        if (!has_next) break;
#pragma unroll
        for (int a = 0; a < 2; ++a)
#pragma unroll
            for (int b = 0; b < 2; ++b)
#pragma unroll
                for (int m = 0; m < 4; ++m)
#pragma unroll
                    for (int n = 0; n < 2; ++n) acc[a][b][m][n] = (f32x4){0.f, 0.f, 0.f, 0.f};
        cur = nxt; cA = nA; cB = nB; ++ui;
        if constexpr (ALIGN_EPI) { if (wr == 1) PG8_BAR; }
    }
    PG8_WAIT_V(0);
    if constexpr (!ALIGN_EPI) { if (wr == 0) PG8_BAR; }
    PG8_BAR;
    if constexpr (Epi::AFTER_DRAIN) { E.fused(acc, cur, wr, wc, fr, fq, lds, wid, lane); S.done(cur); }
#undef PG8_SA
#undef PG8_SB
#undef PG8_STAGE
#undef PG8_LDA
#undef PG8_LDB
#undef PG8_MMA
#undef PG8_WAIT_V
#undef PG8_WAIT_L
#undef PG8_BAR
#undef PG8_SCHED
}
}
#define LAS __attribute__((address_space(3)))
typedef unsigned short bf16;
using pg8::f32x4; using pg8::bf16x8; using pg8::u32x4; using pg8::Unit; using pg8::cvt_pk_bf16;
typedef float f32x16 __attribute__((ext_vector_type(16)));
typedef unsigned u32x2 __attribute__((ext_vector_type(2)));
typedef short s16x4 __attribute__((ext_vector_type(4)));

constexpr int NB = 8, SEQ = 8192, T = NB * SEQ, DM = 1024, FF = 2816;
constexpr int HE_LD = 1792;
constexpr int HE_CQ = 0, HE_CKV = 384, HE_KPE = 640, HE_Q = 672, HE_KC = 1184, HE_VC = 1312, HE_KS = 1440, HE_KW = 1568, HE_GT = 1696;
constexpr float LOG2E = 1.4426950408889634f;
constexpr float DN_ALPHA = 1.4142135623730951f;
constexpr float NEGB = -1e30f;

constexpr size_t MiB = 1u << 20;
constexpr size_t WS_CTL = 0;
constexpr size_t WS_W = 1 * MiB;
constexpr size_t WS_PT = 256 * 1024;
constexpr size_t WS_ST = 512 * 1024;
constexpr size_t WE_GU = 0;
constexpr size_t WE_D = WE_GU + 4ull * 5632 * 1024;
constexpr size_t WE_E1 = WE_D + 4ull * 1024 * 2816;
constexpr size_t WE_E2 = WE_E1 + 1792ull * 1024;
constexpr size_t WE_UQ = WE_E2 + 256ull * 1024;
constexpr size_t WE_UK = WE_UQ + 768ull * 384;
constexpr size_t WE_UV = WE_UK + 512ull * 256;
constexpr size_t WE_C1K = WE_UV + 512ull * 256;
constexpr size_t WE_C1V = WE_C1K + 256ull * 2048;
constexpr size_t WE_C2K = WE_C1V + 256ull * 2048;
constexpr size_t WE_C2V = WE_C2K + 256ull * 256;
constexpr size_t WE_OE = WE_C2V + 256ull * 256;
constexpr size_t WE_O1 = WE_OE + 1024ull * 1024;
constexpr size_t WE_O2 = WE_O1 + 3072ull * 1024;
constexpr size_t WE_OO = WE_O2 + 1536ull * 1024;
constexpr size_t WE_END = WE_OO + 1024ull * 512;
static_assert(WE_END * 2 <= 95 * MiB, "weights fit");
constexpr size_t WS_CB = 96 * MiB;
constexpr size_t WS_XB = 97 * MiB;
constexpr size_t WS_R = 225 * MiB;
constexpr size_t R_H = WS_R;
constexpr size_t R_HE = WS_R;
constexpr size_t R_VT = WS_R + 224 * MiB;
constexpr size_t R_QM = WS_R + 256 * MiB;
constexpr size_t R_KN = WS_R + 352 * MiB;
constexpr size_t R_VMT = WS_R + 416 * MiB;
constexpr size_t R_OE = WS_R + 480 * MiB;
constexpr size_t R_KROT = WS_R + 608 * MiB;
constexpr size_t R_RT = WS_R + 612 * MiB;
constexpr size_t R_GT = WS_R + 620 * MiB;
constexpr size_t R_RSTD = WS_R + 628 * MiB;
constexpr size_t R_HC = WS_R + 629 * MiB;
constexpr size_t R_KCC = WS_R + 645 * MiB;
constexpr size_t R_VCT = WS_R + 647 * MiB;
constexpr size_t R_QK = WS_R;
constexpr size_t R_VOT = WS_R + 384 * MiB;
constexpr size_t R_OG = WS_R + 576 * MiB;
constexpr size_t R_LSE = WS_R + 768 * MiB;
constexpr size_t R_OO = WS_R;
constexpr size_t WS_NEED = WS_R + 772 * MiB;
static_assert(WS_NEED <= 1024 * MiB, "ws");

constexpr int LDS_BYTES = 147456;

__device__ __forceinline__ float fast_exp2(float x) { return __builtin_amdgcn_exp2f(x); }
__device__ __forceinline__ float fast_rcp(float x) { return __builtin_amdgcn_rcpf(x); }
__device__ __forceinline__ float bf2f(bf16 v) { return __uint_as_float(((unsigned)v) << 16); }
__device__ __forceinline__ float wave_sum(float v) {
#pragma unroll
    for (int o = 1; o < 64; o <<= 1) v += __shfl_xor(v, o);
    return v;
}

struct EpiStore {
    static constexpr bool PERM = true, AFTER_DRAIN = false;
    bf16* O; int ldc; const float* rscale; const float* cscale; const float* bias; int act; int ncv; int nrv; int zrow; int zcol;
    __device__ __forceinline__ void operator()(const f32x4 (&acc)[2][2][4][2], const Unit& u, int wr, int wc, int fr, int fq) const {
#pragma unroll
        for (int bj = 0; bj < 2; ++bj) {
            const int col = u.pn * 256 + bj * 128 + wc * 32 + 8 * fq;
            if (col < ncv) {
                float cs[8], bs[8];
#pragma unroll
                for (int e = 0; e < 8; ++e) { cs[e] = cscale ? cscale[col + e] : 1.f; bs[e] = bias ? bias[col + e] : 0.f; }
#pragma unroll
                for (int ai = 0; ai < 2; ++ai)
#pragma unroll
                    for (int m = 0; m < 4; ++m) {
                        const int row = u.pm * 256 + ai * 128 + wr * 64 + m * 16 + fr;
                        if (row < nrv) {
                            const float rs = rscale ? rscale[row] : 1.f;
                            const f32x4 v0 = acc[ai][bj][m][0], v1 = acc[ai][bj][m][1];
                            float v[8] = {v0[0], v0[1], v0[2], v0[3], v1[0], v1[1], v1[2], v1[3]};
                            const bool zr = zrow && ((row & 511) == 511);
#pragma unroll
                            for (int e = 0; e < 8; ++e) {
                                float x = v[e] + bs[e];
                                if (act == 1) { const float y = 0.7978845608028654f * (x + 0.044715f * x * x * x); x = x * fast_rcp(1.f + fast_exp2(-2.f * LOG2E * y)); }
                                x *= rs * cs[e];
                                if (zr || (zcol && (((col + e) & 511) == 511))) x = 0.f;
                                v[e] = x;
                            }
                            u32x4 w; w.x = cvt_pk_bf16(v[0], v[1]); w.y = cvt_pk_bf16(v[2], v[3]); w.z = cvt_pk_bf16(v[4], v[5]); w.w = cvt_pk_bf16(v[6], v[7]);
                            *(u32x4*)(O + (size_t)row * ldc + col) = w;
                        }
                    }
            }
        }
    }
};
struct EpiSwiglu {
    static constexpr bool PERM = true, AFTER_DRAIN = false;
    bf16* H; int ldh;
    __device__ __forceinline__ void operator()(const f32x4 (&acc)[2][2][4][2], const Unit& u, int wr, int wc, int fr, int fq) const {
        const int col = u.pn * 128 + wc * 32 + 8 * fq;
#pragma unroll
        for (int ai = 0; ai < 2; ++ai)
#pragma unroll
            for (int m = 0; m < 4; ++m) {
                const int row = u.pm * 256 + ai * 128 + wr * 64 + m * 16 + fr;
                const f32x4 g0 = acc[ai][0][m][0], g1 = acc[ai][0][m][1], u0 = acc[ai][1][m][0], u1 = acc[ai][1][m][1];
                float g[8] = {g0[0], g0[1], g0[2], g0[3], g1[0], g1[1], g1[2], g1[3]};
                float uu[8] = {u0[0], u0[1], u0[2], u0[3], u1[0], u1[1], u1[2], u1[3]};
#pragma unroll
                for (int e = 0; e < 8; ++e) g[e] = g[e] * fast_rcp(1.f + fast_exp2(-LOG2E * g[e])) * uu[e];
                u32x4 w; w.x = cvt_pk_bf16(g[0], g[1]); w.y = cvt_pk_bf16(g[2], g[3]); w.z = cvt_pk_bf16(g[4], g[5]); w.w = cvt_pk_bf16(g[6], g[7]);
                *(u32x4*)(H + (size_t)row * ldh + col) = w;
            }
    }
};
template <bool LN>
struct EpiResidT {
    static constexpr bool PERM = true, AFTER_DRAIN = false;
    const float* Xin; float* Xout; unsigned char* ws; int gi, bi, goff; float alpha, beta;
    __device__ __forceinline__ void operator()(const f32x4 (&acc)[2][2][4][2], const Unit& u, int wr, int wc, int fr, int fq) const {
        constexpr int ldx = 1024;
        const float* st = (const float*)(ws + WS_ST); const float* gam = nullptr; const float* bet = nullptr;
        if (LN) { const float* const* PT = (const float* const*)(ws + WS_PT); gam = PT[gi] + goff; bet = PT[bi] + goff; }
#pragma unroll
        for (int bj = 0; bj < 2; ++bj) {
            const int col = u.pn * 256 + bj * 128 + wc * 32 + 8 * fq;
            f32x4 g0, g1, b0, b1;
            if (LN) { g0 = *(const f32x4*)(gam + col); g1 = *(const f32x4*)(gam + col + 4); b0 = *(const f32x4*)(bet + col); b1 = *(const f32x4*)(bet + col + 4); }
#pragma unroll
            for (int ai = 0; ai < 2; ++ai) {
                f32x4 x0[4], x1[4]; float mean[4], rstd[4];
#pragma unroll
                for (int m = 0; m < 4; ++m) {
                    const int row = u.pm * 256 + ai * 128 + wr * 64 + m * 16 + fr;
                    const size_t off = (size_t)row * ldx + col;
                    x0[m] = *(const f32x4*)(Xin + off); x1[m] = *(const f32x4*)(Xin + off + 4);
                    if (LN) { mean[m] = st[2 * row]; rstd[m] = st[2 * row + 1]; }
                }
#pragma unroll
                for (int m = 0; m < 4; ++m) {
                    const int row = u.pm * 256 + ai * 128 + wr * 64 + m * 16 + fr;
                    const size_t off = (size_t)row * ldx + col;
                    f32x4 a0 = x0[m], a1 = x1[m];
                    if (LN) { a0 = (a0 - mean[m]) * rstd[m] * g0 + b0; a1 = (a1 - mean[m]) * rstd[m] * g1 + b1; }
                    *(f32x4*)(Xout + off) = a0 * alpha + acc[ai][bj][m][0] * beta;
                    *(f32x4*)(Xout + off + 4) = a1 * alpha + acc[ai][bj][m][1] * beta;
                }
            }
        }
    }
};
struct EpiRopeQ {
    static constexpr bool PERM = true, AFTER_DRAIN = false;
    bf16* Q; int ldq; const float* rstd; const float* RT; float qscale;
    __device__ __forceinline__ void operator()(const f32x4 (&acc)[2][2][4][2], const Unit& u, int wr, int wc, int fr, int fq) const {
#pragma unroll
        for (int bj = 0; bj < 2; ++bj) {
            const int grp = u.pn * 8 + bj * 4 + wc; const bool is_rope = (grp % 3) == 2;
            const int col = u.pn * 256 + bj * 128 + wc * 32 + 8 * fq;
#pragma unroll
            for (int ai = 0; ai < 2; ++ai)
#pragma unroll
                for (int m = 0; m < 4; ++m) {
                    const int row = u.pm * 256 + ai * 128 + wr * 64 + m * 16 + fr;
                    const float rs = rstd[row] * qscale;
                    f32x4 v0 = acc[ai][bj][m][0] * rs, v1 = acc[ai][bj][m][1] * rs;
                    if (is_rope) {
                        const f32x4 c01 = *(const f32x4*)(RT + (size_t)row * 32 + 8 * fq), c23 = *(const f32x4*)(RT + (size_t)row * 32 + 8 * fq + 4);
                        const float cs[4] = {c01[0], c01[2], c23[0], c23[2]}, sn[4] = {c01[1], c01[3], c23[1], c23[3]};
                        f32x4 o1, o2;
#pragma unroll
                        for (int e = 0; e < 4; ++e) { o1[e] = v0[e] * cs[e] - v1[e] * sn[e]; o2[e] = v1[e] * cs[e] + v0[e] * sn[e]; }
                        v0 = o1; v1 = o2;
                    }
                    u32x4 w; w.x = cvt_pk_bf16(v0[0], v0[1]); w.y = cvt_pk_bf16(v0[2], v0[3]); w.z = cvt_pk_bf16(v1[0], v1[1]); w.w = cvt_pk_bf16(v1[2], v1[3]);
                    *(u32x4*)(Q + (size_t)row * ldq + col) = w;
                }
        }
    }
};
#define XB_TMO      128
#define XB_XCNT(j)  (256  + 64 * (j))
#define XB_XSUB(j)  (1280 + 64 * (j))
#define XB_XGEN(j)  (2304 + 64 * (j))
#define XB_TOP      3328
#define XB_TOPGEN   3392
#define XCD_BAR_WORDS 3456
#define XB_SPIN_CAP (1u << 18)

__device__ __forceinline__ unsigned xb_ld(unsigned* p)              { return __hip_atomic_load(p, __ATOMIC_RELAXED, __HIP_MEMORY_SCOPE_AGENT); }
__device__ __forceinline__ unsigned xb_add(unsigned* p, unsigned v) { return __hip_atomic_fetch_add(p, v, __ATOMIC_RELAXED, __HIP_MEMORY_SCOPE_AGENT); }
__device__ __forceinline__ unsigned xb_xcc_id() { return (unsigned)__builtin_amdgcn_s_getreg((3 << 11) | 20) & 0xFu; }
#define XB_SPIN(cond, bar) do { unsigned _sp = 0; while (cond) { __builtin_amdgcn_s_sleep(1); \
    if ((++_sp & 255u) == 0u) { if (xb_ld(&(bar)[XB_TMO])) break; if (_sp > XB_SPIN_CAP) { atomicAdd(&(bar)[XB_TMO], 1u); break; } } } } while (0)

struct XcdBarrier {
    unsigned* bar; unsigned x;
    volatile LAS unsigned* st;
};

__device__ __forceinline__ XcdBarrier xcd_barrier_post(unsigned* bar, volatile LAS unsigned* st) {
    XcdBarrier b; b.bar = bar; b.x = xb_xcc_id(); b.st = st;
    if (threadIdx.x == 0) (void)xb_add(&bar[XB_XCNT(b.x)], 1u);
    return b;
}
__device__ __forceinline__ void xcd_barrier_complete(unsigned* bar, unsigned x, unsigned& nloc, unsigned& nx) {
    const unsigned G = gridDim.x * gridDim.y * gridDim.z;
    unsigned sum, cnt, mine, sp = 0u;
    for (;;) {
        sum = 0u; cnt = 0u; mine = 0u;
#pragma unroll
        for (unsigned j = 0; j < 16; ++j) { const unsigned c = xb_ld(&bar[XB_XCNT(j)]); sum += c; cnt += (c > 0u) ? 1u : 0u; mine = (j == x) ? c : mine; }
        if (sum == G) break;
        __builtin_amdgcn_s_sleep(1);
        if ((++sp & 255u) == 0u) { if (xb_ld(&bar[XB_TMO])) break; if (sp > XB_SPIN_CAP) { atomicAdd(&bar[XB_TMO], 1u); break; } }
    }
    nloc = mine > 0u ? mine : 1u; nx = cnt > 0u ? cnt : 1u;
}

__device__ __forceinline__ void xcd_barrier(const XcdBarrier& b) {
    asm volatile("s_waitcnt vmcnt(0)" ::: "memory");
    __syncthreads();
    if (threadIdx.x == 0) {
        unsigned* bar = b.bar;
        __builtin_amdgcn_s_waitcnt(0);
        unsigned nloc = b.st[0], nx = b.st[1];
        if (nloc == 0u) { xcd_barrier_complete(bar, b.x, nloc, nx); b.st[0] = nloc; b.st[1] = nx; }
        const unsigned old = xb_add(&bar[XB_XSUB(b.x)], 1u);
        const unsigned gen = old / nloc;
        if (old + 1u == (gen + 1u) * nloc) {
            __builtin_amdgcn_fence(__ATOMIC_RELEASE, "agent");
            asm volatile("s_waitcnt vmcnt(0)" ::: "memory");
            const unsigned og = xb_add(&bar[XB_TOP], 1u);
            const unsigned tg = og / nx;
            if (og + 1u == (tg + 1u) * nx) xb_add(&bar[XB_TOPGEN], 1u);
            else XB_SPIN(xb_ld(&bar[XB_TOPGEN]) == tg, bar);
            __builtin_amdgcn_fence(__ATOMIC_ACQUIRE, "agent");
            xb_add(&bar[XB_XGEN(b.x)], 1u);
            asm volatile("s_waitcnt vmcnt(0)" ::: "memory");
        } else {
            XB_SPIN(xb_ld(&bar[XB_XGEN(b.x)]) == gen, bar);
            __builtin_amdgcn_fence(__ATOMIC_ACQUIRE, "agent");
            asm volatile("s_waitcnt vmcnt(0)" ::: "memory");
        }
    }
    __syncthreads();
}
struct KP {
    float* out; unsigned char* ws; const int* pos;
    __device__ __forceinline__ const int* pos_local() const { int one = 1; asm volatile("" : "+s"(one)); return (const int*)(((const float* const*)(ws + WS_PT))[one]); }
#define KP_ACC(T_, NAME, OFF) __device__ __forceinline__ T_* NAME() const { return (T_*)(ws + (OFF)); }
    KP_ACC(bf16, WB, WS_W) KP_ACC(bf16, XB, WS_XB) KP_ACC(bf16, H, R_H) KP_ACC(bf16, HE, R_HE) KP_ACC(bf16, VT, R_VT) KP_ACC(bf16, QM, R_QM)
    KP_ACC(bf16, KN, R_KN) KP_ACC(bf16, VMT, R_VMT) KP_ACC(bf16, OE, R_OE) KP_ACC(bf16, KROT, R_KROT) KP_ACC(bf16, HC, R_HC) KP_ACC(bf16, KCC, R_KCC)
    KP_ACC(bf16, VCT, R_VCT) KP_ACC(bf16, QK, R_QK) KP_ACC(bf16, VOT, R_VOT) KP_ACC(bf16, OG, R_OG) KP_ACC(bf16, OO, R_OO)
    KP_ACC(float, RT, R_RT) KP_ACC(float, GT, R_GT) KP_ACC(float, RSTD, R_RSTD) KP_ACC(float, LSE, R_LSE) KP_ACC(float, CB, WS_CB) KP_ACC(unsigned, CTL, WS_CTL)
};

__device__ __forceinline__ int crow(int v, int hi) { return (v & 3) + 8 * (v >> 2) + 4 * hi; }
__device__ __forceinline__ float xhalf_max(float x) { auto rr = __builtin_amdgcn_permlane32_swap(__float_as_uint(x), __float_as_uint(x), false, false); return fmaxf(__uint_as_float(rr[0]), __uint_as_float(rr[1])); }
__device__ __forceinline__ float xhalf_sum(float x) { auto rr = __builtin_amdgcn_permlane32_swap(__float_as_uint(x), __float_as_uint(x), false, false); return __uint_as_float(rr[0]) + __uint_as_float(rr[1]); }
__device__ __forceinline__ float max16(const f32x16& s) {
    float a = fmaxf(fmaxf(s[0], s[1]), s[2]), b = fmaxf(fmaxf(s[3], s[4]), s[5]);
    a = fmaxf(fmaxf(a, s[6]), s[7]); b = fmaxf(fmaxf(b, s[8]), s[9]); a = fmaxf(fmaxf(a, s[10]), s[11]); b = fmaxf(fmaxf(b, s[12]), s[13]);
    return fmaxf(fmaxf(a, b), fmaxf(s[14], s[15])); }

template <int DK16>
__device__ __forceinline__ f32x16 qk_sub(const LAS unsigned char* Kt, int ks, int sub, const bf16x8 (&qf)[DK16], int r32, int hi) {
    f32x16 s;
#pragma unroll
    for (int v = 0; v < 16; ++v) s[v] = 0.f;
    const LAS unsigned char* p = Kt + (sub * 32 + r32) * ks + hi * 16;
#pragma unroll
    for (int dk = 0; dk < DK16; ++dk) { const bf16x8 kf = *(const LAS bf16x8*)(p + dk * 32); s = __builtin_amdgcn_mfma_f32_32x32x16_bf16(kf, qf[dk], s, 0, 0, 0); }
    return s;
}
template <int DV32>
__device__ __forceinline__ void pv_sub(f32x16 (&o)[DV32], const LAS unsigned char* Vt, int vs, int sub, const f32x16& p, int r32, int hi) {
#pragma unroll
    for (int kb = 0; kb < 2; ++kb) {
        u32x4 pw; pw.x = cvt_pk_bf16(p[8 * kb + 0], p[8 * kb + 1]); pw.y = cvt_pk_bf16(p[8 * kb + 2], p[8 * kb + 3]); pw.z = cvt_pk_bf16(p[8 * kb + 4], p[8 * kb + 5]); pw.w = cvt_pk_bf16(p[8 * kb + 6], p[8 * kb + 7]);
        const bf16x8 pf = __builtin_bit_cast(bf16x8, pw);
#pragma unroll
        for (int i = 0; i < DV32; ++i) {
            const bf16x8 vf = *(const LAS bf16x8*)(Vt + (32 * i + r32) * vs + sub * 64 + kb * 32 + hi * 16);
            o[i] = __builtin_amdgcn_mfma_f32_32x32x16_bf16(vf, pf, o[i], 0, 0, 0);
        }
    }
}
template <int DV32>
__device__ __forceinline__ void pv_packed(f32x16 (&o)[DV32], const LAS unsigned char* Vt, int vs, int sub, const u32x4& pk0, const u32x4& pk1, int r32, int hi) {
#pragma unroll
    for (int kb = 0; kb < 2; ++kb) {
        const bf16x8 pf = __builtin_bit_cast(bf16x8, kb == 0 ? pk0 : pk1);
#pragma unroll
        for (int i = 0; i < DV32; ++i) {
            const bf16x8 vf = *(const LAS bf16x8*)(Vt + (32 * i + r32) * vs + sub * 64 + kb * 32 + hi * 16);
            o[i] = __builtin_amdgcn_mfma_f32_32x32x16_bf16(vf, pf, o[i], 0, 0, 0);
        }
    }
}
__device__ __forceinline__ u32x4 pack8(const f32x16& p, int kb) {
    u32x4 pw; pw.x = cvt_pk_bf16(p[8 * kb + 0], p[8 * kb + 1]); pw.y = cvt_pk_bf16(p[8 * kb + 2], p[8 * kb + 3]); pw.z = cvt_pk_bf16(p[8 * kb + 4], p[8 * kb + 5]); pw.w = cvt_pk_bf16(p[8 * kb + 6], p[8 * kb + 7]); return pw; }
template <int D, int DV, int MODE, bool HASBIAS, bool JOINT, bool DEFER, class KA, class VA, class PF, class BF, class VF, class NM, class WS, class CB>
__device__ __forceinline__ void fa_loop(LAS unsigned char* lds, int nt, const KA& ka, const VA& va, const PF& pf, const BF& bf, const VF& vf, const NM& nm, const WS& wskip, const CB& cb, float c1,
                                        const bf16x8 (&qf)[D / 16], float& m, float& l, f32x16 (&o)[DV / 32], int tid_in, int r32, int hi) {
    int tid = tid_in; asm volatile("" : "+v"(tid));
    constexpr int KS = D * 2 + 16, VS = 144, KCH = D / 8, NKR = (64 * KCH + 511) / 512, NVR = (DV * 8) / 512, NVS = DEFER ? 3 : 2, KOFF = 0, VOFF = 2 * 64 * KS, POFF = VOFF + NVS * DV * VS;
    constexpr bool NEEDV = (MODE != 1);
    u32x4 kregA[NKR], kregB[NKR]; u32x4 vregA[NVR], vregB[NVR]; float pregA = 0.f, pregB = 0.f;
    if (nt <= 0) return;
#define FA_LOAD(t_, KR, VR, PR) do { \
    _Pragma("unroll") for (int r_ = 0; r_ < NKR; ++r_) { const int idx_ = tid + 512 * r_; if (idx_ < 64 * KCH) { const int row_ = idx_ / KCH, ch_ = idx_ % KCH; KR[r_] = *(const u32x4*)ka((t_), row_, ch_); } } \
    if (NEEDV) { _Pragma("unroll") for (int r_ = 0; r_ < NVR; ++r_) { const int idx_ = tid + 512 * r_; const int d_ = idx_ >> 3, ch_ = idx_ & 7; VR[r_] = *(const u32x4*)va((t_), d_, ch_); } } \
    if (HASBIAS) { if (tid < 64) PR = pf((t_), tid); } } while (0)
#define FA_STORE(tt_, KR, VR, PR) do { LAS unsigned char* kb_ = lds + KOFF + ((tt_) & 1) * (64 * KS); LAS unsigned char* vb_ = lds + VOFF + ((tt_) % NVS) * (DV * VS); \
    _Pragma("unroll") for (int r_ = 0; r_ < NKR; ++r_) { const int idx_ = tid + 512 * r_; if (idx_ < 64 * KCH) { const int row_ = idx_ / KCH, ch_ = idx_ % KCH; *(LAS u32x4*)(kb_ + row_ * KS + ch_ * 16) = KR[r_]; } } \
    if (NEEDV) { _Pragma("unroll") for (int r_ = 0; r_ < NVR; ++r_) { const int idx_ = tid + 512 * r_; const int d_ = idx_ >> 3, ch_ = idx_ & 7; LAS unsigned char* q_ = vb_ + d_ * VS + (ch_ >> 2) * 64 + ((ch_ & 2) << 4) + ((ch_ & 1) << 3); *(LAS u32x2*)q_ = (u32x2){VR[r_].x, VR[r_].y}; *(LAS u32x2*)(q_ + 16) = (u32x2){VR[r_].z, VR[r_].w}; } } \
    if (HASBIAS) { if (tid < 64) *(LAS float*)(lds + POFF + ((tt_) & 1) * 256 + tid * 4) = PR; } } while (0)
    const bool defer_wave = DEFER && (tid_in >= 256);
    u32x4 pp0 = {0u, 0u, 0u, 0u}, pp1 = pp0, pp2 = pp0, pp3 = pp0; int pend = -1;
    auto compute = [&](int t, int bufi) __attribute__((always_inline)) {
        const LAS unsigned char* cur = lds + KOFF + (t & 1) * (64 * KS);
        const int vslot = t % NVS; const LAS unsigned char* curv = lds + VOFF + vslot * (DV * VS);
        const LAS float* kp = (const LAS float*)(lds + POFF + (t & 1) * 256);
        if (DEFER) { if (pend >= 0) { const LAS unsigned char* pv_ = lds + VOFF + pend * (DV * VS); pv_packed<DV / 32>(o, pv_, VS, 0, pp0, pp1, r32, hi); pv_packed<DV / 32>(o, pv_, VS, 1, pp2, pp3, r32, hi); pend = -1; } }
        const bool sk0 = wskip(t, 0), sk1 = wskip(t, 1);
        if (JOINT && MODE != 2 && !sk0 && !sk1) {
            f32x16 s0 = qk_sub<D / 16>(cur, KS, 0, qf, r32, hi); if (DEFER) __builtin_amdgcn_sched_barrier(0); f32x16 s1 = qk_sub<D / 16>(cur, KS, 1, qf, r32, hi);
            if (HASBIAS) {
#pragma unroll
                for (int a4 = 0; a4 < 4; ++a4) { const int kin0 = 8 * a4 + 4 * hi; const f32x4 kq0 = *(const LAS f32x4*)(kp + kin0), kq1 = *(const LAS f32x4*)(kp + 32 + kin0);
#pragma unroll
                    for (int e = 0; e < 4; ++e) { s0[4 * a4 + e] = s0[4 * a4 + e] * c1 + bf(t, kin0 + e, kq0[e]); s1[4 * a4 + e] = s1[4 * a4 + e] * c1 + bf(t, 32 + kin0 + e, kq1[e]); } }
            }
            const bool masked = nm(t, 0) || nm(t, 1);
            if (masked) {
#pragma unroll
                for (int v = 0; v < 16; ++v) { const int kin = crow(v, hi); if (!vf(t, kin)) s0[v] = NEGB; if (!vf(t, 32 + kin)) s1[v] = NEGB; }
            }
            float mx = xhalf_max(fmaxf(max16(s0), max16(s1)));
            const float mn = fmaxf(m, mx); float sum0 = 0.f, sum1 = 0.f;
            if (masked) {
#pragma unroll
                for (int v = 0; v < 16; ++v) { const float p0 = s0[v] > -1e29f ? fast_exp2(s0[v] - mn) : 0.f, p1 = s1[v] > -1e29f ? fast_exp2(s1[v] - mn) : 0.f; s0[v] = p0; s1[v] = p1; sum0 += p0; sum1 += p1; }
            } else {
#pragma unroll
                for (int v = 0; v < 16; ++v) { const float p0 = fast_exp2(s0[v] - mn), p1 = fast_exp2(s1[v] - mn); s0[v] = p0; s1[v] = p1; sum0 += p0; sum1 += p1; }
            }
            if (__any(mn > m)) {
                const float alpha = fast_exp2(m - mn); l *= alpha;
                if (MODE == 0) {
#pragma unroll
                    for (int i = 0; i < DV / 32; ++i)
#pragma unroll
                        for (int v = 0; v < 16; ++v) o[i][v] *= alpha;
                }
            }
            l += sum0 + sum1; m = mn;
            if (MODE == 0) {
                if (defer_wave) { pp0 = pack8(s0, 0); pp1 = pack8(s0, 1); pp2 = pack8(s1, 0); pp3 = pack8(s1, 1); pend = vslot; }
                else { pv_sub<DV / 32>(o, curv, VS, 0, s0, r32, hi); pv_sub<DV / 32>(o, curv, VS, 1, s1, r32, hi); }
            }
        } else
#pragma unroll
        for (int sub = 0; sub < 2; ++sub) {
            if (!wskip(t, sub)) {
                f32x16 s = qk_sub<D / 16>(cur, KS, sub, qf, r32, hi);
                if (HASBIAS) {
#pragma unroll
                    for (int a4 = 0; a4 < 4; ++a4) { const int kin0 = sub * 32 + 8 * a4 + 4 * hi; const f32x4 kq = *(const LAS f32x4*)(kp + kin0);
#pragma unroll
                        for (int e = 0; e < 4; ++e) s[4 * a4 + e] = s[4 * a4 + e] * c1 + bf(t, kin0 + e, kq[e]); }
                }
                const bool masked = nm(t, sub);
                if (masked) {
#pragma unroll
                    for (int v = 0; v < 16; ++v) { const int kin = sub * 32 + crow(v, hi); if (!vf(t, kin)) s[v] = NEGB; }
                }
                if (MODE == 2) {
                    if (masked) {
#pragma unroll
                        for (int v = 0; v < 16; ++v) s[v] = s[v] > -1e29f ? fast_exp2(s[v] - m) * l : 0.f;
                    } else {
#pragma unroll
                        for (int v = 0; v < 16; ++v) s[v] = fast_exp2(s[v] - m) * l;
                    }
                    cb(t, sub, s);
                    pv_sub<DV / 32>(o, curv, VS, sub, s, r32, hi);
                } else {
                    float mx0 = fmaxf(fmaxf(s[0], s[1]), s[2]), mx1 = fmaxf(fmaxf(s[3], s[4]), s[5]);
                    mx0 = fmaxf(fmaxf(mx0, s[6]), s[7]); mx1 = fmaxf(fmaxf(mx1, s[8]), s[9]); mx0 = fmaxf(fmaxf(mx0, s[10]), s[11]); mx1 = fmaxf(fmaxf(mx1, s[12]), s[13]);
                    float mx = fmaxf(fmaxf(mx0, mx1), fmaxf(s[14], s[15]));
                    mx = xhalf_max(mx);
                    const float mn = fmaxf(m, mx); float sum = 0.f;
                    if (masked) {
#pragma unroll
                        for (int v = 0; v < 16; ++v) { const float p = s[v] > -1e29f ? fast_exp2(s[v] - mn) : 0.f; s[v] = p; sum += p; }
                    } else {
#pragma unroll
                        for (int v = 0; v < 16; ++v) { const float p = fast_exp2(s[v] - mn); s[v] = p; sum += p; }
                    }
                    if (__any(mn > m)) {
                        const float alpha = fast_exp2(m - mn); l *= alpha;
                        if (MODE == 0) {
#pragma unroll
                            for (int i = 0; i < DV / 32; ++i)
#pragma unroll
                                for (int v = 0; v < 16; ++v) o[i][v] *= alpha;
                        }
                    }
                    l += sum; m = mn;
                    if (MODE == 0) pv_sub<DV / 32>(o, curv, VS, sub, s, r32, hi);
                }
            }
        }
    };
    if (DEFER) {
        FA_LOAD(0, kregA, vregA, pregA); FA_STORE(0, kregA, vregA, pregA); __syncthreads();
        for (int t = 0; t < nt; ++t) {
            asm volatile("" : "+v"(tid));
            if (t + 1 < nt) FA_LOAD(t + 1, kregA, vregA, pregA);
            compute(t, 0);
            asm volatile("" : "+v"(tid));
            if (t + 1 < nt) FA_STORE(t + 1, kregA, vregA, pregA);
            __syncthreads();
        }
    } else {
    FA_LOAD(0, kregA, vregA, pregA); FA_STORE(0, kregA, vregA, pregA); if (nt > 1) FA_LOAD(1, kregB, vregB, pregB); __syncthreads();
    for (int t = 0; t < nt; t += 2) {
        if (t + 2 < nt) FA_LOAD(t + 2, kregA, vregA, pregA);
        compute(t, 0);
        if (t + 1 < nt) FA_STORE(t + 1, kregB, vregB, pregB);
        __syncthreads();
        if (t + 1 < nt) {
            if (t + 3 < nt) FA_LOAD(t + 3, kregB, vregB, pregB);
            compute(t + 1, 1);
            if (t + 2 < nt) FA_STORE(t + 2, kregA, vregA, pregA);
            __syncthreads();
        }
    }
    }
    if (DEFER) { if (pend >= 0) { const LAS unsigned char* pv_ = lds + VOFF + pend * (DV * VS); pv_packed<DV / 32>(o, pv_, VS, 0, pp0, pp1, r32, hi); pv_packed<DV / 32>(o, pv_, VS, 1, pp2, pp3, r32, hi); }
        __syncthreads(); }
#undef FA_LOAD
#undef FA_STORE
}
template <int NV>
__device__ __forceinline__ void store_o(bf16* op, const f32x16 (&o)[NV], float sc, int hi) {
#pragma unroll
    for (int i = 0; i < NV; ++i)
#pragma unroll
        for (int a = 0; a < 4; ++a) {
            u32x2 wv; wv.x = cvt_pk_bf16(o[i][4 * a] * sc, o[i][4 * a + 1] * sc); wv.y = cvt_pk_bf16(o[i][4 * a + 2] * sc, o[i][4 * a + 3] * sc);
            *(u32x2*)(op + 32 * i + 8 * a + 4 * hi) = wv;
        }
}
struct NoCb { __device__ __forceinline__ void operator()(int, int, const f32x16&) const {} };

__device__ __forceinline__ void mla_unit(const KP& P, LAS unsigned char* lds, int b, int h, int qb, int tid_u) {
    int tid = tid_u; asm volatile("" : "+v"(tid));
    const int* const posp = P.pos_local();
    const int lane = tid & 63, w = __builtin_amdgcn_readfirstlane(tid >> 6), r32 = lane & 31, hi = lane >> 5;
    const int q0 = qb * 256, tq = q0 + 32 * w + r32; const size_t bS = (size_t)b * SEQ, tok = bS + tq;
    bf16x8 qf[6];
#pragma unroll
    for (int dk = 0; dk < 6; ++dk) qf[dk] = *(const bf16x8*)(P.QM() + tok * 768 + h * 96 + dk * 16 + hi * 8);
    const int nt = (q0 + 256) / 64;
    auto ka = [&](int t, int row, int ch) -> const bf16* { const size_t tk = bS + 64 * t + row; return ch < 8 ? P.KN() + tk * 512 + h * 64 + ch * 8 : P.KROT() + tk * 32 + (ch - 8) * 8; };
    auto va = [&](int t, int d, int ch) -> const bf16* { return P.VMT() + (size_t)(h * 64 + d) * T + bS + 64 * t + ch * 8; };
    auto pf = [&](int, int) -> float { return 0.f; };
    auto bf = [&](int, int, float) -> float { return 0.f; };
    auto vf = [&](int t, int kin) -> bool { return 64 * t + kin <= tq; };
    const int wq_lo = q0 + 32 * w, wq_hi = wq_lo + 31;
    auto nm = [&](int t, int sub) -> bool { return 64 * t + 32 * sub + 31 > wq_lo; };
    auto ws = [&](int t, int sub) -> bool { return 64 * t + 32 * sub > wq_hi; };
    float m = NEGB, l = 0.f; f32x16 o[2];
#pragma unroll
    for (int i = 0; i < 2; ++i)
#pragma unroll
        for (int v = 0; v < 16; ++v) o[i][v] = 0.f;
    fa_loop<96, 64, 0, false, true, false>(lds, nt, ka, va, pf, bf, vf, nm, ws, NoCb(), 1.f, qf, m, l, o, tid, r32, hi);
    l = xhalf_sum(l); const float inv = l > 0.f ? 1.f / l : 0.f;
    store_o<2>(P.OE() + tok * 1024 + h * 64, o, inv, hi);
}

constexpr int NSA_GL = 40960, NSA_SELM = NSA_GL + 8 * 2 * 8 * 132 * 4, NSA_BU = NSA_SELM + 1024, NSA_TL = NSA_BU + 32;
__device__ __forceinline__ void nsa_unit(const KP& P, LAS unsigned char* lds, int b, int c, int g, int tid_u) {
    int tid = tid_u; asm volatile("" : "+v"(tid));
    const int* const posp = P.pos_local();
    const int lane = tid & 63, w = __builtin_amdgcn_readfirstlane(tid >> 6), r32 = lane & 31, hi = lane >> 5;
    const int n = r32 >> 3, qi = r32 & 7, hh = g * 4 + n;
    const int tq = 64 * c + 8 * w + qi; const size_t bS = (size_t)b * SEQ, tok = bS + tq;
    const float slope2 = fast_exp2(-(float)(hh + 1)) * LOG2E, c1 = 0.125f * LOG2E;
    const float pq = (float)posp[tok], nbq = -slope2 * pq;
    bf16x8 qf[4];
#pragma unroll
    for (int dk = 0; dk < 4; ++dk) qf[dk] = *(const bf16x8*)(P.HE() + tok * HE_LD + HE_Q + hh * 64 + dk * 16 + hi * 8);
    LAS float* GLw = (LAS float*)(lds + NSA_GL) + w * (2 * 8 * 132);
    LAS unsigned long long* SELM = (LAS unsigned long long*)(lds + NSA_SELM);
    LAS unsigned* BU = (LAS unsigned*)(lds + NSA_BU);
    LAS int* TL = (LAS int*)(lds + NSA_TL);
    for (int i = tid; i < 8 * 2 * 8 * 132; i += 512) ((LAS float*)(lds + NSA_GL))[i] = 0.f;
    if (tid < 8) BU[tid] = 0u;
    __syncthreads();
    const int wq_lo = 64 * c + 8 * w, wq_hi = wq_lo + 7;
    f32x16 o[2];
#pragma unroll
    for (int i = 0; i < 2; ++i)
#pragma unroll
        for (int v = 0; v < 16; ++v) o[i][v] = 0.f;
    LAS float* stash = (LAS float*)(lds + NSA_GL) + tid;
    {
        const int nt1 = (4 * c + 3 + 63) >> 6;
        auto ka1 = [&](int t, int row, int ch) -> const bf16* { return P.KCC() + ((size_t)b * 512 + 64 * t + row) * 128 + g * 64 + ch * 8; };
        auto va1 = [&](int t, int d, int ch) -> const bf16* { return P.VCT() + (size_t)(g * 64 + d) * 8192 + b * 512 + 64 * t + ch * 8; };
        auto pf1 = [&](int t, int i) -> float { int j = 64 * t + i; j = j > 510 ? 510 : j; return (float)posp[bS + 31 + 16 * j]; };
        auto bf1 = [&](int, int, float kp) -> float { return kp * slope2 + nbq; };
        auto vf1 = [&](int t, int kin) -> bool { const int j = 64 * t + kin; return 16 * j + 31 <= tq; };
        auto nm1 = [&](int t, int sub) -> bool { return 16 * (64 * t + 32 * sub + 31) + 31 > wq_lo; };
        auto ws1 = [&](int t, int sub) -> bool { return 16 * (64 * t + 32 * sub) + 31 > wq_hi; };
        float m1 = NEGB, l1 = 0.f;
        fa_loop<64, 64, 1, true, false, false>(lds, nt1, ka1, va1, pf1, bf1, vf1, nm1, ws1, NoCb(), c1, qf, m1, l1, o, tid, r32, hi);
        l1 = xhalf_sum(l1); float invl = l1 > 0.f ? 1.f / l1 : 0.f;
        auto cb1 = [&](int t, int sub, const f32x16& p) {
#pragma unroll
            for (int a = 0; a < 4; ++a) {
                float gsum = (p[4 * a] + p[4 * a + 1]) + (p[4 * a + 2] + p[4 * a + 3]), last = p[4 * a + 3];
                gsum += __shfl_xor(gsum, 8); gsum += __shfl_xor(gsum, 16); last += __shfl_xor(last, 8); last += __shfl_xor(last, 16);
                const int u = (64 * t + 32 * sub) / 4 + 2 * a + hi;
                if (r32 < 8) { GLw[qi * 132 + u] = gsum; GLw[8 * 132 + qi * 132 + u + 1] = last; }
            }
        };
        fa_loop<64, 64, 2, true, false, false>(lds, nt1, ka1, va1, pf1, bf1, vf1, nm1, ws1, cb1, c1, qf, m1, invl, o, tid, r32, hi);
        const float gtc = P.GT()[tok * 24 + hh];
#pragma unroll
        for (int i = 0; i < 2; ++i)
#pragma unroll
            for (int v = 0; v < 16; ++v) o[i][v] *= gtc;
    }
    unsigned long long wu0 = 0ull, wu1 = 0ull;
    {
        const int ncand = c - 1 > 0 ? c - 1 : 0, need = 16 - (c == 0 ? 1 : 2);
        for (int q = 0; q < 8; ++q) {
            const int s0 = lane, s1 = lane + 64;
            const bool c0 = (s0 >= 1) && (s0 <= c - 1), cc1 = (s1 <= c - 1);
            const float f0 = c0 ? GLw[q * 132 + s0] + GLw[8 * 132 + q * 132 + s0] : 0.f;
            const float f1 = cc1 ? GLw[q * 132 + s1] + GLw[8 * 132 + q * 132 + s1] : 0.f;
            const unsigned b0 = __float_as_uint(f0), b1 = __float_as_uint(f1);
            unsigned long long sel0, sel1;
            if (ncand <= need) { sel0 = __ballot(c0); sel1 = __ballot(cc1); }
            else {
                unsigned x = 0u;
                for (int bit = 30; bit >= 0; --bit) {
                    const unsigned tt = x | (1u << bit);
                    const int cnt = __popcll(__ballot(c0 && b0 >= tt)) + __popcll(__ballot(cc1 && b1 >= tt));
                    if (cnt >= need) x = tt;
                }
                sel0 = __ballot(c0 && b0 > x); sel1 = __ballot(cc1 && b1 > x);
                int rem = need - (__popcll(sel0) + __popcll(sel1));
                unsigned long long e0 = __ballot(c0 && b0 == x), e1 = __ballot(cc1 && b1 == x);
                while (rem > 0 && e0) { const unsigned long long low = e0 & (~e0 + 1ull); sel0 |= low; e0 ^= low; --rem; }
                while (rem > 0 && e1) { const unsigned long long low = e1 & (~e1 + 1ull); sel1 |= low; e1 ^= low; --rem; }
            }
            sel0 |= 1ull; if (c < 64) sel0 |= 1ull << c; else sel1 |= 1ull << (c - 64);
            if (lane == 0) { SELM[(w * 8 + q) * 2] = sel0; SELM[(w * 8 + q) * 2 + 1] = sel1; }
            wu0 |= sel0; wu1 |= sel1;
        }
        if (lane == 0) { atomicOr((unsigned*)&BU[0], (unsigned)wu0); atomicOr((unsigned*)&BU[1], (unsigned)(wu0 >> 32)); atomicOr((unsigned*)&BU[2], (unsigned)wu1); atomicOr((unsigned*)&BU[3], (unsigned)(wu1 >> 32)); }
    }
    __syncthreads();
#pragma unroll
    for (int i = 0; i < 2; ++i)
#pragma unroll
        for (int v = 0; v < 16; ++v) { stash[(i * 16 + v) * 512] = o[i][v]; o[i][v] = 0.f; }
    if (tid < 128) {
        const unsigned u0 = BU[0], u1 = BU[1], u2 = BU[2], u3 = BU[3];
        const int k = tid >> 5; const unsigned wk = k == 0 ? u0 : (k == 1 ? u1 : (k == 2 ? u2 : u3));
        if ((wk >> (tid & 31)) & 1u) {
            int pos = __popc(wk & ((1u << (tid & 31)) - 1u));
            if (k > 0) pos += __popc(u0); if (k > 1) pos += __popc(u1); if (k > 2) pos += __popc(u2);
            TL[pos] = tid;
        }
        if (tid == 0) BU[4] = __popc(u0) + __popc(u1) + __popc(u2) + __popc(u3);
    }
    __syncthreads();
    const unsigned long long ms0 = SELM[(w * 8 + qi) * 2], ms1 = SELM[(w * 8 + qi) * 2 + 1];
    {
        const int nsel = (int)BU[4];
        auto ka2 = [&](int t, int row, int ch) -> const bf16* { const int sb = TL[t]; return P.HE() + (bS + 64 * sb + row) * HE_LD + HE_KS + g * 64 + ch * 8; };
        auto va2 = [&](int t, int d, int ch) -> const bf16* { const int sb = TL[t]; return P.VT() + (size_t)(g * 64 + d) * T + bS + 64 * sb + ch * 8; };
        auto pf2 = [&](int t, int i) -> float { const int sb = TL[t]; return (float)posp[bS + 64 * sb + i]; };
        auto bf2 = [&](int, int, float kp) -> float { return kp * slope2 + nbq; };
        auto vf2 = [&](int t, int kin) -> bool { const int sb = TL[t]; const bool selb = (((sb < 64 ? ms0 : ms1) >> (sb & 63)) & 1ull) != 0ull; return selb && (64 * sb + kin <= tq); };
        auto nm2 = [&](int t, int) -> bool { const int sb = TL[t]; const bool selb = (((sb < 64 ? ms0 : ms1) >> (sb & 63)) & 1ull) != 0ull; return sb == c || !__all(selb); };
        auto ws2 = [&](int t, int) -> bool { const int sb = TL[t]; return (((sb < 64 ? wu0 : wu1) >> (sb & 63)) & 1ull) == 0ull; };
        float m2 = NEGB, l2 = 0.f;
        fa_loop<64, 64, 0, true, false, false>(lds, nsel, ka2, va2, pf2, bf2, vf2, nm2, ws2, NoCb(), c1, qf, m2, l2, o, tid, r32, hi);
        l2 = xhalf_sum(l2); const float gts = P.GT()[tok * 24 + 8 + hh]; const float sc = l2 > 0.f ? gts / l2 : 0.f;
#pragma unroll
        for (int i = 0; i < 2; ++i)
#pragma unroll
            for (int v = 0; v < 16; ++v) { stash[(i * 16 + v) * 512] += o[i][v] * sc; o[i][v] = 0.f; }
    }
    {
        const int first = c < 8 ? 8 - c : 0, nt3 = 9 - first, base3 = 64 * c - 512 + 64 * first;
        auto ka3 = [&](int t, int row, int ch) -> const bf16* { return P.HE() + (bS + base3 + 64 * t + row) * HE_LD + HE_KW + g * 64 + ch * 8; };
        auto va3 = [&](int t, int d, int ch) -> const bf16* { return P.VT() + (size_t)(128 + g * 64 + d) * T + bS + base3 + 64 * t + ch * 8; };
        auto pf3 = [&](int t, int i) -> float { return (float)posp[bS + base3 + 64 * t + i]; };
        auto bf3 = [&](int, int, float kp) -> float { return kp * slope2 + nbq; };
        auto vf3 = [&](int t, int kin) -> bool { const int df = tq - (base3 + 64 * t + kin); return df >= 0 && df < 512; };
        auto nm3 = [&](int t, int sub) -> bool { const int k0 = base3 + 64 * t + 32 * sub; return k0 + 31 > wq_lo || k0 < wq_hi - 511; };
        auto ws3 = [&](int t, int sub) -> bool { const int k0 = base3 + 64 * t + 32 * sub; return k0 > wq_hi || k0 + 31 < wq_lo - 511; };
        float m3 = NEGB, l3 = 0.f;
        fa_loop<64, 64, 0, true, false, false>(lds, nt3, ka3, va3, pf3, bf3, vf3, nm3, ws3, NoCb(), c1, qf, m3, l3, o, tid, r32, hi);
        l3 = xhalf_sum(l3); const float gtw = P.GT()[tok * 24 + 16 + hh]; const float sc = l3 > 0.f ? gtw / l3 : 0.f;
#pragma unroll
        for (int i = 0; i < 2; ++i)
#pragma unroll
            for (int v = 0; v < 16; ++v) o[i][v] = o[i][v] * sc + stash[(i * 16 + v) * 512];
    }
    store_o<2>(P.OE() + tok * 1024 + 512 + hh * 64, o, 1.f, hi);
}

__device__ __forceinline__ void dil_unit(const KP& P, LAS unsigned char* lds, int b, int g, int h, int rj, int tid_u) {
    int tid = tid_u; asm volatile("" : "+v"(tid));
    const int* const posp = P.pos_local();
    const int lane = tid & 63, w = __builtin_amdgcn_readfirstlane(tid >> 6), r32 = lane & 31, hi = lane >> 5;
    const int dil = g == 0 ? 1 : (g == 1 ? 4 : 16), per = 32 / dil, r = rj / per, jt = rj % per, clen = SEQ / dil;
    const int J = 256 * jt + 32 * w + r32; const size_t bS = (size_t)b * SEQ, tok = bS + r + dil * J;
    const float slope2 = fast_exp2(-8.f * (float)(g * 4 + h + 1) / 12.f) * LOG2E, c1 = 0.08838834764831845f * LOG2E;
    const float pq = (float)posp[tok], nbq = -slope2 * pq;
    bf16x8 qf[8];
#pragma unroll
    for (int dk = 0; dk < 8; ++dk) qf[dk] = *(const bf16x8*)(P.QK() + tok * 3072 + g * 512 + h * 128 + dk * 16 + hi * 8);
    const int first = jt == 0 ? 2 : 0, nt = 6 - first, I00 = 256 * jt - 128 + 64 * first;
    auto ka = [&](int t, int row, int ch) -> const bf16* { return P.QK() + (bS + r + (size_t)dil * (I00 + 64 * t + row)) * 3072 + 1536 + g * 512 + h * 128 + ch * 8; };
    auto va = [&](int t, int d, int ch) -> const bf16* { return P.VOT() + (size_t)(g * 512 + h * 128 + d) * T + bS + (size_t)r * clen + I00 + 64 * t + ch * 8; };
    auto pf = [&](int t, int i) -> float { return (float)posp[bS + r + dil * (I00 + 64 * t + i)]; };
    auto bf = [&](int, int, float kp) -> float { return kp * slope2 + nbq; };
    auto vf = [&](int t, int kin) -> bool { const int df = J - (I00 + 64 * t + kin); return df >= 0 && df <= 128; };
    const int Jw = 256 * jt + 32 * w;
    auto nm = [&](int t, int sub) -> bool { const int i0 = I00 + 64 * t + 32 * sub; return i0 + 31 > Jw || i0 < Jw + 31 - 128; };
    auto ws = [&](int t, int sub) -> bool { const int i0 = I00 + 64 * t + 32 * sub; return i0 > Jw + 31 || i0 + 31 < Jw - 128; };
    float m = NEGB, l = 0.f; f32x16 o[4];
#pragma unroll
    for (int i = 0; i < 4; ++i)
#pragma unroll
        for (int v = 0; v < 16; ++v) o[i][v] = 0.f;
    fa_loop<128, 128, 0, true, false, false>(lds, nt, ka, va, pf, bf, vf, nm, ws, NoCb(), c1, qf, m, l, o, tid, r32, hi);
    l = xhalf_sum(l); const float inv = l > 0.f ? 1.f / l : 0.f;
    store_o<4>(P.OG() + ((size_t)g * T + tok) * 512 + h * 128, o, inv, hi);
    if (hi == 0) P.LSE()[((size_t)g * T + tok) * 4 + h] = m + __log2f(l);
}
struct Args { const float* in[28]; float* out; unsigned char* ws; int ph_lo, ph_hi; };

enum { WM_ID = 0, WM_SWIGLU = 1, WM_E1 = 2, WM_E2 = 3, WM_UQ = 4 };
struct WSpec { const float* W; const float* W2; const float* gk; bf16* WT; int K, Nsrc, Ndst, mode, soff, nvalid; };
__device__ __forceinline__ void transpose_item(const WSpec& s, LAS float* scr, int item, int lane) {
    const int nblk = s.Ndst / 32, kb = item / nblk, nb = item % nblk, k0 = 128 * kb, n0 = 32 * nb;
    const int R = n0 + (lane & 31); int sc; const float* Wp = s.W;
    if (s.mode == WM_ID) sc = R < s.nvalid ? R + s.soff : -1;
    else if (s.mode == WM_SWIGLU) { sc = (R >> 8) * 128 + (R & 127); if ((R >> 7) & 1) Wp = s.W2; }
    else if (s.mode == WM_E1) sc = R < 1568 ? R : (R < 1696 ? R + 128 : (R < 1720 ? R + 256 : -1));
    else if (s.mode == WM_E2) sc = R < 128 ? 1568 + R : 1824 + (R - 128);
    else { const int h = R / 96, wq = R % 96; if (wq < 64) sc = R; else { const int p = wq - 64, fq = p >> 3, sub = p & 7; sc = 96 * h + 64 + (sub < 4 ? 4 * fq + sub : 16 + 4 * fq + (sub - 4)); } }
    if (s.mode != WM_UQ) {
        const int c4 = (lane & 7) * 4, R4 = n0 + c4; int sc4; const float* Wq = s.W;
        if (s.mode == WM_ID) sc4 = R4 < s.nvalid ? R4 + s.soff : -1;
        else if (s.mode == WM_SWIGLU) { sc4 = (R4 >> 8) * 128 + (R4 & 127); if ((R4 >> 7) & 1) Wq = s.W2; }
        else if (s.mode == WM_E1) sc4 = R4 < 1568 ? R4 : (R4 < 1696 ? R4 + 128 : (R4 < 1720 ? R4 + 256 : -1));
        else sc4 = R4 < 128 ? 1568 + R4 : 1824 + (R4 - 128);
        const float msk = sc4 >= 0 ? 1.f : 0.f; const int sc4c = sc4 >= 0 ? sc4 : 0;
        f32x4 vv[16];
#pragma unroll
        for (int i = 0; i < 16; ++i) { const int kk = 8 * i + (lane >> 3); vv[i] = *(const f32x4*)(Wq + (size_t)(k0 + kk) * s.Nsrc + sc4c); }
        if (s.gk) {
#pragma unroll
            for (int i = 0; i < 16; ++i) { const int kk = 8 * i + (lane >> 3); vv[i] = vv[i] * s.gk[k0 + kk]; }
        }
#pragma unroll
        for (int i = 0; i < 16; ++i) { const int kk = 8 * i + (lane >> 3); const f32x4 v = vv[i] * msk;
            scr[kk * 33 + c4] = v[0]; scr[kk * 33 + c4 + 1] = v[1]; scr[kk * 33 + c4 + 2] = v[2]; scr[kk * 33 + c4 + 3] = v[3]; }
    } else {
        float vs[64];
#pragma unroll
        for (int i = 0; i < 64; ++i) { const int kk = 2 * i + (lane >> 5); vs[i] = Wp[(size_t)(k0 + kk) * s.Nsrc + sc]; }
#pragma unroll
        for (int i = 0; i < 64; ++i) { const int kk = 2 * i + (lane >> 5); scr[kk * 33 + (lane & 31)] = vs[i] * s.gk[k0 + kk]; }
    }
    asm volatile("s_waitcnt lgkmcnt(0)" ::: "memory");
    const int c = lane & 15;
#pragma unroll
    for (int j = 0; j < 8; ++j) { const int nn = (lane >> 4) + 4 * j; const LAS float* sp = scr + (8 * c) * 33 + nn;
        u32x4 o; o.x = cvt_pk_bf16(sp[0 * 33], sp[1 * 33]); o.y = cvt_pk_bf16(sp[2 * 33], sp[3 * 33]); o.z = cvt_pk_bf16(sp[4 * 33], sp[5 * 33]); o.w = cvt_pk_bf16(sp[6 * 33], sp[7 * 33]);
        *(u32x4*)(s.WT + (size_t)(n0 + nn) * s.K + k0 + 8 * c) = o; }
    asm volatile("s_waitcnt lgkmcnt(0)" ::: "memory");
}
__device__ __forceinline__ const float* ffn_w(const Args& a, int f, int which) {
    const int L = f >> 1; const bool second = (f & 1) != 0;
    const float* base = which == 0 ? (second ? a.in[23] : a.in[4]) : (which == 1 ? (second ? a.in[24] : a.in[5]) : (second ? a.in[25] : a.in[6]));
    return base + (size_t)L * 1024 * 2816;
}
__device__ __forceinline__ void p0_prologue(const Args& a, const KP& P, LAS unsigned char* lds, int tid, int gw, int NGW) {
    const int lane = tid & 63, w = tid >> 6;
    LAS float* scr = (LAS float*)(lds + w * 17408);
    int cum = 0;
    for (int wi = 0; wi < 21; ++wi) {
        WSpec s; s.W2 = nullptr; s.gk = nullptr; s.mode = WM_ID; s.soff = 0;
        if (wi < 4) { s.W = ffn_w(a, wi, 0); s.W2 = ffn_w(a, wi, 1); s.K = 1024; s.Nsrc = 2816; s.Ndst = 5632; s.mode = WM_SWIGLU; s.WT = P.WB() + WE_GU + (size_t)wi * 5632 * 1024; }
        else if (wi < 8) { s.W = ffn_w(a, wi - 4, 2); s.K = 2816; s.Nsrc = 1024; s.Ndst = 1024; s.WT = P.WB() + WE_D + (size_t)(wi - 4) * 1024 * 2816; }
        else if (wi == 8) { s.W = a.in[7]; s.K = 1024; s.Nsrc = 1976; s.Ndst = 1792; s.mode = WM_E1; s.WT = P.WB() + WE_E1; }
        else if (wi == 9) { s.W = a.in[7]; s.K = 1024; s.Nsrc = 1976; s.Ndst = 256; s.mode = WM_E2; s.WT = P.WB() + WE_E2; }
        else if (wi == 10) { s.W = a.in[10]; s.gk = a.in[8]; s.K = 384; s.Nsrc = 768; s.Ndst = 768; s.mode = WM_UQ; s.WT = P.WB() + WE_UQ; }
        else if (wi == 11) { s.W = a.in[11]; s.gk = a.in[9]; s.K = 256; s.Nsrc = 512; s.Ndst = 512; s.WT = P.WB() + WE_UK; }
        else if (wi == 12) { s.W = a.in[12]; s.gk = a.in[9]; s.K = 256; s.Nsrc = 512; s.Ndst = 512; s.WT = P.WB() + WE_UV; }
        else if (wi == 13) { s.W = a.in[14]; s.K = 2048; s.Nsrc = 256; s.Ndst = 256; s.WT = P.WB() + WE_C1K; }
        else if (wi == 14) { s.W = a.in[16]; s.K = 2048; s.Nsrc = 256; s.Ndst = 256; s.WT = P.WB() + WE_C1V; }
        else if (wi == 15) { s.W = a.in[15]; s.K = 256; s.Nsrc = 64; s.Ndst = 256; s.WT = P.WB() + WE_C2K; }
        else if (wi == 16) { s.W = a.in[17]; s.K = 256; s.Nsrc = 64; s.Ndst = 256; s.WT = P.WB() + WE_C2V; }
        else if (wi == 17) { s.W = a.in[18]; s.K = 1024; s.Nsrc = 1024; s.Ndst = 1024; s.WT = P.WB() + WE_OE; }
        else if (wi == 18) { s.W = a.in[19]; s.K = 1024; s.Nsrc = 4608; s.Ndst = 3072; s.WT = P.WB() + WE_O1; }
        else if (wi == 19) { s.W = a.in[19]; s.K = 1024; s.Nsrc = 4608; s.Ndst = 1536; s.soff = 3072; s.WT = P.WB() + WE_O2; }
        else { s.W = a.in[20]; s.K = 512; s.Nsrc = 1024; s.Ndst = 1024; s.WT = P.WB() + WE_OO; }
        s.nvalid = (wi == 15 || wi == 16) ? 64 : s.Ndst;
        const int nitems = (s.K / 128) * (s.Ndst / 32);
        { int it0 = (gw - cum) % NGW; if (it0 < 0) it0 += NGW; for (int it = it0; it < nitems; it += NGW) transpose_item(s, scr, it, lane); cum = (cum + nitems) % NGW; }
    }
    { const float* x = a.in[0]; const size_t n8 = (size_t)T * DM / 8; const size_t gt = (size_t)gw * 64 + lane, NT_ = (size_t)NGW * 64;
#pragma unroll 4
      for (size_t i = gt; i < n8; i += NT_) { const f32x4 v0 = *(const f32x4*)(x + i * 8), v1 = *(const f32x4*)(x + i * 8 + 4);
          u32x4 o; o.x = cvt_pk_bf16(v0[0], v0[1]); o.y = cvt_pk_bf16(v0[2], v0[3]); o.z = cvt_pk_bf16(v1[0], v1[1]); o.w = cvt_pk_bf16(v1[2], v1[3]); *(u32x4*)(P.XB() + i * 8) = o; } }
    if (gw < 512) { const int kv = gw >> 8, nn = gw & 255; const float* w1 = kv ? a.in[16] : a.in[14]; const float* cp = a.in[13]; float sacc = 0.f;
        for (int i = 0; i < 32; ++i) { const int kk = lane + 64 * i; sacc += cp[kk] * w1[(size_t)kk * 256 + nn]; }
        sacc = wave_sum(sacc); if (lane == 0) P.CB()[kv * 256 + nn] = sacc; }
    if (gw == 0) { P.CTL()[lane] = 0u; if (lane < 28) ((const float**)(P.ws + WS_PT))[lane] = a.in[lane]; }
}
__device__ __forceinline__ void ln_pass(const KP& P, const float* gam, const float* bet, bool write_x, int lane, int gw, int NGW) {
    float* ST = (float*)(P.ws + WS_ST);
    f32x4 gv[4], bv[4];
#pragma unroll
    for (int j = 0; j < 4; ++j) { gv[j] = *(const f32x4*)(gam + 4 * lane + 256 * j); bv[j] = *(const f32x4*)(bet + 4 * lane + 256 * j); }
    for (int row = gw; row < T; row += 2 * NGW) {
        const int row2 = row + NGW; const bool has2 = row2 < T;
        float* xr = P.out + (size_t)row * DM + 4 * lane; float* xr2 = P.out + (size_t)(has2 ? row2 : row) * DM + 4 * lane;
        f32x4 v[4], u[4]; float s = 0.f, t = 0.f;
#pragma unroll
        for (int j = 0; j < 4; ++j) { v[j] = *(const f32x4*)(xr + 256 * j); u[j] = *(const f32x4*)(xr2 + 256 * j); }
#pragma unroll
        for (int j = 0; j < 4; ++j) { s += (v[j][0] + v[j][1]) + (v[j][2] + v[j][3]); t += (u[j][0] + u[j][1]) + (u[j][2] + u[j][3]); }
        const float mean = wave_sum(s) * (1.f / DM), mean2 = wave_sum(t) * (1.f / DM); float s2 = 0.f, t2 = 0.f;
#pragma unroll
        for (int j = 0; j < 4; ++j) { v[j] = v[j] - mean; s2 += (v[j][0] * v[j][0] + v[j][1] * v[j][1]) + (v[j][2] * v[j][2] + v[j][3] * v[j][3]);
                                      u[j] = u[j] - mean2; t2 += (u[j][0] * u[j][0] + u[j][1] * u[j][1]) + (u[j][2] * u[j][2] + u[j][3] * u[j][3]); }
        const float rstd = 1.f / sqrtf(wave_sum(s2) * (1.f / DM) + 1e-5f), rstd2 = 1.f / sqrtf(wave_sum(t2) * (1.f / DM) + 1e-5f);
        bf16* xb = P.XB() + (size_t)row * DM + 4 * lane; bf16* xb2 = P.XB() + (size_t)row2 * DM + 4 * lane;
#pragma unroll
        for (int j = 0; j < 4; ++j) { const f32x4 y = v[j] * rstd * gv[j] + bv[j]; if (write_x) *(f32x4*)(xr + 256 * j) = y;
            u32x2 o; o.x = cvt_pk_bf16(y[0], y[1]); o.y = cvt_pk_bf16(y[2], y[3]); *(u32x2*)(xb + 256 * j) = o; }
        if (lane == 0) { ST[2 * row] = mean; ST[2 * row + 1] = rstd; if (has2) { ST[2 * row2] = mean2; ST[2 * row2 + 1] = rstd2; } }
        if (has2) {
#pragma unroll
            for (int j = 0; j < 4; ++j) { const f32x4 y = u[j] * rstd2 * gv[j] + bv[j]; if (write_x) *(f32x4*)(xr2 + 256 * j) = y;
                u32x2 o; o.x = cvt_pk_bf16(y[0], y[1]); o.y = cvt_pk_bf16(y[2], y[3]); *(u32x2*)(xb2 + 256 * j) = o; }
        }
    }
}
__device__ __forceinline__ void small_pass(const KP& P, int lane, int gw, int NGW) {
    constexpr int NR = 4;
    const int lq = lane < 48 ? lane : 47, lg = lane < 32 ? 0 : (lane < 56 ? lane - 32 : 23);
    double inv = 1.0; for (int k = 0; k < (lane & 15); ++k) inv *= 0.5623413251903491;
    for (int tok0 = gw; tok0 < T; tok0 += NR * NGW) {
        u32x4 cq[NR], ck[NR]; bf16 p1[NR], p2[NR], gl[NR]; int ps[NR];
#pragma unroll
        for (int r = 0; r < NR; ++r) { const int tok = tok0 + r * NGW < T ? tok0 + r * NGW : tok0; const bf16* he = P.HE() + (size_t)tok * HE_LD;
            cq[r] = *(const u32x4*)(he + lq * 8); ck[r] = *(const u32x4*)(he + HE_CKV + (lane & 31) * 8);
            p1[r] = he[HE_KPE + (lane & 15)]; p2[r] = he[HE_KPE + 16 + (lane & 15)]; gl[r] = he[HE_GT + lg]; ps[r] = P.pos[tok]; }
#pragma unroll
        for (int r = 0; r < NR; ++r) {
            const int tok = tok0 + r * NGW; float sq = 0.f, skv = 0.f;
#pragma unroll
            for (int e2 = 0; e2 < 4; ++e2) { const float a0 = __uint_as_float(cq[r][e2] << 16), a1 = __uint_as_float(cq[r][e2] & 0xffff0000u); sq += a0 * a0 + a1 * a1;
                                             const float b0 = __uint_as_float(ck[r][e2] << 16), b1 = __uint_as_float(ck[r][e2] & 0xffff0000u); skv += b0 * b0 + b1 * b1; }
            sq = wave_sum(lane < 48 ? sq : 0.f); skv = wave_sum(lane < 32 ? skv : 0.f);
            if (tok < T) {
                if (lane == 0) { P.RSTD()[tok] = 1.f / sqrtf(sq * (1.f / 384.f) + 1e-6f); P.RSTD()[T + tok] = 1.f / sqrtf(skv * (1.f / 256.f) + 1e-6f); }
                if (lane < 16) {
                    const double rev = (double)ps[r] * inv * 0.15915494309189535; const float fr = (float)(rev - floor(rev));
                    const float sn = __builtin_amdgcn_sinf(fr), cs = __builtin_amdgcn_cosf(fr);
                    P.RT()[(size_t)tok * 32 + 2 * lane] = cs; P.RT()[(size_t)tok * 32 + 2 * lane + 1] = sn;
                    const float x1 = bf2f(p1[r]), x2 = bf2f(p2[r]);
                    const int q1 = 8 * (lane >> 2) + (lane & 3);
                    const unsigned o1 = cvt_pk_bf16(x1 * cs - x2 * sn, 0.f), o2 = cvt_pk_bf16(x2 * cs + x1 * sn, 0.f);
                    P.KROT()[(size_t)tok * 32 + q1] = (bf16)(o1 & 0xffffu); P.KROT()[(size_t)tok * 32 + q1 + 4] = (bf16)(o2 & 0xffffu);
                }
                if (lane >= 32 && lane < 56) { const float x = bf2f(gl[r]); P.GT()[(size_t)tok * 24 + (lane - 32)] = fast_rcp(1.f + fast_exp2(-LOG2E * x)); }
            }
        }
    }
}
__device__ __forceinline__ void merge_pass(const KP& P, int lane, int gw, int NGW) {
    const size_t n = (size_t)T * 64, gt = (size_t)gw * 64 + lane, NT_ = (size_t)NGW * 64;
    for (size_t idx = gt; idx < n; idx += NT_) {
        const size_t tok = idx >> 6; const int col = (int)(idx & 63) * 8, h = col >> 7;
        const float l0 = P.LSE()[tok * 4 + h], l1 = P.LSE()[((size_t)T + tok) * 4 + h], l2 = P.LSE()[((size_t)2 * T + tok) * 4 + h];
        const float mx = fmaxf(l0, fmaxf(l1, l2)); float w0 = fast_exp2(l0 - mx), w1 = fast_exp2(l1 - mx), w2 = fast_exp2(l2 - mx);
        const float inv = 1.f / (w0 + w1 + w2); w0 *= inv; w1 *= inv; w2 *= inv;
        const u32x4 a = *(const u32x4*)(P.OG() + tok * 512 + col), b = *(const u32x4*)(P.OG() + ((size_t)T + tok) * 512 + col), c = *(const u32x4*)(P.OG() + ((size_t)2 * T + tok) * 512 + col);
        u32x4 o;
#pragma unroll
        for (int e = 0; e < 4; ++e) {
            const float lo = w0 * __uint_as_float(a[e] << 16) + w1 * __uint_as_float(b[e] << 16) + w2 * __uint_as_float(c[e] << 16);
            const float hi = w0 * __uint_as_float(a[e] & 0xffff0000u) + w1 * __uint_as_float(b[e] & 0xffff0000u) + w2 * __uint_as_float(c[e] & 0xffff0000u);
            o[e] = cvt_pk_bf16(lo, hi);
        }
        *(u32x4*)(P.OO() + tok * 512 + col) = o;
    }
}

#define ONE_LAUNCH 1
#define PROBE_F1 0
#define PROBE_O12 0
#define PROBE_EFRONT 0
#define PROBE_F2 0
#define USE_XBAR 1
#define PROBE_P0 0
#define PROBE_SYNC 0
#define PROBE_ATTE 0
#define PROBE_ATTO 0
#define PROBE_MLA_ONLY 0

enum { K_P0, K_F1, K_F2, K_LN, K_E12, K_SMALL, K_E345, K_C2, K_ATTE, K_OUTE, K_O12, K_ATTO, K_MERGE, K_OUTO };
constexpr int NPH = 25;
#define GEMM_CALL(EPI, g_, E_, off_) do { pg8::StaticOrder S_; S_.init((g_).M, (g_).N, (int)gridDim.x, (int)((blockIdx.x + (off_)) % gridDim.x)); \
    pg8::gemm_phase<EPI, pg8::StaticOrder, true, true>(lds, (g_), S_, (E_)); } while (0)

__global__ void __launch_bounds__(512, 2) mega(Args a) {
    extern __shared__ __attribute__((aligned(16))) unsigned char lds_raw[];
    LAS unsigned char* lds = (LAS unsigned char*)lds_raw;
    cg::grid_group grid = cg::this_grid();
    const int wv = __builtin_amdgcn_readfirstlane((int)threadIdx.x >> 6);
    const int G = gridDim.x, gw = blockIdx.x * 8 + wv, NGW = G * 8;
    KP P; unsigned char* ws = a.ws;
    P.out = a.out; P.ws = ws; P.pos = (const int*)a.in[1];
    LAS int* su = (LAS int*)(lds + LDS_BYTES - 64);
    volatile LAS unsigned* bst = (volatile LAS unsigned*)(lds + LDS_BYTES - 32);
    if (threadIdx.x < 2) bst[threadIdx.x] = 0u;
    __syncthreads();
    XcdBarrier bar = xcd_barrier_post((unsigned*)(a.ws + WS_CTL) + 4096, bst);

    if (a.ph_lo == 0) {
 p0_prologue(a, P, lds, threadIdx.x, gw, NGW);
#if PROBE_P0
 p0_prologue(a, P, lds, threadIdx.x, gw, NGW);
#endif
 if (a.ph_hi > 1) {
#if USE_XBAR
        if (a.ph_hi < 0) grid.sync();
        xcd_barrier(bar);
#else
        grid.sync();
#endif
    } }
#define IN(k) (((const float* const*)(P.ws + WS_PT))[k])
    for (int ph = (a.ph_lo == 0 ? 1 : a.ph_lo); ph < a.ph_hi; ++ph) {
        int tid = threadIdx.x; asm volatile("" : "+v"(tid));
        const int lane = tid & 63;
        { unsigned char* ws_i = a.ws; float* out_i = a.out; asm volatile("" : "+s"(ws_i), "+s"(out_i)); P.ws = ws_i; P.out = out_i; P.pos = (const int*)IN(1); }
        int kind, f = 0, lns = 0, layer = 0;
        switch (ph) {
            case 1: kind = K_F1; f = 0; break;  case 2: kind = K_F2; f = 0; break;  case 3: kind = K_LN; lns = 0; layer = 0; break;
            case 4: kind = K_E12; break; case 5: kind = K_SMALL; break; case 6: kind = K_E345; break; case 7: kind = K_C2; break; case 8: kind = K_ATTE; break; case 9: kind = K_OUTE; break;
            case 10: kind = K_LN; lns = 1; layer = 0; break;
            case 11: kind = K_F1; f = 1; break; case 12: kind = K_F2; f = 1; break; case 13: kind = K_LN; lns = 2; layer = 0; break;
            case 14: kind = K_F1; f = 2; break; case 15: kind = K_F2; f = 2; break; case 16: kind = K_LN; lns = 0; layer = 1; break;
            case 17: kind = K_O12; break; case 18: kind = K_ATTO; break; case 19: kind = K_MERGE; break; case 20: kind = K_OUTO; break;
            case 21: kind = K_LN; lns = 1; layer = 1; break;
            case 22: kind = K_F1; f = 3; break; case 23: kind = K_F2; f = 3; break; default: kind = K_LN; lns = 2; layer = 1; break;
        }
        if (kind == K_F1) {
            pg8::Gemm g{P.XB(), P.WB() + WE_GU + (size_t)f * 5632 * 1024, T, 5632, 1024, 1024, 1024, 128, 0}; EpiSwiglu E{P.H(), FF};
            GEMM_CALL(EpiSwiglu, g, E, 0);
#if PROBE_F1
            GEMM_CALL(EpiSwiglu, g, E, 0);
#endif
        }
        else if (kind == K_F2) {
            pg8::Gemm g{P.H(), P.WB() + WE_D + (size_t)f * 1024 * 2816, T, 1024, FF, FF, FF, 128, 0};
            if (f == 0) { EpiResidT<false> E{IN(0), P.out, P.ws, 0, 0, 0, DN_ALPHA, 0.5f}; GEMM_CALL(EpiResidT<false>, g, E, 0); }
            else {
#if PROBE_F2
                { EpiResidT<true> E{P.out, (float*)(P.ws + WS_R + 352 * MiB), P.ws, (f == 2 ? 26 : 21), (f == 2 ? 27 : 22), (f == 3 ? DM : 0), DN_ALPHA, 0.5f}; GEMM_CALL(EpiResidT<true>, g, E, 0); }
#endif
 EpiResidT<true> E{P.out, P.out, P.ws, (f == 2 ? 26 : 21), (f == 2 ? 27 : 22), (f == 3 ? DM : 0), DN_ALPHA, 0.5f}; GEMM_CALL(EpiResidT<true>, g, E, 0); }
        }
        else if (kind == K_OUTE) {
            pg8::Gemm g{P.OE(), P.WB() + WE_OE, T, 1024, 1024, 1024, 1024, 128, 0}; EpiResidT<true> E{P.out, P.out, P.ws, 2, 3, 0, DN_ALPHA, 1.f};
            GEMM_CALL(EpiResidT<true>, g, E, 0);
        }
        else if (kind == K_OUTO) {
            pg8::Gemm g{P.OO(), P.WB() + WE_OO, T, 1024, 512, 512, 512, 128, 0}; EpiResidT<true> E{P.out, P.out, P.ws, 2, 3, DM, DN_ALPHA, 1.f};
            GEMM_CALL(EpiResidT<true>, g, E, 0);
        }
        else if (kind == K_LN) {
            const float* gam = (lns == 0 ? IN(2) : (lns == 1 ? IN(21) : IN(26))) + layer * DM;
            const float* bet = (lns == 0 ? IN(3) : (lns == 1 ? IN(22) : IN(27))) + layer * DM;

#ifndef DIS_LN
 ln_pass(P, gam, bet, ph == NPH - 1, lane, gw, NGW);
#endif

        }
        else if (kind == K_SMALL) {
#ifndef DIS_SMALL
 small_pass(P, lane, gw, NGW);
#endif
 }
        else if (kind == K_MERGE) {
#ifndef DIS_MERGE
 merge_pass(P, lane, gw, NGW);
#endif
 }
        else if (kind == K_E12) {
            { pg8::Gemm g{P.XB(), P.WB() + WE_E1, T, 1792, 1024, 1024, 1024, 128, 0}; EpiStore E{P.HE(), HE_LD, nullptr, nullptr, nullptr, 0, 1792, T, 0, 0}; GEMM_CALL(EpiStore, g, E, 0); }
            { pg8::Gemm g{P.WB() + WE_E2, P.XB(), 256, T, 1024, 1024, 1024, 128, 0}; EpiStore E{P.VT(), T, nullptr, nullptr, nullptr, 0, T, 256, 0, 0}; GEMM_CALL(EpiStore, g, E, 0); }
        }
        else if (kind == K_E345) {
            for (int j = 0; j < 4; ++j) { const int kv = j >> 1, gg = j & 1;
                pg8::Gemm g{P.HE() + (kv ? HE_VC : HE_KC) + gg * 64, P.WB() + (kv ? WE_C1V : WE_C1K), 8192, 256, 2048, 16 * HE_LD, 2048, HE_LD * 2, 0};
                EpiStore E{P.HC() + (size_t)j * 8192 * 256, 256, nullptr, nullptr, P.CB() + kv * 256, 1, 256, 8192, 0, 0}; GEMM_CALL(EpiStore, g, E, 32 * j); }
            { pg8::Gemm g{P.HE() + HE_CQ, P.WB() + WE_UQ, T, 768, 384, HE_LD, 384, 128, 0}; EpiRopeQ E{P.QM(), 768, P.RSTD(), P.RT(), 0.10206207261596575f * LOG2E}; GEMM_CALL(EpiRopeQ, g, E, 128); }
            { pg8::Gemm g{P.HE() + HE_CKV, P.WB() + WE_UK, T, 512, 256, HE_LD, 256, 128, 0}; EpiStore E{P.KN(), 512, P.RSTD() + T, nullptr, nullptr, 0, 512, T, 0, 0}; GEMM_CALL(EpiStore, g, E, 128); }
            { pg8::Gemm g{P.WB() + WE_UV, P.HE() + HE_CKV, 512, T, 256, 256, HE_LD, 128, 0}; EpiStore E{P.VMT(), T, nullptr, P.RSTD() + T, nullptr, 0, T, 512, 0, 0}; GEMM_CALL(EpiStore, g, E, 128); }
        }
        else if (kind == K_C2) {
            for (int gg = 0; gg < 2; ++gg) { pg8::Gemm g{P.HC() + (size_t)gg * 8192 * 256, P.WB() + WE_C2K, 8192, 256, 256, 256, 256, 128, 0};
                EpiStore E{P.KCC() + gg * 64, 128, nullptr, nullptr, nullptr, 0, 64, 8192, 1, 0}; GEMM_CALL(EpiStore, g, E, 32 * gg); }
            for (int gg = 0; gg < 2; ++gg) { pg8::Gemm g{P.WB() + WE_C2V, P.HC() + (size_t)(2 + gg) * 8192 * 256, 256, 8192, 256, 256, 256, 128, 0};
                EpiStore E{P.VCT() + (size_t)gg * 64 * 8192, 8192, nullptr, nullptr, nullptr, 0, 8192, 64, 0, 1}; GEMM_CALL(EpiStore, g, E, 64 + 32 * gg); }
        }
        else if (kind == K_O12) {
            { pg8::Gemm g{P.XB(), P.WB() + WE_O1, T, 3072, 1024, 1024, 1024, 128, 0}; EpiStore E{P.QK(), 3072, nullptr, nullptr, nullptr, 0, 3072, T, 0, 0}; GEMM_CALL(EpiStore, g, E, 0); }
            for (int gg = 0; gg < 3; ++gg) { const int dil = gg == 0 ? 1 : (gg == 1 ? 4 : 16);
                pg8::Gemm g{P.WB() + WE_O2 + (size_t)gg * 512 * 1024, P.XB(), 512, T, 1024, 1024, dil * 1024, 128, dil};
                EpiStore E{P.VOT() + (size_t)gg * 512 * T, T, nullptr, nullptr, nullptr, 0, T, 512, 0, 0}; GEMM_CALL(EpiStore, g, E, 0); }
        }
        else if (kind == K_ATTE) {
            __syncthreads();
            for (int rep = 0; rep < (PROBE_ATTE ? 2 : 1); ++rep)
            for (;;) {
                if (tid == 0) *su = (int)atomicAdd(&P.CTL()[0 + 2 * rep], 1u);
                __syncthreads(); const int u = *su; __syncthreads();
                if (u >= 4096) break;
                if (PROBE_MLA_ONLY && rep == 1 && u >= 2048) break;
                if (u < 2048) { const int qb = 31 - (u >> 6), bh = u & 63;
#ifndef DIS_MLA
 mla_unit(P, lds, bh >> 3, bh & 7, qb, tid);
#endif
 }
                else { const int v = u - 2048, c = 127 - (v >> 4), bg = v & 15;
#ifndef DIS_NSA
 nsa_unit(P, lds, bg >> 1, c, bg & 1, tid);
#endif
 }
            }
        }
        else if (kind == K_ATTO) {
            __syncthreads();
            for (int rep = 0; rep < (PROBE_ATTO ? 2 : 1); ++rep)
            for (;;) {
                if (tid == 0) *su = (int)atomicAdd(&P.CTL()[1 + 2 * rep], 1u);
                __syncthreads(); const int u = *su; __syncthreads();
                if (u >= 3072) break;
                const int rj = u & 31, rest = u >> 5, h = rest & 3, g = (rest >> 2) % 3, b = rest / 12;

#ifndef DIS_DIL
 dil_unit(P, lds, b, g, h, rj, tid);
#endif

            }
        }
        if (ph + 1 < a.ph_hi) {
#if USE_XBAR
            xcd_barrier(bar);
#else
            grid.sync();
#endif
        }
#if PROBE_SYNC
        if (ph + 1 < a.ph_hi) { grid.sync(); grid.sync(); }
#endif
    }
}

#ifndef ONE_LAUNCH_X
#define ONE_LAUNCH 1
#endif
extern "C" void kernel_launch(void* const* d_in, const int* in_sizes, int n_in, void* d_out, int out_size, void* d_ws, size_t ws_size, hipStream_t stream) {
    static int grid = 0;
    if (grid == 0) {
        if (n_in != 28 || ws_size < WS_NEED) { fprintf(stderr, "kernel_launch: unexpected n_in %d / ws %zu\n", n_in, ws_size); grid = -1; return; }
        int dev = 0, cus = 0, per_cu = 0;
        hipGetDevice(&dev); hipDeviceGetAttribute(&cus, hipDeviceAttributeMultiprocessorCount, dev);
        if (hipFuncSetAttribute((const void*)mega, hipFuncAttributeMaxDynamicSharedMemorySize, LDS_BYTES) != hipSuccess) { fprintf(stderr, "hipFuncSetAttribute failed\n"); grid = -1; return; }
        hipOccupancyMaxActiveBlocksPerMultiprocessor(&per_cu, (const void*)mega, 512, LDS_BYTES);
        if (per_cu < 1) per_cu = 1;
        grid = cus * 1;
        (void)hipGetLastError();
    }
    if (grid < 0) return;
    if (hipMemsetAsync((char*)d_ws + WS_CTL, 0, 65536, stream) != hipSuccess) { fprintf(stderr, "memset failed\n"); return; }
    Args a{};
    for (int i = 0; i < 28; ++i) a.in[i] = (const float*)d_in[i];
    a.out = (float*)d_out; a.ws = (unsigned char*)d_ws;
#if ONE_LAUNCH
    a.ph_lo = 0; a.ph_hi = NPH;
    void* args[] = {&a};
    hipError_t e = hipLaunchCooperativeKernel((const void*)mega, dim3(grid), dim3(512), args, LDS_BYTES, stream);
    if (e != hipSuccess) fprintf(stderr, "cooperative launch failed: %s (grid %d)\n", hipGetErrorString(e), grid);
#else
    for (int ph = 0; ph < NPH; ++ph) { a.ph_lo = ph; a.ph_hi = ph + 1; hipLaunchKernelGGL(mega, dim3(grid), dim3(512), LDS_BYTES, stream, a); }
#endif
}
```

```cpp
#include <hip/hip_runtime.h>
#include <hip/hip_cooperative_groups.h>
#include <cstdio>
#include <cstdint>
namespace cg = cooperative_groups;
namespace pg8 {
#define PG8_LAS __attribute__((address_space(3)))
typedef unsigned short bf16_t;
typedef short bf16x8 __attribute__((ext_vector_type(8)));
typedef float f32x4 __attribute__((ext_vector_type(4)));
typedef unsigned u32x4 __attribute__((ext_vector_type(4)));
constexpr int BM = 256, BK = 64, HALF = 128, HTB = HALF * BK * 2  , STAGE_BYTES = 8 * HTB, NXCD = 8, WGM = 8;

__host__ __device__ __forceinline__ int lds_byte(int r, int c) { const int st = (r >> 4) * 2 + (c >> 5), rr = r & 15, cc = c & 31, ob = rr * 64 + cc * 2; return st * 1024 + (ob ^ (((ob >> 9) & 1) << 5)); }
__host__ __device__ __forceinline__ void stage_rc(int b, int& R, int& C) { const int st = b / 1024, sb = b % 1024, swz = sb ^ (((sb >> 9) & 1) << 5); R = (st >> 1) * 16 + swz / 64; C = (st & 1) * 32 + (swz % 64) / 2; }
__host__ __device__ __forceinline__ int perm32(int rho) { const int n = rho >> 4, i = rho & 15; return 8 * (i >> 2) + 4 * n + (i & 3); }

struct Unit { int pm, pn; };
struct Gemm { const bf16_t* A; const bf16_t* Bt; int M, N, K; int lda, ldb, kstepA, bdil;
    __device__ __forceinline__ size_t aoff(int pm) const { return (size_t)pm * 256 * lda * 2; }
    __device__ __forceinline__ size_t boff(int pn) const {
        if (bdil == 0) return (size_t)pn * 256 * ldb * 2;
        const int per = 32 / bdil, b = pn >> 5, rem = pn & 31, r = rem / per, jt = rem % per;
        return ((size_t)b * 8192 + r + (size_t)bdil * 256 * jt) * 1024 * 2; } };

struct StaticOrder {
    int nM, nN, nwg, G, c;
    __host__ __device__ void init(int M, int N, int G_, int c_) { nM = M / BM; nN = N / BM; nwg = nM * nN; G = G_; c = c_; }
    __host__ __device__ bool next(int i, Unit& u) const {
        const long L = (long)i * G + c; if (L >= nwg) return false;
        int wgid = (int)L; { const int q = nwg / NXCD, r = nwg % NXCD, xcd = wgid % NXCD, off = wgid / NXCD; wgid = (xcd < r ? xcd * (q + 1) : r * (q + 1) + (xcd - r) * q) + off; }
        const int nig = WGM * nN, gid = wgid / nig, fm = gid * WGM, gsz = (nM - fm) < WGM ? (nM - fm) : WGM;
        u.pm = fm + ((wgid % nig) % gsz); u.pn = (wgid % nig) / gsz; return true;
    }
    __device__ __forceinline__ void a_ready(const Unit&) const {}
    __device__ __forceinline__ void done(const Unit&) const {}
};

__device__ __forceinline__ unsigned cvt_pk_bf16(float lo, float hi) { unsigned r; asm volatile("v_cvt_pk_bf16_f32 %0, %1, %2" : "=v"(r) : "v"(lo), "v"(hi)); return r; }
typedef float f32x2 __attribute__((ext_vector_type(2)));
template <class Epi, class Sched, bool ALIGN_EPI = false, bool SP2 = false>
__device__ __forceinline__ void gemm_phase(PG8_LAS unsigned char* lds, const Gemm g, const Sched& S, const Epi& E) {
    int tid_o = threadIdx.x; asm volatile("" : "+v"(tid_o)); const int tid = tid_o, wid = __builtin_amdgcn_readfirstlane(tid >> 6), lane = tid & 63, wr = wid >> 2, wc = wid & 3, fr = lane & 15, fq = lane >> 4;
    const int K = g.K, nt = K / BK;
    unsigned voffA[2], voffB[2];
#pragma unroll
    for (int i = 0; i < 2; ++i) { int R, C; stage_rc(tid * 16 + i * 8192, R, C); const int Rb = Epi::PERM ? ((R & ~31) + perm32(R & 31)) : R;
        voffA[i] = (unsigned)(R * g.lda + C) * 2u; voffB[i] = (unsigned)(Rb * g.ldb + C) * 2u; }
    const size_t kstepB = (size_t)(BK * 2), kstepA = (size_t)g.kstepA;
    const size_t hstepA = (size_t)HALF * g.lda * 2, hstepB = (size_t)HALF * g.ldb * 2;
    const unsigned ldsw = (unsigned)wid * 1024u;
    const int aoff = lds_byte(wr * 64 + fr, fq * 8), boff = lds_byte(wc * 32 + fr, fq * 8);
#define PG8_SA(b, h) (((b) * 2 + (h)) * HTB)
#define PG8_SB(b, h) ((4 + (b) * 2 + (h)) * HTB)
#define PG8_STAGE(bufoff, gbase, voff) do { _Pragma("unroll") for (int _i = 0; _i < 2; ++_i) \
        __builtin_amdgcn_global_load_lds((const unsigned*)((const char*)(gbase) + (voff)[_i]), (PG8_LAS unsigned*)(lds + (bufoff) + ldsw + _i * 8192), 16, 0, 0); } while (0)
#define PG8_LDA(dst, b, h) do { _Pragma("unroll") for (int m = 0; m < 4; ++m) _Pragma("unroll") for (int k = 0; k < 2; ++k) dst[m][k] = *(const PG8_LAS bf16x8*)(lds + PG8_SA(b, h) + aoff + m * 2048 + k * 1024); } while (0)
#define PG8_LDB(dst, b, h) do { _Pragma("unroll") for (int n = 0; n < 2; ++n) _Pragma("unroll") for (int k = 0; k < 2; ++k) dst[n][k] = *(const PG8_LAS bf16x8*)(lds + PG8_SB(b, h) + boff + n * 2048 + k * 1024); } while (0)
#define PG8_MMA(ai, bj, At, Bt) do { __builtin_amdgcn_s_setprio(1); _Pragma("unroll") for (int m = 0; m < 4; ++m) _Pragma("unroll") for (int n = 0; n < 2; ++n) _Pragma("unroll") for (int k = 0; k < 2; ++k) \
        acc[ai][bj][m][n] = __builtin_amdgcn_mfma_f32_16x16x32_bf16(Bt[n][k], At[m][k], acc[ai][bj][m][n], 0, 0, 0); __builtin_amdgcn_s_setprio(0); } while (0)
#define PG8_WAIT_V(n) asm volatile("s_waitcnt vmcnt(" #n ")" ::: "memory")
#define PG8_WAIT_L(n) asm volatile("s_waitcnt lgkmcnt(" #n ")" ::: "memory")
#define PG8_BAR __builtin_amdgcn_s_barrier()
#define PG8_SCHED __builtin_amdgcn_sched_barrier(0)
    Unit cur, nxt; int ui = 0;
    if (!S.next(0, cur)) return;
    f32x4 acc[2][2][4][2];
#pragma unroll
    for (int a = 0; a < 2; ++a)
#pragma unroll
        for (int b = 0; b < 2; ++b)
#pragma unroll
            for (int m = 0; m < 4; ++m)
#pragma unroll
                for (int n = 0; n < 2; ++n) acc[a][b][m][n] = (f32x4){0.f, 0.f, 0.f, 0.f};
    bf16x8 At[4][2], B0[2][2], B1[2][2];
    const char* cA = (const char*)g.A + g.aoff(cur.pm); const char* cB = (const char*)g.Bt + g.boff(cur.pn);
    S.a_ready(cur);
    if constexpr (SP2) {
        PG8_STAGE(PG8_SB(0, 0), cB, voffB); PG8_STAGE(PG8_SB(0, 1), cB + hstepB, voffB); PG8_STAGE(PG8_SA(0, 0), cA, voffA); PG8_STAGE(PG8_SA(0, 1), cA + hstepA, voffA);
        if (wr == 1) PG8_BAR;
        PG8_WAIT_V(2); PG8_BAR;
        PG8_STAGE(PG8_SB(1, 0), cB + kstepB, voffB); PG8_STAGE(PG8_SA(1, 0), cA + kstepA, voffA); PG8_STAGE(PG8_SB(1, 1), cB + hstepB + kstepB, voffB);
        PG8_WAIT_V(6); PG8_BAR;
    } else {
        PG8_STAGE(PG8_SB(0, 0), cB, voffB); PG8_STAGE(PG8_SA(0, 0), cA, voffA); PG8_STAGE(PG8_SB(0, 1), cB + hstepB, voffB); PG8_STAGE(PG8_SA(0, 1), cA + hstepA, voffA);
        if (wr == 1) PG8_BAR;
        PG8_WAIT_V(4); PG8_BAR;
        PG8_STAGE(PG8_SB(1, 0), cB + kstepB, voffB); PG8_STAGE(PG8_SA(1, 0), cA + kstepA, voffA); PG8_STAGE(PG8_SB(1, 1), cB + hstepB + kstepB, voffB);
        PG8_WAIT_V(6); PG8_BAR;
    }
    for (;;) {
        const bool has_next = S.next(ui + 1, nxt);
        const char* nA = has_next ? (const char*)g.A + g.aoff(nxt.pm) : cA; const char* nB = has_next ? (const char*)g.Bt + g.boff(nxt.pn) : cB;
        _Pragma("clang loop unroll(disable)") for (int t = 0; t < nt; t += 2) {
            const bool last = (t == nt - 2);
            const char* a1 = cA + (size_t)(t + 1) * kstepA;
            const char* a2 = last ? nA : cA + (size_t)(t + 2) * kstepA; const char* b2 = last ? nB : cB + (size_t)(t + 2) * kstepB;
            const char* a3 = a2 + kstepA; const char* b3 = b2 + kstepB;
            if (last && has_next) S.a_ready(nxt);
            if constexpr (SP2) {
            PG8_LDB(B0, 0, 0); PG8_LDB(B1, 0, 1); PG8_SCHED; PG8_LDA(At, 0, 0); PG8_STAGE(PG8_SA(1, 1), a1 + hstepA, voffA);
            PG8_WAIT_V(8); PG8_WAIT_L(0); PG8_BAR; PG8_MMA(0, 0, At, B0); PG8_MMA(0, 1, At, B1); PG8_BAR; PG8_SCHED;
            PG8_LDA(At, 0, 1); PG8_STAGE(PG8_SB(0, 0), b2, voffB); PG8_STAGE(PG8_SB(0, 1), b2 + hstepB, voffB); PG8_STAGE(PG8_SA(0, 0), a2, voffA);
            PG8_WAIT_V(8); PG8_WAIT_L(0); PG8_BAR; PG8_MMA(1, 0, At, B0); PG8_MMA(1, 1, At, B1); PG8_BAR; PG8_SCHED;
            PG8_LDB(B0, 1, 0); PG8_LDB(B1, 1, 1); PG8_SCHED; PG8_LDA(At, 1, 0); PG8_STAGE(PG8_SA(0, 1), a2 + hstepA, voffA);
            PG8_WAIT_V(8); PG8_WAIT_L(0); PG8_BAR; PG8_MMA(0, 0, At, B0); PG8_MMA(0, 1, At, B1); PG8_BAR; PG8_SCHED;
            PG8_LDA(At, 1, 1); PG8_STAGE(PG8_SB(1, 0), b3, voffB); PG8_STAGE(PG8_SB(1, 1), b3 + hstepB, voffB); PG8_STAGE(PG8_SA(1, 0), a3, voffA);
            PG8_WAIT_V(8); PG8_WAIT_L(0); PG8_BAR; PG8_MMA(1, 0, At, B0); PG8_MMA(1, 1, At, B1); PG8_BAR; PG8_SCHED;
            } else {
            PG8_LDB(B0, 0, 0); PG8_SCHED; PG8_LDA(At, 0, 0); PG8_STAGE(PG8_SA(1, 1), a1 + hstepA, voffA);
            PG8_WAIT_L(8); PG8_BAR; PG8_WAIT_L(0); PG8_MMA(0, 0, At, B0); PG8_BAR; PG8_SCHED;
            PG8_LDB(B1, 0, 1); PG8_STAGE(PG8_SB(0, 0), b2, voffB);
            PG8_BAR; PG8_WAIT_L(0); PG8_MMA(0, 1, At, B1); PG8_BAR;
            PG8_LDA(At, 0, 1); PG8_STAGE(PG8_SA(0, 0), a2, voffA);
            PG8_BAR; PG8_WAIT_L(0); PG8_MMA(1, 0, At, B0); PG8_BAR; PG8_SCHED;
            PG8_STAGE(PG8_SB(0, 1), b2 + hstepB, voffB);
            PG8_WAIT_V(6); PG8_BAR; PG8_MMA(1, 1, At, B1); PG8_BAR;
            PG8_LDB(B0, 1, 0); PG8_SCHED; PG8_LDA(At, 1, 0); PG8_STAGE(PG8_SA(0, 1), a2 + hstepA, voffA);
            PG8_WAIT_L(8); PG8_BAR; PG8_WAIT_L(0); PG8_MMA(0, 0, At, B0); PG8_BAR; PG8_SCHED;
            PG8_LDB(B1, 1, 1); PG8_STAGE(PG8_SB(1, 0), b3, voffB);
            PG8_BAR; PG8_WAIT_L(0); PG8_MMA(0, 1, At, B1); PG8_BAR;
            PG8_LDA(At, 1, 1); PG8_STAGE(PG8_SA(1, 0), a3, voffA);
            PG8_BAR; PG8_WAIT_L(0); PG8_MMA(1, 0, At, B0); PG8_BAR; PG8_SCHED;
            PG8_STAGE(PG8_SB(1, 1), b3 + hstepB, voffB);
            PG8_WAIT_V(6); PG8_BAR; PG8_MMA(1, 1, At, B1); PG8_BAR;
            }
        }
        if constexpr (ALIGN_EPI) { if (wr == 0) PG8_BAR; }
        if constexpr (!Epi::AFTER_DRAIN) { E(acc, cur, wr, wc, fr, fq); S.done(cur); }
        if (!has_next) break;
#pragma unroll
        for (int a = 0; a < 2; ++a)
#pragma unroll
            for (int b = 0; b < 2; ++b)
#pragma unroll
                for (int m = 0; m < 4; ++m)
#pragma unroll
                    for (int n = 0; n < 2; ++n) acc[a][b][m][n] = (f32x4){0.f, 0.f, 0.f, 0.f};
        cur = nxt; cA = nA; cB = nB; ++ui;
        if constexpr (ALIGN_EPI) { if (wr == 1) PG8_BAR; }
    }
    PG8_WAIT_V(0);
    if constexpr (!ALIGN_EPI) { if (wr == 0) PG8_BAR; }
    PG8_BAR;
    if constexpr (Epi::AFTER_DRAIN) { E.fused(acc, cur, wr, wc, fr, fq, lds, wid, lane); S.done(cur); }
#undef PG8_SA
#undef PG8_SB
#undef PG8_STAGE
#undef PG8_LDA
#undef PG8_LDB
#undef PG8_MMA
#undef PG8_WAIT_V
#undef PG8_WAIT_L
#undef PG8_BAR
#undef PG8_SCHED
}
}
#define LAS __attribute__((address_space(3)))
typedef unsigned short bf16;
using pg8::f32x4; using pg8::bf16x8; using pg8::u32x4; using pg8::Unit; using pg8::cvt_pk_bf16;
typedef float f32x16 __attribute__((ext_vector_type(16)));
typedef unsigned u32x2 __attribute__((ext_vector_type(2)));
typedef short s16x4 __attribute__((ext_vector_type(4)));

constexpr int NB = 8, SEQ = 8192, T = NB * SEQ, DM = 1024, FF = 2816;
constexpr int HE_LD = 1792;
constexpr int HE_CQ = 0, HE_CKV = 384, HE_KPE = 640, HE_Q = 672, HE_KC = 1184, HE_VC = 1312, HE_KS = 1440, HE_KW = 1568, HE_GT = 1696;
constexpr float LOG2E = 1.4426950408889634f;
constexpr float DN_ALPHA = 1.4142135623730951f;
constexpr float NEGB = -1e30f;

constexpr size_t MiB = 1u << 20;
constexpr size_t WS_CTL = 0;
constexpr size_t WS_W = 1 * MiB;
constexpr size_t WS_PT = 256 * 1024;
constexpr size_t WS_ST = 512 * 1024;
constexpr size_t WE_GU = 0;
constexpr size_t WE_D = WE_GU + 4ull * 5632 * 1024;
constexpr size_t WE_E1 = WE_D + 4ull * 1024 * 2816;
constexpr size_t WE_E2 = WE_E1 + 1792ull * 1024;
constexpr size_t WE_UQ = WE_E2 + 256ull * 1024;
constexpr size_t WE_UK = WE_UQ + 768ull * 384;
constexpr size_t WE_UV = WE_UK + 512ull * 256;
constexpr size_t WE_C1K = WE_UV + 512ull * 256;
constexpr size_t WE_C1V = WE_C1K + 256ull * 2048;
constexpr size_t WE_C2K = WE_C1V + 256ull * 2048;
constexpr size_t WE_C2V = WE_C2K + 256ull * 256;
constexpr size_t WE_OE = WE_C2V + 256ull * 256;
constexpr size_t WE_O1 = WE_OE + 1024ull * 1024;
constexpr size_t WE_O2 = WE_O1 + 3072ull * 1024;
constexpr size_t WE_OO = WE_O2 + 1536ull * 1024;
constexpr size_t WE_END = WE_OO + 1024ull * 512;
static_assert(WE_END * 2 <= 95 * MiB, "weights fit");
constexpr size_t WS_CB = 96 * MiB;
constexpr size_t WS_XB = 97 * MiB;
constexpr size_t WS_R = 225 * MiB;
constexpr size_t R_H = WS_R;
constexpr size_t R_HE = WS_R;
constexpr size_t R_VT = WS_R + 224 * MiB;
constexpr size_t R_QM = WS_R + 256 * MiB;
constexpr size_t R_KN = WS_R + 352 * MiB;
constexpr size_t R_VMT = WS_R + 416 * MiB;
constexpr size_t R_OE = WS_R + 480 * MiB;
constexpr size_t R_KROT = WS_R + 608 * MiB;
constexpr size_t R_RT = WS_R + 612 * MiB;
constexpr size_t R_GT = WS_R + 620 * MiB;
constexpr size_t R_RSTD = WS_R + 628 * MiB;
constexpr size_t R_HC = WS_R + 629 * MiB;
constexpr size_t R_KCC = WS_R + 645 * MiB;
constexpr size_t R_VCT = WS_R + 647 * MiB;
constexpr size_t R_QK = WS_R;
constexpr size_t R_VOT = WS_R + 384 * MiB;
constexpr size_t R_OG = WS_R + 576 * MiB;
constexpr size_t R_LSE = WS_R + 768 * MiB;
constexpr size_t R_OO = WS_R;
constexpr size_t WS_NEED = WS_R + 772 * MiB;
static_assert(WS_NEED <= 1024 * MiB, "ws");

constexpr int LDS_BYTES = 147456;

__device__ __forceinline__ float fast_exp2(float x) { return __builtin_amdgcn_exp2f(x); }
__device__ __forceinline__ float fast_rcp(float x) { return __builtin_amdgcn_rcpf(x); }
__device__ __forceinline__ float bf2f(bf16 v) { return __uint_as_float(((unsigned)v) << 16); }
__device__ __forceinline__ float wave_sum(float v) {
#pragma unroll
    for (int o = 1; o < 64; o <<= 1) v += __shfl_xor(v, o);
    return v;
}

struct EpiStore {
    static constexpr bool PERM = true, AFTER_DRAIN = false;
    bf16* O; int ldc; const float* rscale; const float* cscale; const float* bias; int act; int ncv; int nrv; int zrow; int zcol;
    __device__ __forceinline__ void operator()(const f32x4 (&acc)[2][2][4][2], const Unit& u, int wr, int wc, int fr, int fq) const {
#pragma unroll
        for (int bj = 0; bj < 2; ++bj) {
            const int col = u.pn * 256 + bj * 128 + wc * 32 + 8 * fq;
            if (col < ncv) {
                float cs[8], bs[8];
#pragma unroll
                for (int e = 0; e < 8; ++e) { cs[e] = cscale ? cscale[col + e] : 1.f; bs[e] = bias ? bias[col + e] : 0.f; }
#pragma unroll
                for (int ai = 0; ai < 2; ++ai)
#pragma unroll
                    for (int m = 0; m < 4; ++m) {
                        const int row = u.pm * 256 + ai * 128 + wr * 64 + m * 16 + fr;
                        if (row < nrv) {
                            const float rs = rscale ? rscale[row] : 1.f;
                            const f32x4 v0 = acc[ai][bj][m][0], v1 = acc[ai][bj][m][1];
                            float v[8] = {v0[0], v0[1], v0[2], v0[3], v1[0], v1[1], v1[2], v1[3]};
                            const bool zr = zrow && ((row & 511) == 511);
#pragma unroll
                            for (int e = 0; e < 8; ++e) {
                                float x = v[e] + bs[e];
                                if (act == 1) { const float y = 0.7978845608028654f * (x + 0.044715f * x * x * x); x = x * fast_rcp(1.f + fast_exp2(-2.f * LOG2E * y)); }
                                x *= rs * cs[e];
                                if (zr || (zcol && (((col + e) & 511) == 511))) x = 0.f;
                                v[e] = x;
                            }
                            u32x4 w; w.x = cvt_pk_bf16(v[0], v[1]); w.y = cvt_pk_bf16(v[2], v[3]); w.z = cvt_pk_bf16(v[4], v[5]); w.w = cvt_pk_bf16(v[6], v[7]);
                            *(u32x4*)(O + (size_t)row * ldc + col) = w;
                        }
                    }
            }
        }
    }
};
struct EpiSwiglu {
    static constexpr bool PERM = true, AFTER_DRAIN = false;
    bf16* H; int ldh;
    __device__ __forceinline__ void operator()(const f32x4 (&acc)[2][2][4][2], const Unit& u, int wr, int wc, int fr, int fq) const {
        const int col = u.pn * 128 + wc * 32 + 8 * fq;
#pragma unroll
        for (int ai = 0; ai < 2; ++ai)
#pragma unroll
            for (int m = 0; m < 4; ++m) {
                const int row = u.pm * 256 + ai * 128 + wr * 64 + m * 16 + fr;
                const f32x4 g0 = acc[ai][0][m][0], g1 = acc[ai][0][m][1], u0 = acc[ai][1][m][0], u1 = acc[ai][1][m][1];
                float g[8] = {g0[0], g0[1], g0[2], g0[3], g1[0], g1[1], g1[2], g1[3]};
                float uu[8] = {u0[0], u0[1], u0[2], u0[3], u1[0], u1[1], u1[2], u1[3]};
#pragma unroll
                for (int e = 0; e < 8; ++e) g[e] = g[e] * fast_rcp(1.f + fast_exp2(-LOG2E * g[e])) * uu[e];
                u32x4 w; w.x = cvt_pk_bf16(g[0], g[1]); w.y = cvt_pk_bf16(g[2], g[3]); w.z = cvt_pk_bf16(g[4], g[5]); w.w = cvt_pk_bf16(g[6], g[7]);
                *(u32x4*)(H + (size_t)row * ldh + col) = w;
            }
    }
};
template <bool LN>
struct EpiResidT {
    static constexpr bool PERM = true, AFTER_DRAIN = false;
    const float* Xin; float* Xout; unsigned char* ws; int gi, bi, goff; float alpha, beta;
    __device__ __forceinline__ void operator()(const f32x4 (&acc)[2][2][4][2], const Unit& u, int wr, int wc, int fr, int fq) const {
        constexpr int ldx = 1024;
        const float* st = (const float*)(ws + WS_ST); const float* gam = nullptr; const float* bet = nullptr;
        if (LN) { const float* const* PT = (const float* const*)(ws + WS_PT); gam = PT[gi] + goff; bet = PT[bi] + goff; }
#pragma unroll
        for (int bj = 0; bj < 2; ++bj) {
            const int col = u.pn * 256 + bj * 128 + wc * 32 + 8 * fq;
            f32x4 g0, g1, b0, b1;
            if (LN) { g0 = *(const f32x4*)(gam + col); g1 = *(const f32x4*)(gam + col + 4); b0 = *(const f32x4*)(bet + col); b1 = *(const f32x4*)(bet + col + 4); }
#pragma unroll
            for (int ai = 0; ai < 2; ++ai) {
                f32x4 x0[4], x1[4]; float mean[4], rstd[4];
#pragma unroll
                for (int m = 0; m < 4; ++m) {
                    const int row = u.pm * 256 + ai * 128 + wr * 64 + m * 16 + fr;
                    const size_t off = (size_t)row * ldx + col;
                    x0[m] = *(const f32x4*)(Xin + off); x1[m] = *(const f32x4*)(Xin + off + 4);
                    if (LN) { mean[m] = st[2 * row]; rstd[m] = st[2 * row + 1]; }
                }
#pragma unroll
                for (int m = 0; m < 4; ++m) {
                    const int row = u.pm * 256 + ai * 128 + wr * 64 + m * 16 + fr;
                    const size_t off = (size_t)row * ldx + col;
                    f32x4 a0 = x0[m], a1 = x1[m];
                    if (LN) { a0 = (a0 - mean[m]) * rstd[m] * g0 + b0; a1 = (a1 - mean[m]) * rstd[m] * g1 + b1; }
                    *(f32x4*)(Xout + off) = a0 * alpha + acc[ai][bj][m][0] * beta;
                    *(f32x4*)(Xout + off + 4) = a1 * alpha + acc[ai][bj][m][1] * beta;
                }
            }
        }
    }
};
struct EpiRopeQ {
    static constexpr bool PERM = true, AFTER_DRAIN = false;
    bf16* Q; int ldq; const float* rstd; const float* RT; float qscale;
    __device__ __forceinline__ void operator()(const f32x4 (&acc)[2][2][4][2], const Unit& u, int wr, int wc, int fr, int fq) const {
#pragma unroll
        for (int bj = 0; bj < 2; ++bj) {
            const int grp = u.pn * 8 + bj * 4 + wc; const bool is_rope = (grp % 3) == 2;
            const int col = u.pn * 256 + bj * 128 + wc * 32 + 8 * fq;
#pragma unroll
            for (int ai = 0; ai < 2; ++ai)
#pragma unroll
                for (int m = 0; m < 4; ++m) {
                    const int row = u.pm * 256 + ai * 128 + wr * 64 + m * 16 + fr;
                    const float rs = rstd[row] * qscale;
                    f32x4 v0 = acc[ai][bj][m][0] * rs, v1 = acc[ai][bj][m][1] * rs;
                    if (is_rope) {
                        const f32x4 c01 = *(const f32x4*)(RT + (size_t)row * 32 + 8 * fq), c23 = *(const f32x4*)(RT + (size_t)row * 32 + 8 * fq + 4);
                        const float cs[4] = {c01[0], c01[2], c23[0], c23[2]}, sn[4] = {c01[1], c01[3], c23[1], c23[3]};
                        f32x4 o1, o2;
#pragma unroll
                        for (int e = 0; e < 4; ++e) { o1[e] = v0[e] * cs[e] - v1[e] * sn[e]; o2[e] = v1[e] * cs[e] + v0[e] * sn[e]; }
                        v0 = o1; v1 = o2;
                    }
                    u32x4 w; w.x = cvt_pk_bf16(v0[0], v0[1]); w.y = cvt_pk_bf16(v0[2], v0[3]); w.z = cvt_pk_bf16(v1[0], v1[1]); w.w = cvt_pk_bf16(v1[2], v1[3]);
                    *(u32x4*)(Q + (size_t)row * ldq + col) = w;
                }
        }
    }
};
#define XB_TMO      128
#define XB_XCNT(j)  (256  + 64 * (j))
#define XB_XSUB(j)  (1280 + 64 * (j))
#define XB_XGEN(j)  (2304 + 64 * (j))
#define XB_TOP      3328
#define XB_TOPGEN   3392
#define XCD_BAR_WORDS 3456
#define XB_SPIN_CAP (1u << 18)

__device__ __forceinline__ unsigned xb_ld(unsigned* p)              { return __hip_atomic_load(p, __ATOMIC_RELAXED, __HIP_MEMORY_SCOPE_AGENT); }
__device__ __forceinline__ unsigned xb_add(unsigned* p, unsigned v) { return __hip_atomic_fetch_add(p, v, __ATOMIC_RELAXED, __HIP_MEMORY_SCOPE_AGENT); }
__device__ __forceinline__ unsigned xb_xcc_id() { return (unsigned)__builtin_amdgcn_s_getreg((3 << 11) | 20) & 0xFu; }
#define XB_SPIN(cond, bar) do { unsigned _sp = 0; while (cond) { __builtin_amdgcn_s_sleep(1); \
    if ((++_sp & 255u) == 0u) { if (xb_ld(&(bar)[XB_TMO])) break; if (_sp > XB_SPIN_CAP) { atomicAdd(&(bar)[XB_TMO], 1u); break; } } } } while (0)

struct XcdBarrier {
    unsigned* bar; unsigned x;
    volatile LAS unsigned* st;
};

__device__ __forceinline__ XcdBarrier xcd_barrier_post(unsigned* bar, volatile LAS unsigned* st) {
    XcdBarrier b; b.bar = bar; b.x = xb_xcc_id(); b.st = st;
    if (threadIdx.x == 0) (void)xb_add(&bar[XB_XCNT(b.x)], 1u);
    return b;
}
__device__ __forceinline__ void xcd_barrier_complete(unsigned* bar, unsigned x, unsigned& nloc, unsigned& nx) {
    const unsigned G = gridDim.x * gridDim.y * gridDim.z;
    unsigned sum, cnt, mine, sp = 0u;
    for (;;) {
        sum = 0u; cnt = 0u; mine = 0u;
#pragma unroll
        for (unsigned j = 0; j < 16; ++j) { const unsigned c = xb_ld(&bar[XB_XCNT(j)]); sum += c; cnt += (c > 0u) ? 1u : 0u; mine = (j == x) ? c : mine; }
        if (sum == G) break;
        __builtin_amdgcn_s_sleep(1);
        if ((++sp & 255u) == 0u) { if (xb_ld(&bar[XB_TMO])) break; if (sp > XB_SPIN_CAP) { atomicAdd(&bar[XB_TMO], 1u); break; } }
    }
    nloc = mine > 0u ? mine : 1u; nx = cnt > 0u ? cnt : 1u;
}

__device__ __forceinline__ void xcd_barrier(const XcdBarrier& b) {
    asm volatile("s_waitcnt vmcnt(0)" ::: "memory");
    __syncthreads();
    if (threadIdx.x == 0) {
        unsigned* bar = b.bar;
        __builtin_amdgcn_s_waitcnt(0);
        unsigned nloc = b.st[0], nx = b.st[1];
        if (nloc == 0u) { xcd_barrier_complete(bar, b.x, nloc, nx); b.st[0] = nloc; b.st[1] = nx; }
        const unsigned old = xb_add(&bar[XB_XSUB(b.x)], 1u);
        const unsigned gen = old / nloc;
        if (old + 1u == (gen + 1u) * nloc) {
            __builtin_amdgcn_fence(__ATOMIC_RELEASE, "agent");
            asm volatile("s_waitcnt vmcnt(0)" ::: "memory");
            const unsigned og = xb_add(&bar[XB_TOP], 1u);
            const unsigned tg = og / nx;
            if (og + 1u == (tg + 1u) * nx) xb_add(&bar[XB_TOPGEN], 1u);
            else XB_SPIN(xb_ld(&bar[XB_TOPGEN]) == tg, bar);
            __builtin_amdgcn_fence(__ATOMIC_ACQUIRE, "agent");
            xb_add(&bar[XB_XGEN(b.x)], 1u);
            asm volatile("s_waitcnt vmcnt(0)" ::: "memory");
        } else {
            XB_SPIN(xb_ld(&bar[XB_XGEN(b.x)]) == gen, bar);
            __builtin_amdgcn_fence(__ATOMIC_ACQUIRE, "agent");
            asm volatile("s_waitcnt vmcnt(0)" ::: "memory");
        }
    }
    __syncthreads();
}
struct KP {
    float* out; unsigned char* ws; const int* pos;
    __device__ __forceinline__ const int* pos_local() const { int one = 1; asm volatile("" : "+s"(one)); return (const int*)(((const float* const*)(ws + WS_PT))[one]); }
#define KP_ACC(T_, NAME, OFF) __device__ __forceinline__ T_* NAME() const { return (T_*)(ws + (OFF)); }
    KP_ACC(bf16, WB, WS_W) KP_ACC(bf16, XB, WS_XB) KP_ACC(bf16, H, R_H) KP_ACC(bf16, HE, R_HE) KP_ACC(bf16, VT, R_VT) KP_ACC(bf16, QM, R_QM)
    KP_ACC(bf16, KN, R_KN) KP_ACC(bf16, VMT, R_VMT) KP_ACC(bf16, OE, R_OE) KP_ACC(bf16, KROT, R_KROT) KP_ACC(bf16, HC, R_HC) KP_ACC(bf16, KCC, R_KCC)
    KP_ACC(bf16, VCT, R_VCT) KP_ACC(bf16, QK, R_QK) KP_ACC(bf16, VOT, R_VOT) KP_ACC(bf16, OG, R_OG) KP_ACC(bf16, OO, R_OO)
    KP_ACC(float, RT, R_RT) KP_ACC(float, GT, R_GT) KP_ACC(float, RSTD, R_RSTD) KP_ACC(float, LSE, R_LSE) KP_ACC(float, CB, WS_CB) KP_ACC(unsigned, CTL, WS_CTL)
};

__device__ __forceinline__ int crow(int v, int hi) { return (v & 3) + 8 * (v >> 2) + 4 * hi; }
__device__ __forceinline__ float xhalf_max(float x) { auto rr = __builtin_amdgcn_permlane32_swap(__float_as_uint(x), __float_as_uint(x), false, false); return fmaxf(__uint_as_float(rr[0]), __uint_as_float(rr[1])); }
__device__ __forceinline__ float xhalf_sum(float x) { auto rr = __builtin_amdgcn_permlane32_swap(__float_as_uint(x), __float_as_uint(x), false, false); return __uint_as_float(rr[0]) + __uint_as_float(rr[1]); }
__device__ __forceinline__ float max16(const f32x16& s) {
    float a = fmaxf(fmaxf(s[0], s[1]), s[2]), b = fmaxf(fmaxf(s[3], s[4]), s[5]);
    a = fmaxf(fmaxf(a, s[6]), s[7]); b = fmaxf(fmaxf(b, s[8]), s[9]); a = fmaxf(fmaxf(a, s[10]), s[11]); b = fmaxf(fmaxf(b, s[12]), s[13]);
    return fmaxf(fmaxf(a, b), fmaxf(s[14], s[15])); }

template <int DK16>
__device__ __forceinline__ f32x16 qk_sub(const LAS unsigned char* Kt, int ks, int sub, const bf16x8 (&qf)[DK16], int r32, int hi) {
    f32x16 s;
#pragma unroll
    for (int v = 0; v < 16; ++v) s[v] = 0.f;
    const LAS unsigned char* p = Kt + (sub * 32 + r32) * ks + hi * 16;
#pragma unroll
    for (int dk = 0; dk < DK16; ++dk) { const bf16x8 kf = *(const LAS bf16x8*)(p + dk * 32); s = __builtin_amdgcn_mfma_f32_32x32x16_bf16(kf, qf[dk], s, 0, 0, 0); }
    return s;
}
template <int DV32>
__device__ __forceinline__ void pv_sub(f32x16 (&o)[DV32], const LAS unsigned char* Vt, int vs, int sub, const f32x16& p, int r32, int hi) {
#pragma unroll
    for (int kb = 0; kb < 2; ++kb) {
        u32x4 pw; pw.x = cvt_pk_bf16(p[8 * kb + 0], p[8 * kb + 1]); pw.y = cvt_pk_bf16(p[8 * kb + 2], p[8 * kb + 3]); pw.z = cvt_pk_bf16(p[8 * kb + 4], p[8 * kb + 5]); pw.w = cvt_pk_bf16(p[8 * kb + 6], p[8 * kb + 7]);
        const bf16x8 pf = __builtin_bit_cast(bf16x8, pw);
#pragma unroll
        for (int i = 0; i < DV32; ++i) {
            const bf16x8 vf = *(const LAS bf16x8*)(Vt + (32 * i + r32) * vs + sub * 64 + kb * 32 + hi * 16);
            o[i] = __builtin_amdgcn_mfma_f32_32x32x16_bf16(vf, pf, o[i], 0, 0, 0);
        }
    }
}
template <int DV32>
__device__ __forceinline__ void pv_packed(f32x16 (&o)[DV32], const LAS unsigned char* Vt, int vs, int sub, const u32x4& pk0, const u32x4& pk1, int r32, int hi) {
#pragma unroll
    for (int kb = 0; kb < 2; ++kb) {
        const bf16x8 pf = __builtin_bit_cast(bf16x8, kb == 0 ? pk0 : pk1);
#pragma unroll
        for (int i = 0; i < DV32; ++i) {
            const bf16x8 vf = *(const LAS bf16x8*)(Vt + (32 * i + r32) * vs + sub * 64 + kb * 32 + hi * 16);
            o[i] = __builtin_amdgcn_mfma_f32_32x32x16_bf16(vf, pf, o[i], 0, 0, 0);
        }
    }
}
__device__ __forceinline__ u32x4 pack8(const f32x16& p, int kb) {
    u32x4 pw; pw.x = cvt_pk_bf16(p[8 * kb + 0], p[8 * kb + 1]); pw.y = cvt_pk_bf16(p[8 * kb + 2], p[8 * kb + 3]); pw.z = cvt_pk_bf16(p[8 * kb + 4], p[8 * kb + 5]); pw.w = cvt_pk_bf16(p[8 * kb + 6], p[8 * kb + 7]); return pw; }
template <int D, int DV, int MODE, bool HASBIAS, bool JOINT, bool DEFER, class KA, class VA, class PF, class BF, class VF, class NM, class WS, class CB>
__device__ __forceinline__ void fa_loop(LAS unsigned char* lds, int nt, const KA& ka, const VA& va, const PF& pf, const BF& bf, const VF& vf, const NM& nm, const WS& wskip, const CB& cb, float c1,
                                        const bf16x8 (&qf)[D / 16], float& m, float& l, f32x16 (&o)[DV / 32], int tid_in, int r32, int hi) {
    int tid = tid_in; asm volatile("" : "+v"(tid));
    constexpr int KS = D * 2 + 16, VS = 144, KCH = D / 8, NKR = (64 * KCH + 511) / 512, NVR = (DV * 8) / 512, NVS = DEFER ? 3 : 2, KOFF = 0, VOFF = 2 * 64 * KS, POFF = VOFF + NVS * DV * VS;
    constexpr bool NEEDV = (MODE != 1);
    u32x4 kregA[NKR], kregB[NKR]; u32x4 vregA[NVR], vregB[NVR]; float pregA = 0.f, pregB = 0.f;
    if (nt <= 0) return;
#define FA_LOAD(t_, KR, VR, PR) do { \
    _Pragma("unroll") for (int r_ = 0; r_ < NKR; ++r_) { const int idx_ = tid + 512 * r_; if (idx_ < 64 * KCH) { const int row_ = idx_ / KCH, ch_ = idx_ % KCH; KR[r_] = *(const u32x4*)ka((t_), row_, ch_); } } \
    if (NEEDV) { _Pragma("unroll") for (int r_ = 0; r_ < NVR; ++r_) { const int idx_ = tid + 512 * r_; const int d_ = idx_ >> 3, ch_ = idx_ & 7; VR[r_] = *(const u32x4*)va((t_), d_, ch_); } } \
    if (HASBIAS) { if (tid < 64) PR = pf((t_), tid); } } while (0)
#define FA_STORE(tt_, KR, VR, PR) do { LAS unsigned char* kb_ = lds + KOFF + ((tt_) & 1) * (64 * KS); LAS unsigned char* vb_ = lds + VOFF + ((tt_) % NVS) * (DV * VS); \
    _Pragma("unroll") for (int r_ = 0; r_ < NKR; ++r_) { const int idx_ = tid + 512 * r_; if (idx_ < 64 * KCH) { const int row_ = idx_ / KCH, ch_ = idx_ % KCH; *(LAS u32x4*)(kb_ + row_ * KS + ch_ * 16) = KR[r_]; } } \
    if (NEEDV) { _Pragma("unroll") for (int r_ = 0; r_ < NVR; ++r_) { const int idx_ = tid + 512 * r_; const int d_ = idx_ >> 3, ch_ = idx_ & 7; LAS unsigned char* q_ = vb_ + d_ * VS + (ch_ >> 2) * 64 + ((ch_ & 2) << 4) + ((ch_ & 1) << 3); *(LAS u32x2*)q_ = (u32x2){VR[r_].x, VR[r_].y}; *(LAS u32x2*)(q_ + 16) = (u32x2){VR[r_].z, VR[r_].w}; } } \
    if (HASBIAS) { if (tid < 64) *(LAS float*)(lds + POFF + ((tt_) & 1) * 256 + tid * 4) = PR; } } while (0)
    const bool defer_wave = DEFER && (tid_in >= 256);
    u32x4 pp0 = {0u, 0u, 0u, 0u}, pp1 = pp0, pp2 = pp0, pp3 = pp0; int pend = -1;
    auto compute = [&](int t, int bufi) __attribute__((always_inline)) {
        const LAS unsigned char* cur = lds + KOFF + (t & 1) * (64 * KS);
        const int vslot = t % NVS; const LAS unsigned char* curv = lds + VOFF + vslot * (DV * VS);
        const LAS float* kp = (const LAS float*)(lds + POFF + (t & 1) * 256);
        if (DEFER) { if (pend >= 0) { const LAS unsigned char* pv_ = lds + VOFF + pend * (DV * VS); pv_packed<DV / 32>(o, pv_, VS, 0, pp0, pp1, r32, hi); pv_packed<DV / 32>(o, pv_, VS, 1, pp2, pp3, r32, hi); pend = -1; } }
        const bool sk0 = wskip(t, 0), sk1 = wskip(t, 1);
        if (JOINT && MODE != 2 && !sk0 && !sk1) {
            f32x16 s0 = qk_sub<D / 16>(cur, KS, 0, qf, r32, hi); if (DEFER) __builtin_amdgcn_sched_barrier(0); f32x16 s1 = qk_sub<D / 16>(cur, KS, 1, qf, r32, hi);
            if (HASBIAS) {
#pragma unroll
                for (int a4 = 0; a4 < 4; ++a4) { const int kin0 = 8 * a4 + 4 * hi; const f32x4 kq0 = *(const LAS f32x4*)(kp + kin0), kq1 = *(const LAS f32x4*)(kp + 32 + kin0);
#pragma unroll
                    for (int e = 0; e < 4; ++e) { s0[4 * a4 + e] = s0[4 * a4 + e] * c1 + bf(t, kin0 + e, kq0[e]); s1[4 * a4 + e] = s1[4 * a4 + e] * c1 + bf(t, 32 + kin0 + e, kq1[e]); } }
            }
            const bool masked = nm(t, 0) || nm(t, 1);
            if (masked) {
#pragma unroll
                for (int v = 0; v < 16; ++v) { const int kin = crow(v, hi); if (!vf(t, kin)) s0[v] = NEGB; if (!vf(t, 32 + kin)) s1[v] = NEGB; }
            }
            float mx = xhalf_max(fmaxf(max16(s0), max16(s1)));
            const float mn = fmaxf(m, mx); float sum0 = 0.f, sum1 = 0.f;
            if (masked) {
#pragma unroll
                for (int v = 0; v < 16; ++v) { const float p0 = s0[v] > -1e29f ? fast_exp2(s0[v] - mn) : 0.f, p1 = s1[v] > -1e29f ? fast_exp2(s1[v] - mn) : 0.f; s0[v] = p0; s1[v] = p1; sum0 += p0; sum1 += p1; }
            } else {
#pragma unroll
                for (int v = 0; v < 16; ++v) { const float p0 = fast_exp2(s0[v] - mn), p1 = fast_exp2(s1[v] - mn); s0[v] = p0; s1[v] = p1; sum0 += p0; sum1 += p1; }
            }
            if (__any(mn > m)) {
                const float alpha = fast_exp2(m - mn); l *= alpha;
                if (MODE == 0) {
#pragma unroll
                    for (int i = 0; i < DV / 32; ++i)
#pragma unroll
                        for (int v = 0; v < 16; ++v) o[i][v] *= alpha;
                }
            }
            l += sum0 + sum1; m = mn;
            if (MODE == 0) {
                if (defer_wave) { pp0 = pack8(s0, 0); pp1 = pack8(s0, 1); pp2 = pack8(s1, 0); pp3 = pack8(s1, 1); pend = vslot; }
                else { pv_sub<DV / 32>(o, curv, VS, 0, s0, r32, hi); pv_sub<DV / 32>(o, curv, VS, 1, s1, r32, hi); }
            }
        } else
#pragma unroll
        for (int sub = 0; sub < 2; ++sub) {
            if (!wskip(t, sub)) {
                f32x16 s = qk_sub<D / 16>(cur, KS, sub, qf, r32, hi);
                if (HASBIAS) {
#pragma unroll
                    for (int a4 = 0; a4 < 4; ++a4) { const int kin0 = sub * 32 + 8 * a4 + 4 * hi; const f32x4 kq = *(const LAS f32x4*)(kp + kin0);
#pragma unroll
                        for (int e = 0; e < 4; ++e) s[4 * a4 + e] = s[4 * a4 + e] * c1 + bf(t, kin0 + e, kq[e]); }
                }
                const bool masked = nm(t, sub);
                if (masked) {
#pragma unroll
                    for (int v = 0; v < 16; ++v) { const int kin = sub * 32 + crow(v, hi); if (!vf(t, kin)) s[v] = NEGB; }
                }
                if (MODE == 2) {
                    if (masked) {
#pragma unroll
                        for (int v = 0; v < 16; ++v) s[v] = s[v] > -1e29f ? fast_exp2(s[v] - m) * l : 0.f;
                    } else {
#pragma unroll
                        for (int v = 0; v < 16; ++v) s[v] = fast_exp2(s[v] - m) * l;
                    }
                    cb(t, sub, s);
                    pv_sub<DV / 32>(o, curv, VS, sub, s, r32, hi);
                } else {
                    float mx0 = fmaxf(fmaxf(s[0], s[1]), s[2]), mx1 = fmaxf(fmaxf(s[3], s[4]), s[5]);
                    mx0 = fmaxf(fmaxf(mx0, s[6]), s[7]); mx1 = fmaxf(fmaxf(mx1, s[8]), s[9]); mx0 = fmaxf(fmaxf(mx0, s[10]), s[11]); mx1 = fmaxf(fmaxf(mx1, s[12]), s[13]);
                    float mx = fmaxf(fmaxf(mx0, mx1), fmaxf(s[14], s[15]));
                    mx = xhalf_max(mx);
                    const float mn = fmaxf(m, mx); float sum = 0.f;
                    if (masked) {
#pragma unroll
                        for (int v = 0; v < 16; ++v) { const float p = s[v] > -1e29f ? fast_exp2(s[v] - mn) : 0.f; s[v] = p; sum += p; }
                    } else {
#pragma unroll
                        for (int v = 0; v < 16; ++v) { const float p = fast_exp2(s[v] - mn); s[v] = p; sum += p; }
                    }
                    if (__any(mn > m)) {
                        const float alpha = fast_exp2(m - mn); l *= alpha;
                        if (MODE == 0) {
#pragma unroll
                            for (int i = 0; i < DV / 32; ++i)
#pragma unroll
                                for (int v = 0; v < 16; ++v) o[i][v] *= alpha;
                        }
                    }
                    l += sum; m = mn;
                    if (MODE == 0) pv_sub<DV / 32>(o, curv, VS, sub, s, r32, hi);
                }
            }
        }
    };
    if (DEFER) {
        FA_LOAD(0, kregA, vregA, pregA); FA_STORE(0, kregA, vregA, pregA); __syncthreads();
        for (int t = 0; t < nt; ++t) {
            asm volatile("" : "+v"(tid));
            if (t + 1 < nt) FA_LOAD(t + 1, kregA, vregA, pregA);
            compute(t, 0);
            asm volatile("" : "+v"(tid));
            if (t + 1 < nt) FA_STORE(t + 1, kregA, vregA, pregA);
            __syncthreads();
        }
    } else {
    FA_LOAD(0, kregA, vregA, pregA); FA_STORE(0, kregA, vregA, pregA); if (nt > 1) FA_LOAD(1, kregB, vregB, pregB); __syncthreads();
    for (int t = 0; t < nt; t += 2) {
        if (t + 2 < nt) FA_LOAD(t + 2, kregA, vregA, pregA);
        compute(t, 0);
        if (t + 1 < nt) FA_STORE(t + 1, kregB, vregB, pregB);
        __syncthreads();
        if (t + 1 < nt) {
            if (t + 3 < nt) FA_LOAD(t + 3, kregB, vregB, pregB);
            compute(t + 1, 1);
            if (t + 2 < nt) FA_STORE(t + 2, kregA, vregA, pregA);
            __syncthreads();
        }
    }
    }
    if (DEFER) { if (pend >= 0) { const LAS unsigned char* pv_ = lds + VOFF + pend * (DV * VS); pv_packed<DV / 32>(o, pv_, VS, 0, pp0, pp1, r32, hi); pv_packed<DV / 32>(o, pv_, VS, 1, pp2, pp3, r32, hi); }
        __syncthreads(); }
#undef FA_LOAD
#undef FA_STORE
}
template <int NV>
__device__ __forceinline__ void store_o(bf16* op, const f32x16 (&o)[NV], float sc, int hi) {
#pragma unroll
    for (int i = 0; i < NV; ++i)
#pragma unroll
        for (int a = 0; a < 4; ++a) {
            u32x2 wv; wv.x = cvt_pk_bf16(o[i][4 * a] * sc, o[i][4 * a + 1] * sc); wv.y = cvt_pk_bf16(o[i][4 * a + 2] * sc, o[i][4 * a + 3] * sc);
            *(u32x2*)(op + 32 * i + 8 * a + 4 * hi) = wv;
        }
}
struct NoCb { __device__ __forceinline__ void operator()(int, int, const f32x16&) const {} };

__device__ __forceinline__ void mla_unit(const KP& P, LAS unsigned char* lds, int b, int h, int qb, int tid_u) {
    int tid = tid_u; asm volatile("" : "+v"(tid));
    const int* const posp = P.pos_local();
    const int lane = tid & 63, w = __builtin_amdgcn_readfirstlane(tid >> 6), r32 = lane & 31, hi = lane >> 5;
    const int q0 = qb * 256, tq = q0 + 32 * w + r32; const size_t bS = (size_t)b * SEQ, tok = bS + tq;
    bf16x8 qf[6];
#pragma unroll
    for (int dk = 0; dk < 6; ++dk) qf[dk] = *(const bf16x8*)(P.QM() + tok * 768 + h * 96 + dk * 16 + hi * 8);
    const int nt = (q0 + 256) / 64;
    auto ka = [&](int t, int row, int ch) -> const bf16* { const size_t tk = bS + 64 * t + row; return ch < 8 ? P.KN() + tk * 512 + h * 64 + ch * 8 : P.KROT() + tk * 32 + (ch - 8) * 8; };
    auto va = [&](int t, int d, int ch) -> const bf16* { return P.VMT() + (size_t)(h * 64 + d) * T + bS + 64 * t + ch * 8; };
    auto pf = [&](int, int) -> float { return 0.f; };
    auto bf = [&](int, int, float) -> float { return 0.f; };
    auto vf = [&](int t, int kin) -> bool { return 64 * t + kin <= tq; };
    const int wq_lo = q0 + 32 * w, wq_hi = wq_lo + 31;
    auto nm = [&](int t, int sub) -> bool { return 64 * t + 32 * sub + 31 > wq_lo; };
    auto ws = [&](int t, int sub) -> bool { return 64 * t + 32 * sub > wq_hi; };
    float m = NEGB, l = 0.f; f32x16 o[2];
#pragma unroll
    for (int i = 0; i < 2; ++i)
#pragma unroll
        for (int v = 0; v < 16; ++v) o[i][v] = 0.f;
    fa_loop<96, 64, 0, false, true, false>(lds, nt, ka, va, pf, bf, vf, nm, ws, NoCb(), 1.f, qf, m, l, o, tid, r32, hi);
    l = xhalf_sum(l); const float inv = l > 0.f ? 1.f / l : 0.f;
    store_o<2>(P.OE() + tok * 1024 + h * 64, o, inv, hi);
}

constexpr int NSA_GL = 40960, NSA_SELM = NSA_GL + 8 * 2 * 8 * 132 * 4, NSA_BU = NSA_SELM + 1024, NSA_TL = NSA_BU + 32;
__device__ __forceinline__ void nsa_unit(const KP& P, LAS unsigned char* lds, int b, int c, int g, int tid_u) {
    int tid = tid_u; asm volatile("" : "+v"(tid));
    const int* const posp = P.pos_local();
    const int lane = tid & 63, w = __builtin_amdgcn_readfirstlane(tid >> 6), r32 = lane & 31, hi = lane >> 5;
    const int n = r32 >> 3, qi = r32 & 7, hh = g * 4 + n;
    const int tq = 64 * c + 8 * w + qi; const size_t bS = (size_t)b * SEQ, tok = bS + tq;
    const float slope2 = fast_exp2(-(float)(hh + 1)) * LOG2E, c1 = 0.125f * LOG2E;
    const float pq = (float)posp[tok], nbq = -slope2 * pq;
    bf16x8 qf[4];
#pragma unroll
    for (int dk = 0; dk < 4; ++dk) qf[dk] = *(const bf16x8*)(P.HE() + tok * HE_LD + HE_Q + hh * 64 + dk * 16 + hi * 8);
    LAS float* GLw = (LAS float*)(lds + NSA_GL) + w * (2 * 8 * 132);
    LAS unsigned long long* SELM = (LAS unsigned long long*)(lds + NSA_SELM);
    LAS unsigned* BU = (LAS unsigned*)(lds + NSA_BU);
    LAS int* TL = (LAS int*)(lds + NSA_TL);
    for (int i = tid; i < 8 * 2 * 8 * 132; i += 512) ((LAS float*)(lds + NSA_GL))[i] = 0.f;
    if (tid < 8) BU[tid] = 0u;
    __syncthreads();
    const int wq_lo = 64 * c + 8 * w, wq_hi = wq_lo + 7;
    f32x16 o[2];
#pragma unroll
    for (int i = 0; i < 2; ++i)
#pragma unroll
        for (int v = 0; v < 16; ++v) o[i][v] = 0.f;
    LAS float* stash = (LAS float*)(lds + NSA_GL) + tid;
    {
        const int nt1 = (4 * c + 3 + 63) >> 6;
        auto ka1 = [&](int t, int row, int ch) -> const bf16* { return P.KCC() + ((size_t)b * 512 + 64 * t + row) * 128 + g * 64 + ch * 8; };
        auto va1 = [&](int t, int d, int ch) -> const bf16* { return P.VCT() + (size_t)(g * 64 + d) * 8192 + b * 512 + 64 * t + ch * 8; };
        auto pf1 = [&](int t, int i) -> float { int j = 64 * t + i; j = j > 510 ? 510 : j; return (float)posp[bS + 31 + 16 * j]; };
        auto bf1 = [&](int, int, float kp) -> float { return kp * slope2 + nbq; };
        auto vf1 = [&](int t, int kin) -> bool { const int j = 64 * t + kin; return 16 * j + 31 <= tq; };
        auto nm1 = [&](int t, int sub) -> bool { return 16 * (64 * t + 32 * sub + 31) + 31 > wq_lo; };
        auto ws1 = [&](int t, int sub) -> bool { return 16 * (64 * t + 32 * sub) + 31 > wq_hi; };
        float m1 = NEGB, l1 = 0.f;
        fa_loop<64, 64, 1, true, false, false>(lds, nt1, ka1, va1, pf1, bf1, vf1, nm1, ws1, NoCb(), c1, qf, m1, l1, o, tid, r32, hi);
        l1 = xhalf_sum(l1); float invl = l1 > 0.f ? 1.f / l1 : 0.f;
        auto cb1 = [&](int t, int sub, const f32x16& p) {
#pragma unroll
            for (int a = 0; a < 4; ++a) {
                float gsum = (p[4 * a] + p[4 * a + 1]) + (p[4 * a + 2] + p[4 * a + 3]), last = p[4 * a + 3];
                gsum += __shfl_xor(gsum, 8); gsum += __shfl_xor(gsum, 16); last += __shfl_xor(last, 8); last += __shfl_xor(last, 16);
                const int u = (64 * t + 32 * sub) / 4 + 2 * a + hi;
                if (r32 < 8) { GLw[qi * 132 + u] = gsum; GLw[8 * 132 + qi * 132 + u + 1] = last; }
            }
        };
        fa_loop<64, 64, 2, true, false, false>(lds, nt1, ka1, va1, pf1, bf1, vf1, nm1, ws1, cb1, c1, qf, m1, invl, o, tid, r32, hi);
        const float gtc = P.GT()[tok * 24 + hh];
#pragma unroll
        for (int i = 0; i < 2; ++i)
#pragma unroll
            for (int v = 0; v < 16; ++v) o[i][v] *= gtc;
    }
    unsigned long long wu0 = 0ull, wu1 = 0ull;
    {
        const int ncand = c - 1 > 0 ? c - 1 : 0, need = 16 - (c == 0 ? 1 : 2);
        for (int q = 0; q < 8; ++q) {
            const int s0 = lane, s1 = lane + 64;
            const bool c0 = (s0 >= 1) && (s0 <= c - 1), cc1 = (s1 <= c - 1);
            const float f0 = c0 ? GLw[q * 132 + s0] + GLw[8 * 132 + q * 132 + s0] : 0.f;
            const float f1 = cc1 ? GLw[q * 132 + s1] + GLw[8 * 132 + q * 132 + s1] : 0.f;
            const unsigned b0 = __float_as_uint(f0), b1 = __float_as_uint(f1);
            unsigned long long sel0, sel1;
            if (ncand <= need) { sel0 = __ballot(c0); sel1 = __ballot(cc1); }
            else {
                unsigned x = 0u;
                for (int bit = 30; bit >= 0; --bit) {
                    const unsigned tt = x | (1u << bit);
                    const int cnt = __popcll(__ballot(c0 && b0 >= tt)) + __popcll(__ballot(cc1 && b1 >= tt));
                    if (cnt >= need) x = tt;
                }
                sel0 = __ballot(c0 && b0 > x); sel1 = __ballot(cc1 && b1 > x);
                int rem = need - (__popcll(sel0) + __popcll(sel1));
                unsigned long long e0 = __ballot(c0 && b0 == x), e1 = __ballot(cc1 && b1 == x);
                while (rem > 0 && e0) { const unsigned long long low = e0 & (~e0 + 1ull); sel0 |= low; e0 ^= low; --rem; }
                while (rem > 0 && e1) { const unsigned long long low = e1 & (~e1 + 1ull); sel1 |= low; e1 ^= low; --rem; }
            }
            sel0 |= 1ull; if (c < 64) sel0 |= 1ull << c; else sel1 |= 1ull << (c - 64);
            if (lane == 0) { SELM[(w * 8 + q) * 2] = sel0; SELM[(w * 8 + q) * 2 + 1] = sel1; }
            wu0 |= sel0; wu1 |= sel1;
        }
        if (lane == 0) { atomicOr((unsigned*)&BU[0], (unsigned)wu0); atomicOr((unsigned*)&BU[1], (unsigned)(wu0 >> 32)); atomicOr((unsigned*)&BU[2], (unsigned)wu1); atomicOr((unsigned*)&BU[3], (unsigned)(wu1 >> 32)); }
    }
    __syncthreads();
#pragma unroll
    for (int i = 0; i < 2; ++i)
#pragma unroll
        for (int v = 0; v < 16; ++v) { stash[(i * 16 + v) * 512] = o[i][v]; o[i][v] = 0.f; }
    if (tid < 128) {
        const unsigned u0 = BU[0], u1 = BU[1], u2 = BU[2], u3 = BU[3];
        const int k = tid >> 5; const unsigned wk = k == 0 ? u0 : (k == 1 ? u1 : (k == 2 ? u2 : u3));
        if ((wk >> (tid & 31)) & 1u) {
            int pos = __popc(wk & ((1u << (tid & 31)) - 1u));
            if (k > 0) pos += __popc(u0); if (k > 1) pos += __popc(u1); if (k > 2) pos += __popc(u2);
            TL[pos] = tid;
        }
        if (tid == 0) BU[4] = __popc(u0) + __popc(u1) + __popc(u2) + __popc(u3);
    }
    __syncthreads();
    const unsigned long long ms0 = SELM[(w * 8 + qi) * 2], ms1 = SELM[(w * 8 + qi) * 2 + 1];
    {
        const int nsel = (int)BU[4];
        auto ka2 = [&](int t, int row, int ch) -> const bf16* { const int sb = TL[t]; return P.HE() + (bS + 64 * sb + row) * HE_LD + HE_KS + g * 64 + ch * 8; };
        auto va2 = [&](int t, int d, int ch) -> const bf16* { const int sb = TL[t]; return P.VT() + (size_t)(g * 64 + d) * T + bS + 64 * sb + ch * 8; };
        auto pf2 = [&](int t, int i) -> float { const int sb = TL[t]; return (float)posp[bS + 64 * sb + i]; };
        auto bf2 = [&](int, int, float kp) -> float { return kp * slope2 + nbq; };
        auto vf2 = [&](int t, int kin) -> bool { const int sb = TL[t]; const bool selb = (((sb < 64 ? ms0 : ms1) >> (sb & 63)) & 1ull) != 0ull; return selb && (64 * sb + kin <= tq); };
        auto nm2 = [&](int t, int) -> bool { const int sb = TL[t]; const bool selb = (((sb < 64 ? ms0 : ms1) >> (sb & 63)) & 1ull) != 0ull; return sb == c || !__all(selb); };
        auto ws2 = [&](int t, int) -> bool { const int sb = TL[t]; return (((sb < 64 ? wu0 : wu1) >> (sb & 63)) & 1ull) == 0ull; };
        float m2 = NEGB, l2 = 0.f;
        fa_loop<64, 64, 0, true, false, false>(lds, nsel, ka2, va2, pf2, bf2, vf2, nm2, ws2, NoCb(), c1, qf, m2, l2, o, tid, r32, hi);
        l2 = xhalf_sum(l2); const float gts = P.GT()[tok * 24 + 8 + hh]; const float sc = l2 > 0.f ? gts / l2 : 0.f;
#pragma unroll
        for (int i = 0; i < 2; ++i)
#pragma unroll
            for (int v = 0; v < 16; ++v) { stash[(i * 16 + v) * 512] += o[i][v] * sc; o[i][v] = 0.f; }
    }
    {
        const int first = c < 8 ? 8 - c : 0, nt3 = 9 - first, base3 = 64 * c - 512 + 64 * first;
        auto ka3 = [&](int t, int row, int ch) -> const bf16* { return P.HE() + (bS + base3 + 64 * t + row) * HE_LD + HE_KW + g * 64 + ch * 8; };
        auto va3 = [&](int t, int d, int ch) -> const bf16* { return P.VT() + (size_t)(128 + g * 64 + d) * T + bS + base3 + 64 * t + ch * 8; };
        auto pf3 = [&](int t, int i) -> float { return (float)posp[bS + base3 + 64 * t + i]; };
        auto bf3 = [&](int, int, float kp) -> float { return kp * slope2 + nbq; };
        auto vf3 = [&](int t, int kin) -> bool { const int df = tq - (base3 + 64 * t + kin); return df >= 0 && df < 512; };
        auto nm3 = [&](int t, int sub) -> bool { const int k0 = base3 + 64 * t + 32 * sub; return k0 + 31 > wq_lo || k0 < wq_hi - 511; };
        auto ws3 = [&](int t, int sub) -> bool { const int k0 = base3 + 64 * t + 32 * sub; return k0 > wq_hi || k0 + 31 < wq_lo - 511; };
        float m3 = NEGB, l3 = 0.f;
        fa_loop<64, 64, 0, true, false, false>(lds, nt3, ka3, va3, pf3, bf3, vf3, nm3, ws3, NoCb(), c1, qf, m3, l3, o, tid, r32, hi);
        l3 = xhalf_sum(l3); const float gtw = P.GT()[tok * 24 + 16 + hh]; const float sc = l3 > 0.f ? gtw / l3 : 0.f;
#pragma unroll
        for (int i = 0; i < 2; ++i)
#pragma unroll
            for (int v = 0; v < 16; ++v) o[i][v] = o[i][v] * sc + stash[(i * 16 + v) * 512];
    }
    store_o<2>(P.OE() + tok * 1024 + 512 + hh * 64, o, 1.f, hi);
}

__device__ __forceinline__ void dil_unit(const KP& P, LAS unsigned char* lds, int b, int g, int h, int rj, int tid_u) {
    int tid = tid_u; asm volatile("" : "+v"(tid));
    const int* const posp = P.pos_local();
    const int lane = tid & 63, w = __builtin_amdgcn_readfirstlane(tid >> 6), r32 = lane & 31, hi = lane >> 5;
    const int dil = g == 0 ? 1 : (g == 1 ? 4 : 16), per = 32 / dil, r = rj / per, jt = rj % per, clen = SEQ / dil;
    const int J = 256 * jt + 32 * w + r32; const size_t bS = (size_t)b * SEQ, tok = bS + r + dil * J;
    const float slope2 = fast_exp2(-8.f * (float)(g * 4 + h + 1) / 12.f) * LOG2E, c1 = 0.08838834764831845f * LOG2E;
    const float pq = (float)posp[tok], nbq = -slope2 * pq;
    bf16x8 qf[8];
#pragma unroll
    for (int dk = 0; dk < 8; ++dk) qf[dk] = *(const bf16x8*)(P.QK() + tok * 3072 + g * 512 + h * 128 + dk * 16 + hi * 8);
    const int first = jt == 0 ? 2 : 0, nt = 6 - first, I00 = 256 * jt - 128 + 64 * first;
    auto ka = [&](int t, int row, int ch) -> const bf16* { return P.QK() + (bS + r + (size_t)dil * (I00 + 64 * t + row)) * 3072 + 1536 + g * 512 + h * 128 + ch * 8; };
    auto va = [&](int t, int d, int ch) -> const bf16* { return P.VOT() + (size_t)(g * 512 + h * 128 + d) * T + bS + (size_t)r * clen + I00 + 64 * t + ch * 8; };
    auto pf = [&](int t, int i) -> float { return (float)posp[bS + r + dil * (I00 + 64 * t + i)]; };
    auto bf = [&](int, int, float kp) -> float { return kp * slope2 + nbq; };
    auto vf = [&](int t, int kin) -> bool { const int df = J - (I00 + 64 * t + kin); return df >= 0 && df <= 128; };
    const int Jw = 256 * jt + 32 * w;
    auto nm = [&](int t, int sub) -> bool { const int i0 = I00 + 64 * t + 32 * sub; return i0 + 31 > Jw || i0 < Jw + 31 - 128; };
    auto ws = [&](int t, int sub) -> bool { const int i0 = I00 + 64 * t + 32 * sub; return i0 > Jw + 31 || i0 + 31 < Jw - 128; };
    float m = NEGB, l = 0.f; f32x16 o[4];
#pragma unroll
    for (int i = 0; i < 4; ++i)
#pragma unroll
        for (int v = 0; v < 16; ++v) o[i][v] = 0.f;
    fa_loop<128, 128, 0, true, false, false>(lds, nt, ka, va, pf, bf, vf, nm, ws, NoCb(), c1, qf, m, l, o, tid, r32, hi);
    l = xhalf_sum(l); const float inv = l > 0.f ? 1.f / l : 0.f;
    store_o<4>(P.OG() + ((size_t)g * T + tok) * 512 + h * 128, o, inv, hi);
    if (hi == 0) P.LSE()[((size_t)g * T + tok) * 4 + h] = m + __log2f(l);
}
struct Args { const float* in[28]; float* out; unsigned char* ws; int ph_lo, ph_hi; };

enum { WM_ID = 0, WM_SWIGLU = 1, WM_E1 = 2, WM_E2 = 3, WM_UQ = 4 };
struct WSpec { const float* W; const float* W2; const float* gk; bf16* WT; int K, Nsrc, Ndst, mode, soff, nvalid; };
__device__ __forceinline__ void transpose_item(const WSpec& s, LAS float* scr, int item, int lane) {
    const int nblk = s.Ndst / 32, kb = item / nblk, nb = item % nblk, k0 = 128 * kb, n0 = 32 * nb;
    const int R = n0 + (lane & 31); int sc; const float* Wp = s.W;
    if (s.mode == WM_ID) sc = R < s.nvalid ? R + s.soff : -1;
    else if (s.mode == WM_SWIGLU) { sc = (R >> 8) * 128 + (R & 127); if ((R >> 7) & 1) Wp = s.W2; }
    else if (s.mode == WM_E1) sc = R < 1568 ? R : (R < 1696 ? R + 128 : (R < 1720 ? R + 256 : -1));
    else if (s.mode == WM_E2) sc = R < 128 ? 1568 + R : 1824 + (R - 128);
    else { const int h = R / 96, wq = R % 96; if (wq < 64) sc = R; else { const int p = wq - 64, fq = p >> 3, sub = p & 7; sc = 96 * h + 64 + (sub < 4 ? 4 * fq + sub : 16 + 4 * fq + (sub - 4)); } }
    if (s.mode != WM_UQ) {
        const int c4 = (lane & 7) * 4, R4 = n0 + c4; int sc4; const float* Wq = s.W;
        if (s.mode == WM_ID) sc4 = R4 < s.nvalid ? R4 + s.soff : -1;
        else if (s.mode == WM_SWIGLU) { sc4 = (R4 >> 8) * 128 + (R4 & 127); if ((R4 >> 7) & 1) Wq = s.W2; }
        else if (s.mode == WM_E1) sc4 = R4 < 1568 ? R4 : (R4 < 1696 ? R4 + 128 : (R4 < 1720 ? R4 + 256 : -1));
        else sc4 = R4 < 128 ? 1568 + R4 : 1824 + (R4 - 128);
        const float msk = sc4 >= 0 ? 1.f : 0.f; const int sc4c = sc4 >= 0 ? sc4 : 0;
        f32x4 vv[16];
#pragma unroll
        for (int i = 0; i < 16; ++i) { const int kk = 8 * i + (lane >> 3); vv[i] = *(const f32x4*)(Wq + (size_t)(k0 + kk) * s.Nsrc + sc4c); }
        if (s.gk) {
#pragma unroll
            for (int i = 0; i < 16; ++i) { const int kk = 8 * i + (lane >> 3); vv[i] = vv[i] * s.gk[k0 + kk]; }
        }
#pragma unroll
        for (int i = 0; i < 16; ++i) { const int kk = 8 * i + (lane >> 3); const f32x4 v = vv[i] * msk;
            scr[kk * 33 + c4] = v[0]; scr[kk * 33 + c4 + 1] = v[1]; scr[kk * 33 + c4 + 2] = v[2]; scr[kk * 33 + c4 + 3] = v[3]; }
    } else {
        float vs[64];
#pragma unroll
        for (int i = 0; i < 64; ++i) { const int kk = 2 * i + (lane >> 5); vs[i] = Wp[(size_t)(k0 + kk) * s.Nsrc + sc]; }
#pragma unroll
        for (int i = 0; i < 64; ++i) { const int kk = 2 * i + (lane >> 5); scr[kk * 33 + (lane & 31)] = vs[i] * s.gk[k0 + kk]; }
    }
    asm volatile("s_waitcnt lgkmcnt(0)" ::: "memory");
    const int c = lane & 15;
#pragma unroll
    for (int j = 0; j < 8; ++j) { const int nn = (lane >> 4) + 4 * j; const LAS float* sp = scr + (8 * c) * 33 + nn;
        u32x4 o; o.x = cvt_pk_bf16(sp[0 * 33], sp[1 * 33]); o.y = cvt_pk_bf16(sp[2 * 33], sp[3 * 33]); o.z = cvt_pk_bf16(sp[4 * 33], sp[5 * 33]); o.w = cvt_pk_bf16(sp[6 * 33], sp[7 * 33]);
        *(u32x4*)(s.WT + (size_t)(n0 + nn) * s.K + k0 + 8 * c) = o; }
    asm volatile("s_waitcnt lgkmcnt(0)" ::: "memory");
}
__device__ __forceinline__ const float* ffn_w(const Args& a, int f, int which) {
    const int L = f >> 1; const bool second = (f & 1) != 0;
    const float* base = which == 0 ? (second ? a.in[23] : a.in[4]) : (which == 1 ? (second ? a.in[24] : a.in[5]) : (second ? a.in[25] : a.in[6]));
    return base + (size_t)L * 1024 * 2816;
}
__device__ __forceinline__ void p0_prologue(const Args& a, const KP& P, LAS unsigned char* lds, int tid, int gw, int NGW) {
    const int lane = tid & 63, w = tid >> 6;
    LAS float* scr = (LAS float*)(lds + w * 17408);
    int cum = 0;
    for (int wi = 0; wi < 21; ++wi) {
        WSpec s; s.W2 = nullptr; s.gk = nullptr; s.mode = WM_ID; s.soff = 0;
        if (wi < 4) { s.W = ffn_w(a, wi, 0); s.W2 = ffn_w(a, wi, 1); s.K = 1024; s.Nsrc = 2816; s.Ndst = 5632; s.mode = WM_SWIGLU; s.WT = P.WB() + WE_GU + (size_t)wi * 5632 * 1024; }
        else if (wi < 8) { s.W = ffn_w(a, wi - 4, 2); s.K = 2816; s.Nsrc = 1024; s.Ndst = 1024; s.WT = P.WB() + WE_D + (size_t)(wi - 4) * 1024 * 2816; }
        else if (wi == 8) { s.W = a.in[7]; s.K = 1024; s.Nsrc = 1976; s.Ndst = 1792; s.mode = WM_E1; s.WT = P.WB() + WE_E1; }
        else if (wi == 9) { s.W = a.in[7]; s.K = 1024; s.Nsrc = 1976; s.Ndst = 256; s.mode = WM_E2; s.WT = P.WB() + WE_E2; }
        else if (wi == 10) { s.W = a.in[10]; s.gk = a.in[8]; s.K = 384; s.Nsrc = 768; s.Ndst = 768; s.mode = WM_UQ; s.WT = P.WB() + WE_UQ; }
        else if (wi == 11) { s.W = a.in[11]; s.gk = a.in[9]; s.K = 256; s.Nsrc = 512; s.Ndst = 512; s.WT = P.WB() + WE_UK; }
        else if (wi == 12) { s.W = a.in[12]; s.gk = a.in[9]; s.K = 256; s.Nsrc = 512; s.Ndst = 512; s.WT = P.WB() + WE_UV; }
        else if (wi == 13) { s.W = a.in[14]; s.K = 2048; s.Nsrc = 256; s.Ndst = 256; s.WT = P.WB() + WE_C1K; }
        else if (wi == 14) { s.W = a.in[16]; s.K = 2048; s.Nsrc = 256; s.Ndst = 256; s.WT = P.WB() + WE_C1V; }
        else if (wi == 15) { s.W = a.in[15]; s.K = 256; s.Nsrc = 64; s.Ndst = 256; s.WT = P.WB() + WE_C2K; }
        else if (wi == 16) { s.W = a.in[17]; s.K = 256; s.Nsrc = 64; s.Ndst = 256; s.WT = P.WB() + WE_C2V; }
        else if (wi == 17) { s.W = a.in[18]; s.K = 1024; s.Nsrc = 1024; s.Ndst = 1024; s.WT = P.WB() + WE_OE; }
        else if (wi == 18) { s.W = a.in[19]; s.K = 1024; s.Nsrc = 4608; s.Ndst = 3072; s.WT = P.WB() + WE_O1; }
        else if (wi == 19) { s.W = a.in[19]; s.K = 1024; s.Nsrc = 4608; s.Ndst = 1536; s.soff = 3072; s.WT = P.WB() + WE_O2; }
        else { s.W = a.in[20]; s.K = 512; s.Nsrc = 1024; s.Ndst = 1024; s.WT = P.WB() + WE_OO; }
        s.nvalid = (wi == 15 || wi == 16) ? 64 : s.Ndst;
        const int nitems = (s.K / 128) * (s.Ndst / 32);
        { int it0 = (gw - cum) % NGW; if (it0 < 0) it0 += NGW; for (int it = it0; it < nitems; it += NGW) transpose_item(s, scr, it, lane); cum = (cum + nitems) % NGW; }
    }
    { const float* x = a.in[0]; const size_t n8 = (size_t)T * DM / 8; const size_t gt = (size_t)gw * 64 + lane, NT_ = (size_t)NGW * 64;
#pragma unroll 4
      for (size_t i = gt; i < n8; i += NT_) { const f32x4 v0 = *(const f32x4*)(x + i * 8), v1 = *(const f32x4*)(x + i * 8 + 4);
          u32x4 o; o.x = cvt_pk_bf16(v0[0], v0[1]); o.y = cvt_pk_bf16(v0[2], v0[3]); o.z = cvt_pk_bf16(v1[0], v1[1]); o.w = cvt_pk_bf16(v1[2], v1[3]); *(u32x4*)(P.XB() + i * 8) = o; } }
    if (gw < 512) { const int kv = gw >> 8, nn = gw & 255; const float* w1 = kv ? a.in[16] : a.in[14]; const float* cp = a.in[13]; float sacc = 0.f;
        for (int i = 0; i < 32; ++i) { const int kk = lane + 64 * i; sacc += cp[kk] * w1[(size_t)kk * 256 + nn]; }
        sacc = wave_sum(sacc); if (lane == 0) P.CB()[kv * 256 + nn] = sacc; }
    if (gw == 0) { P.CTL()[lane] = 0u; if (lane < 28) ((const float**)(P.ws + WS_PT))[lane] = a.in[lane]; }
}
__device__ __forceinline__ void ln_pass(const KP& P, const float* gam, const float* bet, bool write_x, int lane, int gw, int NGW) {
    float* ST = (float*)(P.ws + WS_ST);
    f32x4 gv[4], bv[4];
#pragma unroll
    for (int j = 0; j < 4; ++j) { gv[j] = *(const f32x4*)(gam + 4 * lane + 256 * j); bv[j] = *(const f32x4*)(bet + 4 * lane + 256 * j); }
    for (int row = gw; row < T; row += 2 * NGW) {
        const int row2 = row + NGW; const bool has2 = row2 < T;
        float* xr = P.out + (size_t)row * DM + 4 * lane; float* xr2 = P.out + (size_t)(has2 ? row2 : row) * DM + 4 * lane;
        f32x4 v[4], u[4]; float s = 0.f, t = 0.f;
#pragma unroll
        for (int j = 0; j < 4; ++j) { v[j] = *(const f32x4*)(xr + 256 * j); u[j] = *(const f32x4*)(xr2 + 256 * j); }
#pragma unroll
        for (int j = 0; j < 4; ++j) { s += (v[j][0] + v[j][1]) + (v[j][2] + v[j][3]); t += (u[j][0] + u[j][1]) + (u[j][2] + u[j][3]); }
        const float mean = wave_sum(s) * (1.f / DM), mean2 = wave_sum(t) * (1.f / DM); float s2 = 0.f, t2 = 0.f;
#pragma unroll
        for (int j = 0; j < 4; ++j) { v[j] = v[j] - mean; s2 += (v[j][0] * v[j][0] + v[j][1] * v[j][1]) + (v[j][2] * v[j][2] + v[j][3] * v[j][3]);
                                      u[j] = u[j] - mean2; t2 += (u[j][0] * u[j][0] + u[j][1] * u[j][1]) + (u[j][2] * u[j][2] + u[j][3] * u[j][3]); }
        const float rstd = 1.f / sqrtf(wave_sum(s2) * (1.f / DM) + 1e-5f), rstd2 = 1.f / sqrtf(wave_sum(t2) * (1.f / DM) + 1e-5f);
        bf16* xb = P.XB() + (size_t)row * DM + 4 * lane; bf16* xb2 = P.XB() + (size_t)row2 * DM + 4 * lane;
#pragma unroll
        for (int j = 0; j < 4; ++j) { const f32x4 y = v[j] * rstd * gv[j] + bv[j]; if (write_x) *(f32x4*)(xr + 256 * j) = y;
            u32x2 o; o.x = cvt_pk_bf16(y[0], y[1]); o.y = cvt_pk_bf16(y[2], y[3]); *(u32x2*)(xb + 256 * j) = o; }
        if (lane == 0) { ST[2 * row] = mean; ST[2 * row + 1] = rstd; if (has2) { ST[2 * row2] = mean2; ST[2 * row2 + 1] = rstd2; } }
        if (has2) {
#pragma unroll
            for (int j = 0; j < 4; ++j) { const f32x4 y = u[j] * rstd2 * gv[j] + bv[j]; if (write_x) *(f32x4*)(xr2 + 256 * j) = y;
                u32x2 o; o.x = cvt_pk_bf16(y[0], y[1]); o.y = cvt_pk_bf16(y[2], y[3]); *(u32x2*)(xb2 + 256 * j) = o; }
        }
    }
}
__device__ __forceinline__ void small_pass(const KP& P, int lane, int gw, int NGW) {
    constexpr int NR = 4;
    const int lq = lane < 48 ? lane : 47, lg = lane < 32 ? 0 : (lane < 56 ? lane - 32 : 23);
    double inv = 1.0; for (int k = 0; k < (lane & 15); ++k) inv *= 0.5623413251903491;
    for (int tok0 = gw; tok0 < T; tok0 += NR * NGW) {
        u32x4 cq[NR], ck[NR]; bf16 p1[NR], p2[NR], gl[NR]; int ps[NR];
#pragma unroll
        for (int r = 0; r < NR; ++r) { const int tok = tok0 + r * NGW < T ? tok0 + r * NGW : tok0; const bf16* he = P.HE() + (size_t)tok * HE_LD;
            cq[r] = *(const u32x4*)(he + lq * 8); ck[r] = *(const u32x4*)(he + HE_CKV + (lane & 31) * 8);
            p1[r] = he[HE_KPE + (lane & 15)]; p2[r] = he[HE_KPE + 16 + (lane & 15)]; gl[r] = he[HE_GT + lg]; ps[r] = P.pos[tok]; }
#pragma unroll
        for (int r = 0; r < NR; ++r) {
            const int tok = tok0 + r * NGW; float sq = 0.f, skv = 0.f;
#pragma unroll
            for (int e2 = 0; e2 < 4; ++e2) { const float a0 = __uint_as_float(cq[r][e2] << 16), a1 = __uint_as_float(cq[r][e2] & 0xffff0000u); sq += a0 * a0 + a1 * a1;
                                             const float b0 = __uint_as_float(ck[r][e2] << 16), b1 = __uint_as_float(ck[r][e2] & 0xffff0000u); skv += b0 * b0 + b1 * b1; }
            sq = wave_sum(lane < 48 ? sq : 0.f); skv = wave_sum(lane < 32 ? skv : 0.f);
            if (tok < T) {
                if (lane == 0) { P.RSTD()[tok] = 1.f / sqrtf(sq * (1.f / 384.f) + 1e-6f); P.RSTD()[T + tok] = 1.f / sqrtf(skv * (1.f / 256.f) + 1e-6f); }
                if (lane < 16) {
                    const double rev = (double)ps[r] * inv * 0.15915494309189535; const float fr = (float)(rev - floor(rev));
                    const float sn = __builtin_amdgcn_sinf(fr), cs = __builtin_amdgcn_cosf(fr);
                    P.RT()[(size_t)tok * 32 + 2 * lane] = cs; P.RT()[(size_t)tok * 32 + 2 * lane + 1] = sn;
                    const float x1 = bf2f(p1[r]), x2 = bf2f(p2[r]);
                    const int q1 = 8 * (lane >> 2) + (lane & 3);
                    const unsigned o1 = cvt_pk_bf16(x1 * cs - x2 * sn, 0.f), o2 = cvt_pk_bf16(x2 * cs + x1 * sn, 0.f);
                    P.KROT()[(size_t)tok * 32 + q1] = (bf16)(o1 & 0xffffu); P.KROT()[(size_t)tok * 32 + q1 + 4] = (bf16)(o2 & 0xffffu);
                }
                if (lane >= 32 && lane < 56) { const float x = bf2f(gl[r]); P.GT()[(size_t)tok * 24 + (lane - 32)] = fast_rcp(1.f + fast_exp2(-LOG2E * x)); }
            }
        }
    }
}
__device__ __forceinline__ void merge_pass(const KP& P, int lane, int gw, int NGW) {
    const size_t n = (size_t)T * 64, gt = (size_t)gw * 64 + lane, NT_ = (size_t)NGW * 64;
    for (size_t idx = gt; idx < n; idx += NT_) {
        const size_t tok = idx >> 6; const int col = (int)(idx & 63) * 8, h = col >> 7;
        const float l0 = P.LSE()[tok * 4 + h], l1 = P.LSE()[((size_t)T + tok) * 4 + h], l2 = P.LSE()[((size_t)2 * T + tok) * 4 + h];
        const float mx = fmaxf(l0, fmaxf(l1, l2)); float w0 = fast_exp2(l0 - mx), w1 = fast_exp2(l1 - mx), w2 = fast_exp2(l2 - mx);
        const float inv = 1.f / (w0 + w1 + w2); w0 *= inv; w1 *= inv; w2 *= inv;
        const u32x4 a = *(const u32x4*)(P.OG() + tok * 512 + col), b = *(const u32x4*)(P.OG() + ((size_t)T + tok) * 512 + col), c = *(const u32x4*)(P.OG() + ((size_t)2 * T + tok) * 512 + col);
        u32x4 o;
#pragma unroll
        for (int e = 0; e < 4; ++e) {
            const float lo = w0 * __uint_as_float(a[e] << 16) + w1 * __uint_as_float(b[e] << 16) + w2 * __uint_as_float(c[e] << 16);
            const float hi = w0 * __uint_as_float(a[e] & 0xffff0000u) + w1 * __uint_as_float(b[e] & 0xffff0000u) + w2 * __uint_as_float(c[e] & 0xffff0000u);
            o[e] = cvt_pk_bf16(lo, hi);
        }
        *(u32x4*)(P.OO() + tok * 512 + col) = o;
    }
}

#define ONE_LAUNCH 1
#define PROBE_F1 0
#define PROBE_O12 0
#define PROBE_EFRONT 0
#define PROBE_F2 0
#define USE_XBAR 1
#define PROBE_P0 0
#define PROBE_SYNC 0
#define PROBE_ATTE 0
#define PROBE_ATTO 0
#define PROBE_MLA_ONLY 0

enum { K_P0, K_F1, K_F2, K_LN, K_E12, K_SMALL, K_E345, K_C2, K_ATTE, K_OUTE, K_O12, K_ATTO, K_MERGE, K_OUTO };
constexpr int NPH = 25;
#define GEMM_CALL(EPI, g_, E_, off_) do { pg8::StaticOrder S_; S_.init((g_).M, (g_).N, (int)gridDim.x, (int)((blockIdx.x + (off_)) % gridDim.x)); \
    pg8::gemm_phase<EPI, pg8::StaticOrder, true, true>(lds, (g_), S_, (E_)); } while (0)

__global__ void __launch_bounds__(512, 2) mega(Args a) {
    extern __shared__ __attribute__((aligned(16))) unsigned char lds_raw[];
    LAS unsigned char* lds = (LAS unsigned char*)lds_raw;
    cg::grid_group grid = cg::this_grid();
    const int wv = __builtin_amdgcn_readfirstlane((int)threadIdx.x >> 6);
    const int G = gridDim.x, gw = blockIdx.x * 8 + wv, NGW = G * 8;
    KP P; unsigned char* ws = a.ws;
    P.out = a.out; P.ws = ws; P.pos = (const int*)a.in[1];
    LAS int* su = (LAS int*)(lds + LDS_BYTES - 64);
    volatile LAS unsigned* bst = (volatile LAS unsigned*)(lds + LDS_BYTES - 32);
    if (threadIdx.x < 2) bst[threadIdx.x] = 0u;
    __syncthreads();
    XcdBarrier bar = xcd_barrier_post((unsigned*)(a.ws + WS_CTL) + 4096, bst);

    if (a.ph_lo == 0) {
 p0_prologue(a, P, lds, threadIdx.x, gw, NGW);
#if PROBE_P0
 p0_prologue(a, P, lds, threadIdx.x, gw, NGW);
#endif
 if (a.ph_hi > 1) {
#if USE_XBAR
        if (a.ph_hi < 0) grid.sync();
        xcd_barrier(bar);
#else
        grid.sync();
#endif
    } }
#define IN(k) (((const float* const*)(P.ws + WS_PT))[k])
    for (int ph = (a.ph_lo == 0 ? 1 : a.ph_lo); ph < a.ph_hi; ++ph) {
        int tid = threadIdx.x; asm volatile("" : "+v"(tid));
        const int lane = tid & 63;
        { unsigned char* ws_i = a.ws; float* out_i = a.out; asm volatile("" : "+s"(ws_i), "+s"(out_i)); P.ws = ws_i; P.out = out_i; P.pos = (const int*)IN(1); }
        int kind, f = 0, lns = 0, layer = 0;
        switch (ph) {
            case 1: kind = K_F1; f = 0; break;  case 2: kind = K_F2; f = 0; break;  case 3: kind = K_LN; lns = 0; layer = 0; break;
            case 4: kind = K_E12; break; case 5: kind = K_SMALL; break; case 6: kind = K_E345; break; case 7: kind = K_C2; break; case 8: kind = K_ATTE; break; case 9: kind = K_OUTE; break;
            case 10: kind = K_LN; lns = 1; layer = 0; break;
            case 11: kind = K_F1; f = 1; break; case 12: kind = K_F2; f = 1; break; case 13: kind = K_LN; lns = 2; layer = 0; break;
            case 14: kind = K_F1; f = 2; break; case 15: kind = K_F2; f = 2; break; case 16: kind = K_LN; lns = 0; layer = 1; break;
            case 17: kind = K_O12; break; case 18: kind = K_ATTO; break; case 19: kind = K_MERGE; break; case 20: kind = K_OUTO; break;
            case 21: kind = K_LN; lns = 1; layer = 1; break;
            case 22: kind = K_F1; f = 3; break; case 23: kind = K_F2; f = 3; break; default: kind = K_LN; lns = 2; layer = 1; break;
        }
        if (kind == K_F1) {
            pg8::Gemm g{P.XB(), P.WB() + WE_GU + (size_t)f * 5632 * 1024, T, 5632, 1024, 1024, 1024, 128, 0}; EpiSwiglu E{P.H(), FF};
            GEMM_CALL(EpiSwiglu, g, E, 0);
#if PROBE_F1
            GEMM_CALL(EpiSwiglu, g, E, 0);
#endif
        }
        else if (kind == K_F2) {
            pg8::Gemm g{P.H(), P.WB() + WE_D + (size_t)f * 1024 * 2816, T, 1024, FF, FF, FF, 128, 0};
            if (f == 0) { EpiResidT<false> E{IN(0), P.out, P.ws, 0, 0, 0, DN_ALPHA, 0.5f}; GEMM_CALL(EpiResidT<false>, g, E, 0); }
            else {
#if PROBE_F2
                { EpiResidT<true> E{P.out, (float*)(P.ws + WS_R + 352 * MiB), P.ws, (f == 2 ? 26 : 21), (f == 2 ? 27 : 22), (f == 3 ? DM : 0), DN_ALPHA, 0.5f}; GEMM_CALL(EpiResidT<true>, g, E, 0); }
#endif
 EpiResidT<true> E{P.out, P.out, P.ws, (f == 2 ? 26 : 21), (f == 2 ? 27 : 22), (f == 3 ? DM : 0), DN_ALPHA, 0.5f}; GEMM_CALL(EpiResidT<true>, g, E, 0); }
        }
        else if (kind == K_OUTE) {
            pg8::Gemm g{P.OE(), P.WB() + WE_OE, T, 1024, 1024, 1024, 1024, 128, 0}; EpiResidT<true> E{P.out, P.out, P.ws, 2, 3, 0, DN_ALPHA, 1.f};
            GEMM_CALL(EpiResidT<true>, g, E, 0);
        }
        else if (kind == K_OUTO) {
            pg8::Gemm g{P.OO(), P.WB() + WE_OO, T, 1024, 512, 512, 512, 128, 0}; EpiResidT<true> E{P.out, P.out, P.ws, 2, 3, DM, DN_ALPHA, 1.f};
            GEMM_CALL(EpiResidT<true>, g, E, 0);
        }
        else if (kind == K_LN) {
            const float* gam = (lns == 0 ? IN(2) : (lns == 1 ? IN(21) : IN(26))) + layer * DM;
            const float* bet = (lns == 0 ? IN(3) : (lns == 1 ? IN(22) : IN(27))) + layer * DM;

#ifndef DIS_LN
 ln_pass(P, gam, bet, ph == NPH - 1, lane, gw, NGW);
#endif

        }
        else if (kind == K_SMALL) {
#ifndef DIS_SMALL
 small_pass(P, lane, gw, NGW);
#endif
 }
        else if (kind == K_MERGE) {
#ifndef DIS_MERGE
 merge_pass(P, lane, gw, NGW);
#endif
 }
        else if (kind == K_E12) {
            { pg8::Gemm g{P.XB(), P.WB() + WE_E1, T, 1792, 1024, 1024, 1024, 128, 0}; EpiStore E{P.HE(), HE_LD, nullptr, nullptr, nullptr, 0, 1792, T, 0, 0}; GEMM_CALL(EpiStore, g, E, 0); }
            { pg8::Gemm g{P.WB() + WE_E2, P.XB(), 256, T, 1024, 1024, 1024, 128, 0}; EpiStore E{P.VT(), T, nullptr, nullptr, nullptr, 0, T, 256, 0, 0}; GEMM_CALL(EpiStore, g, E, 0); }
        }
        else if (kind == K_E345) {
            for (int j = 0; j < 4; ++j) { const int kv = j >> 1, gg = j & 1;
                pg8::Gemm g{P.HE() + (kv ? HE_VC : HE_KC) + gg * 64, P.WB() + (kv ? WE_C1V : WE_C1K), 8192, 256, 2048, 16 * HE_LD, 2048, HE_LD * 2, 0};
                EpiStore E{P.HC() + (size_t)j * 8192 * 256, 256, nullptr, nullptr, P.CB() + kv * 256, 1, 256, 8192, 0, 0}; GEMM_CALL(EpiStore, g, E, 32 * j); }
            { pg8::Gemm g{P.HE() + HE_CQ, P.WB() + WE_UQ, T, 768, 384, HE_LD, 384, 128, 0}; EpiRopeQ E{P.QM(), 768, P.RSTD(), P.RT(), 0.10206207261596575f * LOG2E}; GEMM_CALL(EpiRopeQ, g, E, 128); }
            { pg8::Gemm g{P.HE() + HE_CKV, P.WB() + WE_UK, T, 512, 256, HE_LD, 256, 128, 0}; EpiStore E{P.KN(), 512, P.RSTD() + T, nullptr, nullptr, 0, 512, T, 0, 0}; GEMM_CALL(EpiStore, g, E, 128); }
            { pg8::Gemm g{P.WB() + WE_UV, P.HE() + HE_CKV, 512, T, 256, 256, HE_LD, 128, 0}; EpiStore E{P.VMT(), T, nullptr, P.RSTD() + T, nullptr, 0, T, 512, 0, 0}; GEMM_CALL(EpiStore, g, E, 128); }
        }
        else if (kind == K_C2) {
            for (int gg = 0; gg < 2; ++gg) { pg8::Gemm g{P.HC() + (size_t)gg * 8192 * 256, P.WB() + WE_C2K, 8192, 256, 256, 256, 256, 128, 0};
                EpiStore E{P.KCC() + gg * 64, 128, nullptr, nullptr, nullptr, 0, 64, 8192, 1, 0}; GEMM_CALL(EpiStore, g, E, 32 * gg); }
            for (int gg = 0; gg < 2; ++gg) { pg8::Gemm g{P.WB() + WE_C2V, P.HC() + (size_t)(2 + gg) * 8192 * 256, 256, 8192, 256, 256, 256, 128, 0};
                EpiStore E{P.VCT() + (size_t)gg * 64 * 8192, 8192, nullptr, nullptr, nullptr, 0, 8192, 64, 0, 1}; GEMM_CALL(EpiStore, g, E, 64 + 32 * gg); }
        }
        else if (kind == K_O12) {
            { pg8::Gemm g{P.XB(), P.WB() + WE_O1, T, 3072, 1024, 1024, 1024, 128, 0}; EpiStore E{P.QK(), 3072, nullptr, nullptr, nullptr, 0, 3072, T, 0, 0}; GEMM_CALL(EpiStore, g, E, 0); }
            for (int gg = 0; gg < 3; ++gg) { const int dil = gg == 0 ? 1 : (gg == 1 ? 4 : 16);
                pg8::Gemm g{P.WB() + WE_O2 + (size_t)gg * 512 * 1024, P.XB(), 512, T, 1024, 1024, dil * 1024, 128, dil};
                EpiStore E{P.VOT() + (size_t)gg * 512 * T, T, nullptr, nullptr, nullptr, 0, T, 512, 0, 0}; GEMM_CALL(EpiStore, g, E, 0); }
        }
        else if (kind == K_ATTE) {
            __syncthreads();
            const unsigned xq = bar.x & 7u;
            for (;;) {
                if (tid == 0) { int uu = -1;
                    for (unsigned k = 0; k < 8u && uu < 0; ++k) { const unsigned q = (xq + k) & 7u; const unsigned i = atomicAdd(&P.CTL()[16 + q], 1u); if (i < 512u) uu = (int)(q * 512u + i); }
                    *su = uu; }
                __syncthreads(); const int u = *su; __syncthreads();
                if (u < 0) break;
                const int q = u >> 9, i = u & 511;
                if (i < 256) { const int qb = 31 - (i >> 3), bh = q * 8 + (i & 7);
#ifndef DIS_MLA
 mla_unit(P, lds, bh >> 3, bh & 7, qb, tid);
#endif
 }
                else { const int j = i - 256, c = 127 - (j >> 1), bg = q * 2 + (j & 1);
#ifndef DIS_NSA
 nsa_unit(P, lds, bg >> 1, c, bg & 1, tid);
#endif
 }
            }
        }
        else if (kind == K_ATTO) {
            __syncthreads();
            const unsigned xq = bar.x & 7u;
            for (;;) {
                if (tid == 0) { int uu = -1;
                    for (unsigned k = 0; k < 8u && uu < 0; ++k) { const unsigned q = (xq + k) & 7u; const unsigned i = atomicAdd(&P.CTL()[32 + q], 1u); if (i < 384u) uu = (int)(q * 384u + i); }
                    *su = uu; }
                __syncthreads(); const int u = *su; __syncthreads();
                if (u < 0) break;
                const int rj = u & 31, rest = u >> 5, h = rest & 3, g = (rest >> 2) % 3, b = rest / 12;
#ifndef DIS_DIL
 dil_unit(P, lds, b, g, h, rj, tid);
#endif
            }
        }
        if (ph + 1 < a.ph_hi) {
#if USE_XBAR
            xcd_barrier(bar);
#else
            grid.sync();
#endif
        }
#if PROBE_SYNC
        if (ph + 1 < a.ph_hi) { grid.sync(); grid.sync(); }
#endif
    }
}

#ifndef ONE_LAUNCH_X
#define ONE_LAUNCH 1
#endif
extern "C" void kernel_launch(void* const* d_in, const int* in_sizes, int n_in, void* d_out, int out_size, void* d_ws, size_t ws_size, hipStream_t stream) {
    static int grid = 0;
    if (grid == 0) {
        if (n_in != 28 || ws_size < WS_NEED) { fprintf(stderr, "kernel_launch: unexpected n_in %d / ws %zu\n", n_in, ws_size); grid = -1; return; }
        int dev = 0, cus = 0, per_cu = 0;
        hipGetDevice(&dev); hipDeviceGetAttribute(&cus, hipDeviceAttributeMultiprocessorCount, dev);
        if (hipFuncSetAttribute((const void*)mega, hipFuncAttributeMaxDynamicSharedMemorySize, LDS_BYTES) != hipSuccess) { fprintf(stderr, "hipFuncSetAttribute failed\n"); grid = -1; return; }
        hipOccupancyMaxActiveBlocksPerMultiprocessor(&per_cu, (const void*)mega, 512, LDS_BYTES);
        if (per_cu < 1) per_cu = 1;
        grid = cus * 1;
        (void)hipGetLastError();
    }
    if (grid < 0) return;
    if (hipMemsetAsync((char*)d_ws + WS_CTL, 0, 65536, stream) != hipSuccess) { fprintf(stderr, "memset failed\n"); return; }
    Args a{};
    for (int i = 0; i < 28; ++i) a.in[i] = (const float*)d_in[i];
    a.out = (float*)d_out; a.ws = (unsigned char*)d_ws;
#if ONE_LAUNCH
    a.ph_lo = 0; a.ph_hi = NPH;
    void* args[] = {&a};
    hipError_t e = hipLaunchCooperativeKernel((const void*)mega, dim3(grid), dim3(512), args, LDS_BYTES, stream);
    if (e != hipSuccess) fprintf(stderr, "cooperative launch failed: %s (grid %d)\n", hipGetErrorString(e), grid);
#else
    for (int ph = 0; ph < NPH; ++ph) { a.ph_lo = ph; a.ph_hi = ph + 1; hipLaunchKernelGGL(mega, dim3(grid), dim3(512), LDS_BYTES, stream, a); }
#endif
}
```

```cpp
#include <hip/hip_runtime.h>
#include <hip/hip_cooperative_groups.h>
#include <cstdio>
#include <cstdint>
namespace cg = cooperative_groups;
namespace pg8 {
#define PG8_LAS __attribute__((address_space(3)))
typedef unsigned short bf16_t;
typedef short bf16x8 __attribute__((ext_vector_type(8)));
typedef float f32x4 __attribute__((ext_vector_type(4)));
typedef unsigned u32x4 __attribute__((ext_vector_type(4)));
constexpr int BM = 256, BK = 64, HALF = 128, HTB = HALF * BK * 2  , STAGE_BYTES = 8 * HTB, NXCD = 8, WGM = 8;

__host__ __device__ __forceinline__ int lds_byte(int r, int c) { const int st = (r >> 4) * 2 + (c >> 5), rr = r & 15, cc = c & 31, ob = rr * 64 + cc * 2; return st * 1024 + (ob ^ (((ob >> 9) & 1) << 5)); }
__host__ __device__ __forceinline__ void stage_rc(int b, int& R, int& C) { const int st = b / 1024, sb = b % 1024, swz = sb ^ (((sb >> 9) & 1) << 5); R = (st >> 1) * 16 + swz / 64; C = (st & 1) * 32 + (swz % 64) / 2; }
__host__ __device__ __forceinline__ int perm32(int rho) { const int n = rho >> 4, i = rho & 15; return 8 * (i >> 2) + 4 * n + (i & 3); }

struct Unit { int pm, pn; };
struct Gemm { const bf16_t* A; const bf16_t* Bt; int M, N, K; int lda, ldb, kstepA, bdil;
    __device__ __forceinline__ size_t aoff(int pm) const { return (size_t)pm * 256 * lda * 2; }
    __device__ __forceinline__ size_t boff(int pn) const {
        if (bdil == 0) return (size_t)pn * 256 * ldb * 2;
        const int per = 32 / bdil, b = pn >> 5, rem = pn & 31, r = rem / per, jt = rem % per;
        return ((size_t)b * 8192 + r + (size_t)bdil * 256 * jt) * 1024 * 2; } };

struct StaticOrder {
    int nM, nN, nwg, G, c;
    __host__ __device__ void init(int M, int N, int G_, int c_) { nM = M / BM; nN = N / BM; nwg = nM * nN; G = G_; c = c_; }
    __host__ __device__ bool next(int i, Unit& u) const {
        const long L = (long)i * G + c; if (L >= nwg) return false;
        int wgid = (int)L; { const int q = nwg / NXCD, r = nwg % NXCD, xcd = wgid % NXCD, off = wgid / NXCD; wgid = (xcd < r ? xcd * (q + 1) : r * (q + 1) + (xcd - r) * q) + off; }
        const int nig = WGM * nN, gid = wgid / nig, fm = gid * WGM, gsz = (nM - fm) < WGM ? (nM - fm) : WGM;
        u.pm = fm + ((wgid % nig) % gsz); u.pn = (wgid % nig) / gsz; return true;
    }
    __device__ __forceinline__ void a_ready(const Unit&) const {}
    __device__ __forceinline__ void done(const Unit&) const {}
};

__device__ __forceinline__ unsigned cvt_pk_bf16(float lo, float hi) { unsigned r; asm volatile("v_cvt_pk_bf16_f32 %0, %1, %2" : "=v"(r) : "v"(lo), "v"(hi)); return r; }
typedef float f32x2 __attribute__((ext_vector_type(2)));
template <class Epi, class Sched, bool ALIGN_EPI = false, bool SP2 = false>
__device__ __forceinline__ void gemm_phase(PG8_LAS unsigned char* lds, const Gemm g, const Sched& S, const Epi& E) {
    int tid_o = threadIdx.x; asm volatile("" : "+v"(tid_o)); const int tid = tid_o, wid = __builtin_amdgcn_readfirstlane(tid >> 6), lane = tid & 63, wr = wid >> 2, wc = wid & 3, fr = lane & 15, fq = lane >> 4;
    const int K = g.K, nt = K / BK;
    unsigned voffA[2], voffB[2];
#pragma unroll
    for (int i = 0; i < 2; ++i) { int R, C; stage_rc(tid * 16 + i * 8192, R, C); const int Rb = Epi::PERM ? ((R & ~31) + perm32(R & 31)) : R;
        voffA[i] = (unsigned)(R * g.lda + C) * 2u; voffB[i] = (unsigned)(Rb * g.ldb + C) * 2u; }
    const size_t kstepB = (size_t)(BK * 2), kstepA = (size_t)g.kstepA;
    const size_t hstepA = (size_t)HALF * g.lda * 2, hstepB = (size_t)HALF * g.ldb * 2;
    const unsigned ldsw = (unsigned)wid * 1024u;
    const int aoff = lds_byte(wr * 64 + fr, fq * 8), boff = lds_byte(wc * 32 + fr, fq * 8);
#define PG8_SA(b, h) (((b) * 2 + (h)) * HTB)
#define PG8_SB(b, h) ((4 + (b) * 2 + (h)) * HTB)
#define PG8_STAGE(bufoff, gbase, voff) do { _Pragma("unroll") for (int _i = 0; _i < 2; ++_i) \
        __builtin_amdgcn_global_load_lds((const unsigned*)((const char*)(gbase) + (voff)[_i]), (PG8_LAS unsigned*)(lds + (bufoff) + ldsw + _i * 8192), 16, 0, 0); } while (0)
#define PG8_LDA(dst, b, h) do { _Pragma("unroll") for (int m = 0; m < 4; ++m) _Pragma("unroll") for (int k = 0; k < 2; ++k) dst[m][k] = *(const PG8_LAS bf16x8*)(lds + PG8_SA(b, h) + aoff + m * 2048 + k * 1024); } while (0)
#define PG8_LDB(dst, b, h) do { _Pragma("unroll") for (int n = 0; n < 2; ++n) _Pragma("unroll") for (int k = 0; k < 2; ++k) dst[n][k] = *(const PG8_LAS bf16x8*)(lds + PG8_SB(b, h) + boff + n * 2048 + k * 1024); } while (0)
#define PG8_MMA(ai, bj, At, Bt) do { __builtin_amdgcn_s_setprio(1); _Pragma("unroll") for (int m = 0; m < 4; ++m) _Pragma("unroll") for (int n = 0; n < 2; ++n) _Pragma("unroll") for (int k = 0; k < 2; ++k) \
        acc[ai][bj][m][n] = __builtin_amdgcn_mfma_f32_16x16x32_bf16(Bt[n][k], At[m][k], acc[ai][bj][m][n], 0, 0, 0); __builtin_amdgcn_s_setprio(0); } while (0)
#define PG8_WAIT_V(n) asm volatile("s_waitcnt vmcnt(" #n ")" ::: "memory")
#define PG8_WAIT_L(n) asm volatile("s_waitcnt lgkmcnt(" #n ")" ::: "memory")
#define PG8_BAR __builtin_amdgcn_s_barrier()
#define PG8_SCHED __builtin_amdgcn_sched_barrier(0)
    Unit cur, nxt; int ui = 0;
    if (!S.next(0, cur)) return;
    f32x4 acc[2][2][4][2];
#pragma unroll
    for (int a = 0; a < 2; ++a)
#pragma unroll
        for (int b = 0; b < 2; ++b)
#pragma unroll
            for (int m = 0; m < 4; ++m)
#pragma unroll
                for (int n = 0; n < 2; ++n) acc[a][b][m][n] = (f32x4){0.f, 0.f, 0.f, 0.f};
    bf16x8 At[4][2], B0[2][2], B1[2][2];
    const char* cA = (const char*)g.A + g.aoff(cur.pm); const char* cB = (const char*)g.Bt + g.boff(cur.pn);
    S.a_ready(cur);
    if constexpr (SP2) {
        PG8_STAGE(PG8_SB(0, 0), cB, voffB); PG8_STAGE(PG8_SB(0, 1), cB + hstepB, voffB); PG8_STAGE(PG8_SA(0, 0), cA, voffA); PG8_STAGE(PG8_SA(0, 1), cA + hstepA, voffA);
        if (wr == 1) PG8_BAR;
        PG8_WAIT_V(2); PG8_BAR;
        PG8_STAGE(PG8_SB(1, 0), cB + kstepB, voffB); PG8_STAGE(PG8_SA(1, 0), cA + kstepA, voffA); PG8_STAGE(PG8_SB(1, 1), cB + hstepB + kstepB, voffB);
        PG8_WAIT_V(6); PG8_BAR;
    } else {
        PG8_STAGE(PG8_SB(0, 0), cB, voffB); PG8_STAGE(PG8_SA(0, 0), cA, voffA); PG8_STAGE(PG8_SB(0, 1), cB + hstepB, voffB); PG8_STAGE(PG8_SA(0, 1), cA + hstepA, voffA);
        if (wr == 1) PG8_BAR;
        PG8_WAIT_V(4); PG8_BAR;
        PG8_STAGE(PG8_SB(1, 0), cB + kstepB, voffB); PG8_STAGE(PG8_SA(1, 0), cA + kstepA, voffA); PG8_STAGE(PG8_SB(1, 1), cB + hstepB + kstepB, voffB);
        PG8_WAIT_V(6); PG8_BAR;
    }
    for (;;) {
        const bool has_next = S.next(ui + 1, nxt);
        const char* nA = has_next ? (const char*)g.A + g.aoff(nxt.pm) : cA; const char* nB = has_next ? (const char*)g.Bt + g.boff(nxt.pn) : cB;
        _Pragma("clang loop unroll(disable)") for (int t = 0; t < nt; t += 2) {
            const bool last = (t == nt - 2);
            const char* a1 = cA + (size_t)(t + 1) * kstepA;
            const char* a2 = last ? nA : cA + (size_t)(t + 2) * kstepA; const char* b2 = last ? nB : cB + (size_t)(t + 2) * kstepB;
            const char* a3 = a2 + kstepA; const char* b3 = b2 + kstepB;
            if (last && has_next) S.a_ready(nxt);
            if constexpr (SP2) {
            PG8_LDB(B0, 0, 0); PG8_LDB(B1, 0, 1); PG8_SCHED; PG8_LDA(At, 0, 0); PG8_STAGE(PG8_SA(1, 1), a1 + hstepA, voffA);
            PG8_WAIT_V(8); PG8_WAIT_L(0); PG8_BAR; PG8_MMA(0, 0, At, B0); PG8_MMA(0, 1, At, B1); PG8_BAR; PG8_SCHED;
            PG8_LDA(At, 0, 1); PG8_STAGE(PG8_SB(0, 0), b2, voffB); PG8_STAGE(PG8_SB(0, 1), b2 + hstepB, voffB); PG8_STAGE(PG8_SA(0, 0), a2, voffA);
            PG8_WAIT_V(8); PG8_WAIT_L(0); PG8_BAR; PG8_MMA(1, 0, At, B0); PG8_MMA(1, 1, At, B1); PG8_BAR; PG8_SCHED;
            PG8_LDB(B0, 1, 0); PG8_LDB(B1, 1, 1); PG8_SCHED; PG8_LDA(At, 1, 0); PG8_STAGE(PG8_SA(0, 1), a2 + hstepA, voffA);
            PG8_WAIT_V(8); PG8_WAIT_L(0); PG8_BAR; PG8_MMA(0, 0, At, B0); PG8_MMA(0, 1, At, B1); PG8_BAR; PG8_SCHED;
            PG8_LDA(At, 1, 1); PG8_STAGE(PG8_SB(1, 0), b3, voffB); PG8_STAGE(PG8_SB(1, 1), b3 + hstepB, voffB); PG8_STAGE(PG8_SA(1, 0), a3, voffA);
            PG8_WAIT_V(8); PG8_WAIT_L(0); PG8_BAR; PG8_MMA(1, 0, At, B0); PG8_MMA(1, 1, At, B1); PG8_BAR; PG8_SCHED;
            } else {
            PG8_LDB(B0, 0, 0); PG8_SCHED; PG8_LDA(At, 0, 0); PG8_STAGE(PG8_SA(1, 1), a1 + hstepA, voffA);
            PG8_WAIT_L(8); PG8_BAR; PG8_WAIT_L(0); PG8_MMA(0, 0, At, B0); PG8_BAR; PG8_SCHED;
            PG8_LDB(B1, 0, 1); PG8_STAGE(PG8_SB(0, 0), b2, voffB);
            PG8_BAR; PG8_WAIT_L(0); PG8_MMA(0, 1, At, B1); PG8_BAR;
            PG8_LDA(At, 0, 1); PG8_STAGE(PG8_SA(0, 0), a2, voffA);
            PG8_BAR; PG8_WAIT_L(0); PG8_MMA(1, 0, At, B0); PG8_BAR; PG8_SCHED;
            PG8_STAGE(PG8_SB(0, 1), b2 + hstepB, voffB);
            PG8_WAIT_V(6); PG8_BAR; PG8_MMA(1, 1, At, B1); PG8_BAR;
            PG8_LDB(B0, 1, 0); PG8_SCHED; PG8_LDA(At, 1, 0); PG8_STAGE(PG8_SA(0, 1), a2 + hstepA, voffA);
            PG8_WAIT_L(8); PG8_BAR; PG8_WAIT_L(0); PG8_MMA(0, 0, At, B0); PG8_BAR; PG8_SCHED;
            PG8_LDB(B1, 1, 1); PG8_STAGE(PG8_SB(1, 0), b3, voffB);
            PG8_BAR; PG8_WAIT_L(0); PG8_MMA(0, 1, At, B1); PG8_BAR;
            PG8_LDA(At, 1, 1); PG8_STAGE(PG8_SA(1, 0), a3, voffA);
            PG8_BAR; PG8_WAIT_L(0); PG8_MMA(1, 0, At, B0); PG8_BAR; PG8_SCHED;
            PG8_STAGE(PG8_SB(1, 1), b3 + hstepB, voffB);
            PG8_WAIT_V(6); PG8_BAR; PG8_MMA(1, 1, At, B1); PG8_BAR;
            }
        }
        if constexpr (ALIGN_EPI) { if (wr == 0) PG8_BAR; }
        if constexpr (!Epi::AFTER_DRAIN) { E(acc, cur, wr, wc, fr, fq); S.done(cur); }
        if (!has_next) break;
#pragma unroll
        for (int a = 0; a < 2; ++a)
#pragma unroll
            for (int b = 0; b < 2; ++b)
#pragma unroll
                for (int m = 0; m < 4; ++m)
#pragma unroll
                    for (int n = 0; n < 2; ++n) acc[a][b][m][n] = (f32x4){0.f, 0.f, 0.f, 0.f};
        cur = nxt; cA = nA; cB = nB; ++ui;
        if constexpr (ALIGN_EPI) { if (wr == 1) PG8_BAR; }
    }
    PG8_WAIT_V(0);
    if constexpr (!ALIGN_EPI) { if (wr == 0) PG8_BAR; }
    PG8_BAR;
    if constexpr (Epi::AFTER_DRAIN) { E.fused(acc, cur, wr, wc, fr, fq, lds, wid, lane); S.done(cur); }
#undef PG8_SA
#undef PG8_SB
#undef PG8_STAGE
#undef PG8_LDA
#undef PG8_LDB
#undef PG8_MMA
#undef PG8_WAIT_V
#undef PG8_WAIT_L
#undef PG8_BAR
#undef PG8_SCHED
}
}
#define LAS __attribute__((address_space(3)))
typedef unsigned short bf16;
using pg8::f32x4; using pg8::bf16x8; using pg8::u32x4; using pg8::Unit; using pg8::cvt_pk_bf16;
typedef float f32x16 __attribute__((ext_vector_type(16)));
typedef unsigned u32x2 __attribute__((ext_vector_type(2)));
typedef short s16x4 __attribute__((ext_vector_type(4)));

constexpr int NB = 8, SEQ = 8192, T = NB * SEQ, DM = 1024, FF = 2816;
constexpr int HE_LD = 1792;
constexpr int HE_CQ = 0, HE_CKV = 384, HE_KPE = 640, HE_Q = 672, HE_KC = 1184, HE_VC = 1312, HE_KS = 1440, HE_KW = 1568, HE_GT = 1696;
constexpr float LOG2E = 1.4426950408889634f;
constexpr float DN_ALPHA = 1.4142135623730951f;
constexpr float NEGB = -1e30f;

constexpr size_t MiB = 1u << 20;
constexpr size_t WS_CTL = 0;
constexpr size_t WS_W = 1 * MiB;
constexpr size_t WS_PT = 256 * 1024;
constexpr size_t WS_ST = 512 * 1024;
constexpr size_t WE_GU = 0;
constexpr size_t WE_D = WE_GU + 4ull * 5632 * 1024;
constexpr size_t WE_E1 = WE_D + 4ull * 1024 * 2816;
constexpr size_t WE_E2 = WE_E1 + 1792ull * 1024;
constexpr size_t WE_UQ = WE_E2 + 256ull * 1024;
constexpr size_t WE_UK = WE_UQ + 768ull * 384;
constexpr size_t WE_UV = WE_UK + 512ull * 256;
constexpr size_t WE_C1K = WE_UV + 512ull * 256;
constexpr size_t WE_C1V = WE_C1K + 256ull * 2048;
constexpr size_t WE_C2K = WE_C1V + 256ull * 2048;
constexpr size_t WE_C2V = WE_C2K + 256ull * 256;
constexpr size_t WE_OE = WE_C2V + 256ull * 256;
constexpr size_t WE_O1 = WE_OE + 1024ull * 1024;
constexpr size_t WE_O2 = WE_O1 + 3072ull * 1024;
constexpr size_t WE_OO = WE_O2 + 1536ull * 1024;
constexpr size_t WE_END = WE_OO + 1024ull * 512;
static_assert(WE_END * 2 <= 95 * MiB, "weights fit");
constexpr size_t WS_CB = 96 * MiB;
constexpr size_t WS_XB = 97 * MiB;
constexpr size_t WS_R = 225 * MiB;
constexpr size_t R_H = WS_R;
constexpr size_t R_HE = WS_R;
constexpr size_t R_VT = WS_R + 224 * MiB;
constexpr size_t R_QM = WS_R + 256 * MiB;
constexpr size_t R_KN = WS_R + 352 * MiB;
constexpr size_t R_VMT = WS_R + 416 * MiB;
constexpr size_t R_OE = WS_R + 480 * MiB;
constexpr size_t R_KROT = WS_R + 608 * MiB;
constexpr size_t R_RT = WS_R + 612 * MiB;
constexpr size_t R_GT = WS_R + 620 * MiB;
constexpr size_t R_RSTD = WS_R + 628 * MiB;
constexpr size_t R_HC = WS_R + 629 * MiB;
constexpr size_t R_KCC = WS_R + 645 * MiB;
constexpr size_t R_VCT = WS_R + 647 * MiB;
constexpr size_t R_QK = WS_R;
constexpr size_t R_VOT = WS_R + 384 * MiB;
constexpr size_t R_OG = WS_R + 576 * MiB;
constexpr size_t R_LSE = WS_R + 768 * MiB;
constexpr size_t R_OO = WS_R;
constexpr size_t WS_NEED = WS_R + 772 * MiB;
static_assert(WS_NEED <= 1024 * MiB, "ws");

constexpr int LDS_BYTES = 147456;

__device__ __forceinline__ float fast_exp2(float x) { return __builtin_amdgcn_exp2f(x); }
__device__ __forceinline__ float fast_rcp(float x) { return __builtin_amdgcn_rcpf(x); }
__device__ __forceinline__ float bf2f(bf16 v) { return __uint_as_float(((unsigned)v) << 16); }
__device__ __forceinline__ float wave_sum(float v) {
#pragma unroll
    for (int o = 1; o < 64; o <<= 1) v += __shfl_xor(v, o);
    return v;
}

struct EpiStore {
    static constexpr bool PERM = true, AFTER_DRAIN = false;
    bf16* O; int ldc; const float* rscale; const float* cscale; const float* bias; int act; int ncv; int nrv; int zrow; int zcol;
    __device__ __forceinline__ void operator()(const f32x4 (&acc)[2][2][4][2], const Unit& u, int wr, int wc, int fr, int fq) const {
#pragma unroll
        for (int bj = 0; bj < 2; ++bj) {
            const int col = u.pn * 256 + bj * 128 + wc * 32 + 8 * fq;
            if (col < ncv) {
                float cs[8], bs[8];
#pragma unroll
                for (int e = 0; e < 8; ++e) { cs[e] = cscale ? cscale[col + e] : 1.f; bs[e] = bias ? bias[col + e] : 0.f; }
#pragma unroll
                for (int ai = 0; ai < 2; ++ai)
#pragma unroll
                    for (int m = 0; m < 4; ++m) {
                        const int row = u.pm * 256 + ai * 128 + wr * 64 + m * 16 + fr;
                        if (row < nrv) {
                            const float rs = rscale ? rscale[row] : 1.f;
                            const f32x4 v0 = acc[ai][bj][m][0], v1 = acc[ai][bj][m][1];
                            float v[8] = {v0[0], v0[1], v0[2], v0[3], v1[0], v1[1], v1[2], v1[3]};
                            const bool zr = zrow && ((row & 511) == 511);
#pragma unroll
                            for (int e = 0; e < 8; ++e) {
                                float x = v[e] + bs[e];
                                if (act == 1) { const float y = 0.7978845608028654f * (x + 0.044715f * x * x * x); x = x * fast_rcp(1.f + fast_exp2(-2.f * LOG2E * y)); }
                                x *= rs * cs[e];
                                if (zr || (zcol && (((col + e) & 511) == 511))) x = 0.f;
                                v[e] = x;
                            }
                            u32x4 w; w.x = cvt_pk_bf16(v[0], v[1]); w.y = cvt_pk_bf16(v[2], v[3]); w.z = cvt_pk_bf16(v[4], v[5]); w.w = cvt_pk_bf16(v[6], v[7]);
                            *(u32x4*)(O + (size_t)row * ldc + col) = w;
                        }
                    }
            }
        }
    }
};
struct EpiSwiglu {
    static constexpr bool PERM = true, AFTER_DRAIN = false;
    bf16* H; int ldh;
    __device__ __forceinline__ void operator()(const f32x4 (&acc)[2][2][4][2], const Unit& u, int wr, int wc, int fr, int fq) const {
        const int col = u.pn * 128 + wc * 32 + 8 * fq;
#pragma unroll
        for (int ai = 0; ai < 2; ++ai)
#pragma unroll
            for (int m = 0; m < 4; ++m) {
                const int row = u.pm * 256 + ai * 128 + wr * 64 + m * 16 + fr;
                const f32x4 g0 = acc[ai][0][m][0], g1 = acc[ai][0][m][1], u0 = acc[ai][1][m][0], u1 = acc[ai][1][m][1];
                float g[8] = {g0[0], g0[1], g0[2], g0[3], g1[0], g1[1], g1[2], g1[3]};
                float uu[8] = {u0[0], u0[1], u0[2], u0[3], u1[0], u1[1], u1[2], u1[3]};
#pragma unroll
                for (int e = 0; e < 8; ++e) g[e] = g[e] * fast_rcp(1.f + fast_exp2(-LOG2E * g[e])) * uu[e];
                u32x4 w; w.x = cvt_pk_bf16(g[0], g[1]); w.y = cvt_pk_bf16(g[2], g[3]); w.z = cvt_pk_bf16(g[4], g[5]); w.w = cvt_pk_bf16(g[6], g[7]);
                *(u32x4*)(H + (size_t)row * ldh + col) = w;
            }
    }
};
template <bool LN>
struct EpiResidT {
    static constexpr bool PERM = true, AFTER_DRAIN = false;
    const float* Xin; float* Xout; unsigned char* ws; int gi, bi, goff; float alpha, beta;
    __device__ __forceinline__ void operator()(const f32x4 (&acc)[2][2][4][2], const Unit& u, int wr, int wc, int fr, int fq) const {
        constexpr int ldx = 1024;
        const float* st = (const float*)(ws + WS_ST); const float* gam = nullptr; const float* bet = nullptr;
        if (LN) { const float* const* PT = (const float* const*)(ws + WS_PT); gam = PT[gi] + goff; bet = PT[bi] + goff; }
#pragma unroll
        for (int bj = 0; bj < 2; ++bj) {
            const int col = u.pn * 256 + bj * 128 + wc * 32 + 8 * fq;
            f32x4 g0, g1, b0, b1;
            if (LN) { g0 = *(const f32x4*)(gam + col); g1 = *(const f32x4*)(gam + col + 4); b0 = *(const f32x4*)(bet + col); b1 = *(const f32x4*)(bet + col + 4); }
#pragma unroll
            for (int ai = 0; ai < 2; ++ai) {
                f32x4 x0[4], x1[4]; float mean[4], rstd[4];
#pragma unroll
                for (int m = 0; m < 4; ++m) {
                    const int row = u.pm * 256 + ai * 128 + wr * 64 + m * 16 + fr;
                    const size_t off = (size_t)row * ldx + col;
                    x0[m] = *(const f32x4*)(Xin + off); x1[m] = *(const f32x4*)(Xin + off + 4);
                    if (LN) { mean[m] = st[2 * row]; rstd[m] = st[2 * row + 1]; }
                }
#pragma unroll
                for (int m = 0; m < 4; ++m) {
                    const int row = u.pm * 256 + ai * 128 + wr * 64 + m * 16 + fr;
                    const size_t off = (size_t)row * ldx + col;
                    f32x4 a0 = x0[m], a1 = x1[m];
                    if (LN) { a0 = (a0 - mean[m]) * rstd[m] * g0 + b0; a1 = (a1 - mean[m]) * rstd[m] * g1 + b1; }
                    *(f32x4*)(Xout + off) = a0 * alpha + acc[ai][bj][m][0] * beta;
                    *(f32x4*)(Xout + off + 4) = a1 * alpha + acc[ai][bj][m][1] * beta;
                }
            }
        }
    }
};
struct EpiRopeQ {
    static constexpr bool PERM = true, AFTER_DRAIN = false;
    bf16* Q; int ldq; const float* rstd; const float* RT; float qscale;
    __device__ __forceinline__ void operator()(const f32x4 (&acc)[2][2][4][2], const Unit& u, int wr, int wc, int fr, int fq) const {
#pragma unroll
        for (int bj = 0; bj < 2; ++bj) {
            const int grp = u.pn * 8 + bj * 4 + wc; const bool is_rope = (grp % 3) == 2;
            const int col = u.pn * 256 + bj * 128 + wc * 32 + 8 * fq;
#pragma unroll
            for (int ai = 0; ai < 2; ++ai)
#pragma unroll
                for (int m = 0; m < 4; ++m) {
                    const int row = u.pm * 256 + ai * 128 + wr * 64 + m * 16 + fr;
                    const float rs = rstd[row] * qscale;
                    f32x4 v0 = acc[ai][bj][m][0] * rs, v1 = acc[ai][bj][m][1] * rs;
                    if (is_rope) {
                        const f32x4 c01 = *(const f32x4*)(RT + (size_t)row * 32 + 8 * fq), c23 = *(const f32x4*)(RT + (size_t)row * 32 + 8 * fq + 4);
                        const float cs[4] = {c01[0], c01[2], c23[0], c23[2]}, sn[4] = {c01[1], c01[3], c23[1], c23[3]};
                        f32x4 o1, o2;
#pragma unroll
                        for (int e = 0; e < 4; ++e) { o1[e] = v0[e] * cs[e] - v1[e] * sn[e]; o2[e] = v1[e] * cs[e] + v0[e] * sn[e]; }
                        v0 = o1; v1 = o2;
                    }
                    u32x4 w; w.x = cvt_pk_bf16(v0[0], v0[1]); w.y = cvt_pk_bf16(v0[2], v0[3]); w.z = cvt_pk_bf16(v1[0], v1[1]); w.w = cvt_pk_bf16(v1[2], v1[3]);
                    *(u32x4*)(Q + (size_t)row * ldq + col) = w;
                }
        }
    }
};
#define XB_TMO      128
#define XB_XCNT(j)  (256  + 64 * (j))
#define XB_XSUB(j)  (1280 + 64 * (j))
#define XB_XGEN(j)  (2304 + 64 * (j))
#define XB_TOP      3328
#define XB_TOPGEN   3392
#define XCD_BAR_WORDS 3456
#define XB_SPIN_CAP (1u << 18)

__device__ __forceinline__ unsigned xb_ld(unsigned* p)              { return __hip_atomic_load(p, __ATOMIC_RELAXED, __HIP_MEMORY_SCOPE_AGENT); }
__device__ __forceinline__ unsigned xb_add(unsigned* p, unsigned v) { return __hip_atomic_fetch_add(p, v, __ATOMIC_RELAXED, __HIP_MEMORY_SCOPE_AGENT); }
__device__ __forceinline__ unsigned xb_xcc_id() { return (unsigned)__builtin_amdgcn_s_getreg((3 << 11) | 20) & 0xFu; }
#define XB_SPIN(cond, bar) do { unsigned _sp = 0; while (cond) { __builtin_amdgcn_s_sleep(1); \
    if ((++_sp & 255u) == 0u) { if (xb_ld(&(bar)[XB_TMO])) break; if (_sp > XB_SPIN_CAP) { atomicAdd(&(bar)[XB_TMO], 1u); break; } } } } while (0)

struct XcdBarrier {
    unsigned* bar; unsigned x;
    volatile LAS unsigned* st;
};

__device__ __forceinline__ XcdBarrier xcd_barrier_post(unsigned* bar, volatile LAS unsigned* st) {
    XcdBarrier b; b.bar = bar; b.x = xb_xcc_id(); b.st = st;
    if (threadIdx.x == 0) (void)xb_add(&bar[XB_XCNT(b.x)], 1u);
    return b;
}
__device__ __forceinline__ void xcd_barrier_complete(unsigned* bar, unsigned x, unsigned& nloc, unsigned& nx) {
    const unsigned G = gridDim.x * gridDim.y * gridDim.z;
    unsigned sum, cnt, mine, sp = 0u;
    for (;;) {
        sum = 0u; cnt = 0u; mine = 0u;
#pragma unroll
        for (unsigned j = 0; j < 16; ++j) { const unsigned c = xb_ld(&bar[XB_XCNT(j)]); sum += c; cnt += (c > 0u) ? 1u : 0u; mine = (j == x) ? c : mine; }
        if (sum == G) break;
        __builtin_amdgcn_s_sleep(1);
        if ((++sp & 255u) == 0u) { if (xb_ld(&bar[XB_TMO])) break; if (sp > XB_SPIN_CAP) { atomicAdd(&bar[XB_TMO], 1u); break; } }
    }
    nloc = mine > 0u ? mine : 1u; nx = cnt > 0u ? cnt : 1u;
}

__device__ __forceinline__ void xcd_barrier(const XcdBarrier& b) {
    asm volatile("s_waitcnt vmcnt(0)" ::: "memory");
    __syncthreads();
    if (threadIdx.x == 0) {
        unsigned* bar = b.bar;
        __builtin_amdgcn_s_waitcnt(0);
        unsigned nloc = b.st[0], nx = b.st[1];
        if (nloc == 0u) { xcd_barrier_complete(bar, b.x, nloc, nx); b.st[0] = nloc; b.st[1] = nx; }
        const unsigned old = xb_add(&bar[XB_XSUB(b.x)], 1u);
        const unsigned gen = old / nloc;
        if (old + 1u == (gen + 1u) * nloc) {
            __builtin_amdgcn_fence(__ATOMIC_RELEASE, "agent");
            asm volatile("s_waitcnt vmcnt(0)" ::: "memory");
            const unsigned og = xb_add(&bar[XB_TOP], 1u);
            const unsigned tg = og / nx;
            if (og + 1u == (tg + 1u) * nx) xb_add(&bar[XB_TOPGEN], 1u);
            else XB_SPIN(xb_ld(&bar[XB_TOPGEN]) == tg, bar);
            __builtin_amdgcn_fence(__ATOMIC_ACQUIRE, "agent");
            xb_add(&bar[XB_XGEN(b.x)], 1u);
            asm volatile("s_waitcnt vmcnt(0)" ::: "memory");
        } else {
            XB_SPIN(xb_ld(&bar[XB_XGEN(b.x)]) == gen, bar);
            __builtin_amdgcn_fence(__ATOMIC_ACQUIRE, "agent");
            asm volatile("s_waitcnt vmcnt(0)" ::: "memory");
        }
    }
    __syncthreads();
}
struct KP {
    float* out; unsigned char* ws; const int* pos;
    __device__ __forceinline__ const int* pos_local() const { int one = 1; asm volatile("" : "+s"(one)); return (const int*)(((const float* const*)(ws + WS_PT))[one]); }
#define KP_ACC(T_, NAME, OFF) __device__ __forceinline__ T_* NAME() const { return (T_*)(ws + (OFF)); }
    KP_ACC(bf16, WB, WS_W) KP_ACC(bf16, XB, WS_XB) KP_ACC(bf16, H, R_H) KP_ACC(bf16, HE, R_HE) KP_ACC(bf16, VT, R_VT) KP_ACC(bf16, QM, R_QM)
    KP_ACC(bf16, KN, R_KN) KP_ACC(bf16, VMT, R_VMT) KP_ACC(bf16, OE, R_OE) KP_ACC(bf16, KROT, R_KROT) KP_ACC(bf16, HC, R_HC) KP_ACC(bf16, KCC, R_KCC)
    KP_ACC(bf16, VCT, R_VCT) KP_ACC(bf16, QK, R_QK) KP_ACC(bf16, VOT, R_VOT) KP_ACC(bf16, OG, R_OG) KP_ACC(bf16, OO, R_OO)
    KP_ACC(float, RT, R_RT) KP_ACC(float, GT, R_GT) KP_ACC(float, RSTD, R_RSTD) KP_ACC(float, LSE, R_LSE) KP_ACC(float, CB, WS_CB) KP_ACC(unsigned, CTL, WS_CTL)
};

__device__ __forceinline__ int crow(int v, int hi) { return (v & 3) + 8 * (v >> 2) + 4 * hi; }
__device__ __forceinline__ float xhalf_max(float x) { auto rr = __builtin_amdgcn_permlane32_swap(__float_as_uint(x), __float_as_uint(x), false, false); return fmaxf(__uint_as_float(rr[0]), __uint_as_float(rr[1])); }
__device__ __forceinline__ float xhalf_sum(float x) { auto rr = __builtin_amdgcn_permlane32_swap(__float_as_uint(x), __float_as_uint(x), false, false); return __uint_as_float(rr[0]) + __uint_as_float(rr[1]); }
__device__ __forceinline__ float max16(const f32x16& s) {
    float a = fmaxf(fmaxf(s[0], s[1]), s[2]), b = fmaxf(fmaxf(s[3], s[4]), s[5]);
    a = fmaxf(fmaxf(a, s[6]), s[7]); b = fmaxf(fmaxf(b, s[8]), s[9]); a = fmaxf(fmaxf(a, s[10]), s[11]); b = fmaxf(fmaxf(b, s[12]), s[13]);
    return fmaxf(fmaxf(a, b), fmaxf(s[14], s[15])); }

template <int DK16>
__device__ __forceinline__ f32x16 qk_sub(const LAS unsigned char* Kt, int ks, int sub, const bf16x8 (&qf)[DK16], int r32, int hi) {
    f32x16 s;
#pragma unroll
    for (int v = 0; v < 16; ++v) s[v] = 0.f;
    const LAS unsigned char* p = Kt + (sub * 32 + r32) * ks + hi * 16;
#pragma unroll
    for (int dk = 0; dk < DK16; ++dk) { const bf16x8 kf = *(const LAS bf16x8*)(p + dk * 32); s = __builtin_amdgcn_mfma_f32_32x32x16_bf16(kf, qf[dk], s, 0, 0, 0); }
    return s;
}
template <int DV32>
__device__ __forceinline__ void pv_sub(f32x16 (&o)[DV32], const LAS unsigned char* Vt, int vs, int sub, const f32x16& p, int r32, int hi) {
#pragma unroll
    for (int kb = 0; kb < 2; ++kb) {
        u32x4 pw; pw.x = cvt_pk_bf16(p[8 * kb + 0], p[8 * kb + 1]); pw.y = cvt_pk_bf16(p[8 * kb + 2], p[8 * kb + 3]); pw.z = cvt_pk_bf16(p[8 * kb + 4], p[8 * kb + 5]); pw.w = cvt_pk_bf16(p[8 * kb + 6], p[8 * kb + 7]);
        const bf16x8 pf = __builtin_bit_cast(bf16x8, pw);
#pragma unroll
        for (int i = 0; i < DV32; ++i) {
            const bf16x8 vf = *(const LAS bf16x8*)(Vt + (32 * i + r32) * vs + sub * 64 + kb * 32 + hi * 16);
            o[i] = __builtin_amdgcn_mfma_f32_32x32x16_bf16(vf, pf, o[i], 0, 0, 0);
        }
    }
}
template <int DV32>
__device__ __forceinline__ void pv_packed(f32x16 (&o)[DV32], const LAS unsigned char* Vt, int vs, int sub, const u32x4& pk0, const u32x4& pk1, int r32, int hi) {
#pragma unroll
    for (int kb = 0; kb < 2; ++kb) {
        const bf16x8 pf = __builtin_bit_cast(bf16x8, kb == 0 ? pk0 : pk1);
#pragma unroll
        for (int i = 0; i < DV32; ++i) {
            const bf16x8 vf = *(const LAS bf16x8*)(Vt + (32 * i + r32) * vs + sub * 64 + kb * 32 + hi * 16);
            o[i] = __builtin_amdgcn_mfma_f32_32x32x16_bf16(vf, pf, o[i], 0, 0, 0);
        }
    }
}
__device__ __forceinline__ u32x4 pack8(const f32x16& p, int kb) {
    u32x4 pw; pw.x = cvt_pk_bf16(p[8 * kb + 0], p[8 * kb + 1]); pw.y = cvt_pk_bf16(p[8 * kb + 2], p[8 * kb + 3]); pw.z = cvt_pk_bf16(p[8 * kb + 4], p[8 * kb + 5]); pw.w = cvt_pk_bf16(p[8 * kb + 6], p[8 * kb + 7]); return pw; }
template <int D, int DV, int MODE, bool HASBIAS, bool JOINT, bool DEFER, class KA, class VA, class PF, class BF, class VF, class NM, class WS, class CB>
__device__ __forceinline__ void fa_loop(LAS unsigned char* lds, int nt, const KA& ka, const VA& va, const PF& pf, const BF& bf, const VF& vf, const NM& nm, const WS& wskip, const CB& cb, float c1,
                                        const bf16x8 (&qf)[D / 16], float& m, float& l, f32x16 (&o)[DV / 32], int tid_in, int r32, int hi) {
    int tid = tid_in; asm volatile("" : "+v"(tid));
    constexpr int KS = D * 2 + 16, VS = 144, KCH = D / 8, NKR = (64 * KCH + 511) / 512, NVR = (DV * 8) / 512, NVS = DEFER ? 3 : 2, KOFF = 0, VOFF = 2 * 64 * KS, POFF = VOFF + NVS * DV * VS;
    constexpr bool NEEDV = (MODE != 1);
    u32x4 kregA[NKR], kregB[NKR]; u32x4 vregA[NVR], vregB[NVR]; float pregA = 0.f, pregB = 0.f;
    if (nt <= 0) return;
    if (__builtin_amdgcn_readfirstlane(tid_in) >= 256) __builtin_amdgcn_s_setprio(1);
#define FA_LOAD(t_, KR, VR, PR) do { \
    _Pragma("unroll") for (int r_ = 0; r_ < NKR; ++r_) { const int idx_ = tid + 512 * r_; if (idx_ < 64 * KCH) { const int row_ = idx_ / KCH, ch_ = idx_ % KCH; KR[r_] = *(const u32x4*)ka((t_), row_, ch_); } } \
    if (NEEDV) { _Pragma("unroll") for (int r_ = 0; r_ < NVR; ++r_) { const int idx_ = tid + 512 * r_; const int d_ = idx_ >> 3, ch_ = idx_ & 7; VR[r_] = *(const u32x4*)va((t_), d_, ch_); } } \
    if (HASBIAS) { if (tid < 64) PR = pf((t_), tid); } } while (0)
#define FA_STORE(tt_, KR, VR, PR) do { LAS unsigned char* kb_ = lds + KOFF + ((tt_) & 1) * (64 * KS); LAS unsigned char* vb_ = lds + VOFF + ((tt_) % NVS) * (DV * VS); \
    _Pragma("unroll") for (int r_ = 0; r_ < NKR; ++r_) { const int idx_ = tid + 512 * r_; if (idx_ < 64 * KCH) { const int row_ = idx_ / KCH, ch_ = idx_ % KCH; *(LAS u32x4*)(kb_ + row_ * KS + ch_ * 16) = KR[r_]; } } \
    if (NEEDV) { _Pragma("unroll") for (int r_ = 0; r_ < NVR; ++r_) { const int idx_ = tid + 512 * r_; const int d_ = idx_ >> 3, ch_ = idx_ & 7; LAS unsigned char* q_ = vb_ + d_ * VS + (ch_ >> 2) * 64 + ((ch_ & 2) << 4) + ((ch_ & 1) << 3); *(LAS u32x2*)q_ = (u32x2){VR[r_].x, VR[r_].y}; *(LAS u32x2*)(q_ + 16) = (u32x2){VR[r_].z, VR[r_].w}; } } \
    if (HASBIAS) { if (tid < 64) *(LAS float*)(lds + POFF + ((tt_) & 1) * 256 + tid * 4) = PR; } } while (0)
    const bool defer_wave = DEFER && (tid_in >= 256);
    u32x4 pp0 = {0u, 0u, 0u, 0u}, pp1 = pp0, pp2 = pp0, pp3 = pp0; int pend = -1;
    auto compute = [&](int t, int bufi) __attribute__((always_inline)) {
        const LAS unsigned char* cur = lds + KOFF + (t & 1) * (64 * KS);
        const int vslot = t % NVS; const LAS unsigned char* curv = lds + VOFF + vslot * (DV * VS);
        const LAS float* kp = (const LAS float*)(lds + POFF + (t & 1) * 256);
        if (DEFER) { if (pend >= 0) { const LAS unsigned char* pv_ = lds + VOFF + pend * (DV * VS); pv_packed<DV / 32>(o, pv_, VS, 0, pp0, pp1, r32, hi); pv_packed<DV / 32>(o, pv_, VS, 1, pp2, pp3, r32, hi); pend = -1; } }
        const bool sk0 = wskip(t, 0), sk1 = wskip(t, 1);
        if (JOINT && MODE != 2 && !sk0 && !sk1) {
            f32x16 s0 = qk_sub<D / 16>(cur, KS, 0, qf, r32, hi); if (DEFER) __builtin_amdgcn_sched_barrier(0); f32x16 s1 = qk_sub<D / 16>(cur, KS, 1, qf, r32, hi);
            if (HASBIAS) {
#pragma unroll
                for (int a4 = 0; a4 < 4; ++a4) { const int kin0 = 8 * a4 + 4 * hi; const f32x4 kq0 = *(const LAS f32x4*)(kp + kin0), kq1 = *(const LAS f32x4*)(kp + 32 + kin0);
#pragma unroll
                    for (int e = 0; e < 4; ++e) { s0[4 * a4 + e] = s0[4 * a4 + e] * c1 + bf(t, kin0 + e, kq0[e]); s1[4 * a4 + e] = s1[4 * a4 + e] * c1 + bf(t, 32 + kin0 + e, kq1[e]); } }
            }
            const bool masked = nm(t, 0) || nm(t, 1);
            if (masked) {
#pragma unroll
                for (int v = 0; v < 16; ++v) { const int kin = crow(v, hi); if (!vf(t, kin)) s0[v] = NEGB; if (!vf(t, 32 + kin)) s1[v] = NEGB; }
            }
            float mx = xhalf_max(fmaxf(max16(s0), max16(s1)));
            const float mn = fmaxf(m, mx); float sum0 = 0.f, sum1 = 0.f;
            if (masked) {
#pragma unroll
                for (int v = 0; v < 16; ++v) { const float p0 = s0[v] > -1e29f ? fast_exp2(s0[v] - mn) : 0.f, p1 = s1[v] > -1e29f ? fast_exp2(s1[v] - mn) : 0.f; s0[v] = p0; s1[v] = p1; sum0 += p0; sum1 += p1; }
            } else {
#pragma unroll
                for (int v = 0; v < 16; ++v) { const float p0 = fast_exp2(s0[v] - mn), p1 = fast_exp2(s1[v] - mn); s0[v] = p0; s1[v] = p1; sum0 += p0; sum1 += p1; }
            }
            if (__any(mn > m)) {
                const float alpha = fast_exp2(m - mn); l *= alpha;
                if (MODE == 0) {
#pragma unroll
                    for (int i = 0; i < DV / 32; ++i)
#pragma unroll
                        for (int v = 0; v < 16; ++v) o[i][v] *= alpha;
                }
            }
            l += sum0 + sum1; m = mn;
            if (MODE == 0) {
                if (defer_wave) { pp0 = pack8(s0, 0); pp1 = pack8(s0, 1); pp2 = pack8(s1, 0); pp3 = pack8(s1, 1); pend = vslot; }
                else { pv_sub<DV / 32>(o, curv, VS, 0, s0, r32, hi); pv_sub<DV / 32>(o, curv, VS, 1, s1, r32, hi); }
            }
        } else
#pragma unroll
        for (int sub = 0; sub < 2; ++sub) {
            if (!wskip(t, sub)) {
                f32x16 s = qk_sub<D / 16>(cur, KS, sub, qf, r32, hi);
                if (HASBIAS) {
#pragma unroll
                    for (int a4 = 0; a4 < 4; ++a4) { const int kin0 = sub * 32 + 8 * a4 + 4 * hi; const f32x4 kq = *(const LAS f32x4*)(kp + kin0);
#pragma unroll
                        for (int e = 0; e < 4; ++e) s[4 * a4 + e] = s[4 * a4 + e] * c1 + bf(t, kin0 + e, kq[e]); }
                }
                const bool masked = nm(t, sub);
                if (masked) {
#pragma unroll
                    for (int v = 0; v < 16; ++v) { const int kin = sub * 32 + crow(v, hi); if (!vf(t, kin)) s[v] = NEGB; }
                }
                if (MODE == 2) {
                    if (masked) {
#pragma unroll
                        for (int v = 0; v < 16; ++v) s[v] = s[v] > -1e29f ? fast_exp2(s[v] - m) * l : 0.f;
                    } else {
#pragma unroll
                        for (int v = 0; v < 16; ++v) s[v] = fast_exp2(s[v] - m) * l;
                    }
                    cb(t, sub, s);
                    pv_sub<DV / 32>(o, curv, VS, sub, s, r32, hi);
                } else {
                    float mx0 = fmaxf(fmaxf(s[0], s[1]), s[2]), mx1 = fmaxf(fmaxf(s[3], s[4]), s[5]);
                    mx0 = fmaxf(fmaxf(mx0, s[6]), s[7]); mx1 = fmaxf(fmaxf(mx1, s[8]), s[9]); mx0 = fmaxf(fmaxf(mx0, s[10]), s[11]); mx1 = fmaxf(fmaxf(mx1, s[12]), s[13]);
                    float mx = fmaxf(fmaxf(mx0, mx1), fmaxf(s[14], s[15]));
                    mx = xhalf_max(mx);
                    const float mn = fmaxf(m, mx); float sum = 0.f;
                    if (masked) {
#pragma unroll
                        for (int v = 0; v < 16; ++v) { const float p = s[v] > -1e29f ? fast_exp2(s[v] - mn) : 0.f; s[v] = p; sum += p; }
                    } else {
#pragma unroll
                        for (int v = 0; v < 16; ++v) { const float p = fast_exp2(s[v] - mn); s[v] = p; sum += p; }
                    }
                    if (__any(mn > m)) {
                        const float alpha = fast_exp2(m - mn); l *= alpha;
                        if (MODE == 0) {
#pragma unroll
                            for (int i = 0; i < DV / 32; ++i)
#pragma unroll
                                for (int v = 0; v < 16; ++v) o[i][v] *= alpha;
                        }
                    }
                    l += sum; m = mn;
                    if (MODE == 0) pv_sub<DV / 32>(o, curv, VS, sub, s, r32, hi);
                }
            }
        }
    };
    if (DEFER) {
        FA_LOAD(0, kregA, vregA, pregA); FA_STORE(0, kregA, vregA, pregA); __syncthreads();
        for (int t = 0; t < nt; ++t) {
            asm volatile("" : "+v"(tid));
            if (t + 1 < nt) FA_LOAD(t + 1, kregA, vregA, pregA);
            compute(t, 0);
            asm volatile("" : "+v"(tid));
            if (t + 1 < nt) FA_STORE(t + 1, kregA, vregA, pregA);
            __syncthreads();
        }
    } else {
    FA_LOAD(0, kregA, vregA, pregA); FA_STORE(0, kregA, vregA, pregA); if (nt > 1) FA_LOAD(1, kregB, vregB, pregB); __syncthreads();
    for (int t = 0; t < nt; t += 2) {
        if (t + 2 < nt) FA_LOAD(t + 2, kregA, vregA, pregA);
        compute(t, 0);
        if (t + 1 < nt) FA_STORE(t + 1, kregB, vregB, pregB);
        __syncthreads();
        if (t + 1 < nt) {
            if (t + 3 < nt) FA_LOAD(t + 3, kregB, vregB, pregB);
            compute(t + 1, 1);
            if (t + 2 < nt) FA_STORE(t + 2, kregA, vregA, pregA);
            __syncthreads();
        }
    }
    }
    if (DEFER) { if (pend >= 0) { const LAS unsigned char* pv_ = lds + VOFF + pend * (DV * VS); pv_packed<DV / 32>(o, pv_, VS, 0, pp0, pp1, r32, hi); pv_packed<DV / 32>(o, pv_, VS, 1, pp2, pp3, r32, hi); }
        __syncthreads(); }
    __builtin_amdgcn_s_setprio(0);
#undef FA_LOAD
#undef FA_STORE
}
template <int NV>
__device__ __forceinline__ void store_o(bf16* op, const f32x16 (&o)[NV], float sc, int hi) {
#pragma unroll
    for (int i = 0; i < NV; ++i)
#pragma unroll
        for (int a = 0; a < 4; ++a) {
            u32x2 wv; wv.x = cvt_pk_bf16(o[i][4 * a] * sc, o[i][4 * a + 1] * sc); wv.y = cvt_pk_bf16(o[i][4 * a + 2] * sc, o[i][4 * a + 3] * sc);
            *(u32x2*)(op + 32 * i + 8 * a + 4 * hi) = wv;
        }
}
struct NoCb { __device__ __forceinline__ void operator()(int, int, const f32x16&) const {} };

__device__ __forceinline__ void mla_unit(const KP& P, LAS unsigned char* lds, int b, int h, int qb, int tid_u) {
    int tid = tid_u; asm volatile("" : "+v"(tid));
    const int* const posp = P.pos_local();
    const int lane = tid & 63, w = __builtin_amdgcn_readfirstlane(tid >> 6), r32 = lane & 31, hi = lane >> 5;
    const int q0 = qb * 256, tq = q0 + 32 * w + r32; const size_t bS = (size_t)b * SEQ, tok = bS + tq;
    bf16x8 qf[6];
#pragma unroll
    for (int dk = 0; dk < 6; ++dk) qf[dk] = *(const bf16x8*)(P.QM() + tok * 768 + h * 96 + dk * 16 + hi * 8);
    const int nt = (q0 + 256) / 64;
    auto ka = [&](int t, int row, int ch) -> const bf16* { const size_t tk = bS + 64 * t + row; return ch < 8 ? P.KN() + tk * 512 + h * 64 + ch * 8 : P.KROT() + tk * 32 + (ch - 8) * 8; };
    auto va = [&](int t, int d, int ch) -> const bf16* { return P.VMT() + (size_t)(h * 64 + d) * T + bS + 64 * t + ch * 8; };
    auto pf = [&](int, int) -> float { return 0.f; };
    auto bf = [&](int, int, float) -> float { return 0.f; };
    auto vf = [&](int t, int kin) -> bool { return 64 * t + kin <= tq; };
    const int wq_lo = q0 + 32 * w, wq_hi = wq_lo + 31;
    auto nm = [&](int t, int sub) -> bool { return 64 * t + 32 * sub + 31 > wq_lo; };
    auto ws = [&](int t, int sub) -> bool { return 64 * t + 32 * sub > wq_hi; };
    float m = NEGB, l = 0.f; f32x16 o[2];
#pragma unroll
    for (int i = 0; i < 2; ++i)
#pragma unroll
        for (int v = 0; v < 16; ++v) o[i][v] = 0.f;
    fa_loop<96, 64, 0, false, true, false>(lds, nt, ka, va, pf, bf, vf, nm, ws, NoCb(), 1.f, qf, m, l, o, tid, r32, hi);
    l = xhalf_sum(l); const float inv = l > 0.f ? 1.f / l : 0.f;
    store_o<2>(P.OE() + tok * 1024 + h * 64, o, inv, hi);
}

constexpr int NSA_GL = 40960, NSA_SELM = NSA_GL + 8 * 2 * 8 * 132 * 4, NSA_BU = NSA_SELM + 1024, NSA_TL = NSA_BU + 32;
__device__ __forceinline__ void nsa_unit(const KP& P, LAS unsigned char* lds, int b, int c, int g, int tid_u) {
    int tid = tid_u; asm volatile("" : "+v"(tid));
    const int* const posp = P.pos_local();
    const int lane = tid & 63, w = __builtin_amdgcn_readfirstlane(tid >> 6), r32 = lane & 31, hi = lane >> 5;
    const int n = r32 >> 3, qi = r32 & 7, hh = g * 4 + n;
    const int tq = 64 * c + 8 * w + qi; const size_t bS = (size_t)b * SEQ, tok = bS + tq;
    const float slope2 = fast_exp2(-(float)(hh + 1)) * LOG2E, c1 = 0.125f * LOG2E;
    const float pq = (float)posp[tok], nbq = -slope2 * pq;
    bf16x8 qf[4];
#pragma unroll
    for (int dk = 0; dk < 4; ++dk) qf[dk] = *(const bf16x8*)(P.HE() + tok * HE_LD + HE_Q + hh * 64 + dk * 16 + hi * 8);
    LAS float* GLw = (LAS float*)(lds + NSA_GL) + w * (2 * 8 * 132);
    LAS unsigned long long* SELM = (LAS unsigned long long*)(lds + NSA_SELM);
    LAS unsigned* BU = (LAS unsigned*)(lds + NSA_BU);
    LAS int* TL = (LAS int*)(lds + NSA_TL);
    for (int i = tid; i < 8 * 2 * 8 * 132; i += 512) ((LAS float*)(lds + NSA_GL))[i] = 0.f;
    if (tid < 8) BU[tid] = 0u;
    __syncthreads();
    const int wq_lo = 64 * c + 8 * w, wq_hi = wq_lo + 7;
    f32x16 o[2];
#pragma unroll
    for (int i = 0; i < 2; ++i)
#pragma unroll
        for (int v = 0; v < 16; ++v) o[i][v] = 0.f;
    LAS float* stash = (LAS float*)(lds + NSA_GL) + tid;
    {
        const int nt1 = (4 * c + 3 + 63) >> 6;
        auto ka1 = [&](int t, int row, int ch) -> const bf16* { return P.KCC() + ((size_t)b * 512 + 64 * t + row) * 128 + g * 64 + ch * 8; };
        auto va1 = [&](int t, int d, int ch) -> const bf16* { return P.VCT() + (size_t)(g * 64 + d) * 8192 + b * 512 + 64 * t + ch * 8; };
        auto pf1 = [&](int t, int i) -> float { int j = 64 * t + i; j = j > 510 ? 510 : j; return (float)posp[bS + 31 + 16 * j]; };
        auto bf1 = [&](int, int, float kp) -> float { return kp * slope2 + nbq; };
        auto vf1 = [&](int t, int kin) -> bool { const int j = 64 * t + kin; return 16 * j + 31 <= tq; };
        auto nm1 = [&](int t, int sub) -> bool { return 16 * (64 * t + 32 * sub + 31) + 31 > wq_lo; };
        auto ws1 = [&](int t, int sub) -> bool { return 16 * (64 * t + 32 * sub) + 31 > wq_hi; };
        float m1 = NEGB, l1 = 0.f;
        fa_loop<64, 64, 1, true, false, false>(lds, nt1, ka1, va1, pf1, bf1, vf1, nm1, ws1, NoCb(), c1, qf, m1, l1, o, tid, r32, hi);
        l1 = xhalf_sum(l1); float invl = l1 > 0.f ? 1.f / l1 : 0.f;
        auto cb1 = [&](int t, int sub, const f32x16& p) {
#pragma unroll
            for (int a = 0; a < 4; ++a) {
                float gsum = (p[4 * a] + p[4 * a + 1]) + (p[4 * a + 2] + p[4 * a + 3]), last = p[4 * a + 3];
                gsum += __shfl_xor(gsum, 8); gsum += __shfl_xor(gsum, 16); last += __shfl_xor(last, 8); last += __shfl_xor(last, 16);
                const int u = (64 * t + 32 * sub) / 4 + 2 * a + hi;
                if (r32 < 8) { GLw[qi * 132 + u] = gsum; GLw[8 * 132 + qi * 132 + u + 1] = last; }
            }
        };
        fa_loop<64, 64, 2, true, false, false>(lds, nt1, ka1, va1, pf1, bf1, vf1, nm1, ws1, cb1, c1, qf, m1, invl, o, tid, r32, hi);
        const float gtc = P.GT()[tok * 24 + hh];
#pragma unroll
        for (int i = 0; i < 2; ++i)
#pragma unroll
            for (int v = 0; v < 16; ++v) o[i][v] *= gtc;
    }
    unsigned long long wu0 = 0ull, wu1 = 0ull;
    {
        const int ncand = c - 1 > 0 ? c - 1 : 0, need = 16 - (c == 0 ? 1 : 2);
        for (int q = 0; q < 8; ++q) {
            const int s0 = lane, s1 = lane + 64;
            const bool c0 = (s0 >= 1) && (s0 <= c - 1), cc1 = (s1 <= c - 1);
            const float f0 = c0 ? GLw[q * 132 + s0] + GLw[8 * 132 + q * 132 + s0] : 0.f;
            const float f1 = cc1 ? GLw[q * 132 + s1] + GLw[8 * 132 + q * 132 + s1] : 0.f;
            const unsigned b0 = __float_as_uint(f0), b1 = __float_as_uint(f1);
            unsigned long long sel0, sel1;
            if (ncand <= need) { sel0 = __ballot(c0); sel1 = __ballot(cc1); }
            else {
                unsigned x = 0u;
                for (int bit = 30; bit >= 0; --bit) {
                    const unsigned tt = x | (1u << bit);
                    const int cnt = __popcll(__ballot(c0 && b0 >= tt)) + __popcll(__ballot(cc1 && b1 >= tt));
                    if (cnt >= need) x = tt;
                }
                sel0 = __ballot(c0 && b0 > x); sel1 = __ballot(cc1 && b1 > x);
                int rem = need - (__popcll(sel0) + __popcll(sel1));
                unsigned long long e0 = __ballot(c0 && b0 == x), e1 = __ballot(cc1 && b1 == x);
                while (rem > 0 && e0) { const unsigned long long low = e0 & (~e0 + 1ull); sel0 |= low; e0 ^= low; --rem; }
                while (rem > 0 && e1) { const unsigned long long low = e1 & (~e1 + 1ull); sel1 |= low; e1 ^= low; --rem; }
            }
            sel0 |= 1ull; if (c < 64) sel0 |= 1ull << c; else sel1 |= 1ull << (c - 64);
            if (lane == 0) { SELM[(w * 8 + q) * 2] = sel0; SELM[(w * 8 + q) * 2 + 1] = sel1; }
            wu0 |= sel0; wu1 |= sel1;
        }
        if (lane == 0) { atomicOr((unsigned*)&BU[0], (unsigned)wu0); atomicOr((unsigned*)&BU[1], (unsigned)(wu0 >> 32)); atomicOr((unsigned*)&BU[2], (unsigned)wu1); atomicOr((unsigned*)&BU[3], (unsigned)(wu1 >> 32)); }
    }
    __syncthreads();
#pragma unroll
    for (int i = 0; i < 2; ++i)
#pragma unroll
        for (int v = 0; v < 16; ++v) { stash[(i * 16 + v) * 512] = o[i][v]; o[i][v] = 0.f; }
    if (tid < 128) {
        const unsigned u0 = BU[0], u1 = BU[1], u2 = BU[2], u3 = BU[3];
        const int k = tid >> 5; const unsigned wk = k == 0 ? u0 : (k == 1 ? u1 : (k == 2 ? u2 : u3));
        if ((wk >> (tid & 31)) & 1u) {
            int pos = __popc(wk & ((1u << (tid & 31)) - 1u));
            if (k > 0) pos += __popc(u0); if (k > 1) pos += __popc(u1); if (k > 2) pos += __popc(u2);
            TL[pos] = tid;
        }
        if (tid == 0) BU[4] = __popc(u0) + __popc(u1) + __popc(u2) + __popc(u3);
    }
    __syncthreads();
    const unsigned long long ms0 = SELM[(w * 8 + qi) * 2], ms1 = SELM[(w * 8 + qi) * 2 + 1];
    {
        const int nsel = (int)BU[4];
        auto ka2 = [&](int t, int row, int ch) -> const bf16* { const int sb = TL[t]; return P.HE() + (bS + 64 * sb + row) * HE_LD + HE_KS + g * 64 + ch * 8; };
        auto va2 = [&](int t, int d, int ch) -> const bf16* { const int sb = TL[t]; return P.VT() + (size_t)(g * 64 + d) * T + bS + 64 * sb + ch * 8; };
        auto pf2 = [&](int t, int i) -> float { const int sb = TL[t]; return (float)posp[bS + 64 * sb + i]; };
        auto bf2 = [&](int, int, float kp) -> float { return kp * slope2 + nbq; };
        auto vf2 = [&](int t, int kin) -> bool { const int sb = TL[t]; const bool selb = (((sb < 64 ? ms0 : ms1) >> (sb & 63)) & 1ull) != 0ull; return selb && (64 * sb + kin <= tq); };
        auto nm2 = [&](int t, int) -> bool { const int sb = TL[t]; const bool selb = (((sb < 64 ? ms0 : ms1) >> (sb & 63)) & 1ull) != 0ull; return sb == c || !__all(selb); };
        auto ws2 = [&](int t, int) -> bool { const int sb = TL[t]; return (((sb < 64 ? wu0 : wu1) >> (sb & 63)) & 1ull) == 0ull; };
        float m2 = NEGB, l2 = 0.f;
        fa_loop<64, 64, 0, true, false, false>(lds, nsel, ka2, va2, pf2, bf2, vf2, nm2, ws2, NoCb(), c1, qf, m2, l2, o, tid, r32, hi);
        l2 = xhalf_sum(l2); const float gts = P.GT()[tok * 24 + 8 + hh]; const float sc = l2 > 0.f ? gts / l2 : 0.f;
#pragma unroll
        for (int i = 0; i < 2; ++i)
#pragma unroll
            for (int v = 0; v < 16; ++v) { stash[(i * 16 + v) * 512] += o[i][v] * sc; o[i][v] = 0.f; }
    }
    {
        const int first = c < 8 ? 8 - c : 0, nt3 = 9 - first, base3 = 64 * c - 512 + 64 * first;
        auto ka3 = [&](int t, int row, int ch) -> const bf16* { return P.HE() + (bS + base3 + 64 * t + row) * HE_LD + HE_KW + g * 64 + ch * 8; };
        auto va3 = [&](int t, int d, int ch) -> const bf16* { return P.VT() + (size_t)(128 + g * 64 + d) * T + bS + base3 + 64 * t + ch * 8; };
        auto pf3 = [&](int t, int i) -> float { return (float)posp[bS + base3 + 64 * t + i]; };
        auto bf3 = [&](int, int, float kp) -> float { return kp * slope2 + nbq; };
        auto vf3 = [&](int t, int kin) -> bool { const int df = tq - (base3 + 64 * t + kin); return df >= 0 && df < 512; };
        auto nm3 = [&](int t, int sub) -> bool { const int k0 = base3 + 64 * t + 32 * sub; return k0 + 31 > wq_lo || k0 < wq_hi - 511; };
        auto ws3 = [&](int t, int sub) -> bool { const int k0 = base3 + 64 * t + 32 * sub; return k0 > wq_hi || k0 + 31 < wq_lo - 511; };
        float m3 = NEGB, l3 = 0.f;
        fa_loop<64, 64, 0, true, false, false>(lds, nt3, ka3, va3, pf3, bf3, vf3, nm3, ws3, NoCb(), c1, qf, m3, l3, o, tid, r32, hi);
        l3 = xhalf_sum(l3); const float gtw = P.GT()[tok * 24 + 16 + hh]; const float sc = l3 > 0.f ? gtw / l3 : 0.f;
#pragma unroll
        for (int i = 0; i < 2; ++i)
#pragma unroll
            for (int v = 0; v < 16; ++v) o[i][v] = o[i][v] * sc + stash[(i * 16 + v) * 512];
    }
    store_o<2>(P.OE() + tok * 1024 + 512 + hh * 64, o, 1.f, hi);
}

__device__ __forceinline__ void dil_unit(const KP& P, LAS unsigned char* lds, int b, int g, int h, int rj, int tid_u) {
    int tid = tid_u; asm volatile("" : "+v"(tid));
    const int* const posp = P.pos_local();
    const int lane = tid & 63, w = __builtin_amdgcn_readfirstlane(tid >> 6), r32 = lane & 31, hi = lane >> 5;
    const int dil = g == 0 ? 1 : (g == 1 ? 4 : 16), per = 32 / dil, r = rj / per, jt = rj % per, clen = SEQ / dil;
    const int J = 256 * jt + 32 * w + r32; const size_t bS = (size_t)b * SEQ, tok = bS + r + dil * J;
    const float slope2 = fast_exp2(-8.f * (float)(g * 4 + h + 1) / 12.f) * LOG2E, c1 = 0.08838834764831845f * LOG2E;
    const float pq = (float)posp[tok], nbq = -slope2 * pq;
    bf16x8 qf[8];
#pragma unroll
    for (int dk = 0; dk < 8; ++dk) qf[dk] = *(const bf16x8*)(P.QK() + tok * 3072 + g * 512 + h * 128 + dk * 16 + hi * 8);
    const int first = jt == 0 ? 2 : 0, nt = 6 - first, I00 = 256 * jt - 128 + 64 * first;
    auto ka = [&](int t, int row, int ch) -> const bf16* { return P.QK() + (bS + r + (size_t)dil * (I00 + 64 * t + row)) * 3072 + 1536 + g * 512 + h * 128 + ch * 8; };
    auto va = [&](int t, int d, int ch) -> const bf16* { return P.VOT() + (size_t)(g * 512 + h * 128 + d) * T + bS + (size_t)r * clen + I00 + 64 * t + ch * 8; };
    auto pf = [&](int t, int i) -> float { return (float)posp[bS + r + dil * (I00 + 64 * t + i)]; };
    auto bf = [&](int, int, float kp) -> float { return kp * slope2 + nbq; };
    auto vf = [&](int t, int kin) -> bool { const int df = J - (I00 + 64 * t + kin); return df >= 0 && df <= 128; };
    const int Jw = 256 * jt + 32 * w;
    auto nm = [&](int t, int sub) -> bool { const int i0 = I00 + 64 * t + 32 * sub; return i0 + 31 > Jw || i0 < Jw + 31 - 128; };
    auto ws = [&](int t, int sub) -> bool { const int i0 = I00 + 64 * t + 32 * sub; return i0 > Jw + 31 || i0 + 31 < Jw - 128; };
    float m = NEGB, l = 0.f; f32x16 o[4];
#pragma unroll
    for (int i = 0; i < 4; ++i)
#pragma unroll
        for (int v = 0; v < 16; ++v) o[i][v] = 0.f;
    fa_loop<128, 128, 0, true, false, false>(lds, nt, ka, va, pf, bf, vf, nm, ws, NoCb(), c1, qf, m, l, o, tid, r32, hi);
    l = xhalf_sum(l); const float inv = l > 0.f ? 1.f / l : 0.f;
    store_o<4>(P.OG() + ((size_t)g * T + tok) * 512 + h * 128, o, inv, hi);
    if (hi == 0) P.LSE()[((size_t)g * T + tok) * 4 + h] = m + __log2f(l);
}
struct Args { const float* in[28]; float* out; unsigned char* ws; int ph_lo, ph_hi; };

enum { WM_ID = 0, WM_SWIGLU = 1, WM_E1 = 2, WM_E2 = 3, WM_UQ = 4 };
struct WSpec { const float* W; const float* W2; const float* gk; bf16* WT; int K, Nsrc, Ndst, mode, soff, nvalid; };
__device__ __forceinline__ void transpose_item(const WSpec& s, LAS float* scr, int item, int lane) {
    const int nblk = s.Ndst / 32, kb = item / nblk, nb = item % nblk, k0 = 128 * kb, n0 = 32 * nb;
    const int R = n0 + (lane & 31); int sc; const float* Wp = s.W;
    if (s.mode == WM_ID) sc = R < s.nvalid ? R + s.soff : -1;
    else if (s.mode == WM_SWIGLU) { sc = (R >> 8) * 128 + (R & 127); if ((R >> 7) & 1) Wp = s.W2; }
    else if (s.mode == WM_E1) sc = R < 1568 ? R : (R < 1696 ? R + 128 : (R < 1720 ? R + 256 : -1));
    else if (s.mode == WM_E2) sc = R < 128 ? 1568 + R : 1824 + (R - 128);
    else { const int h = R / 96, wq = R % 96; if (wq < 64) sc = R; else { const int p = wq - 64, fq = p >> 3, sub = p & 7; sc = 96 * h + 64 + (sub < 4 ? 4 * fq + sub : 16 + 4 * fq + (sub - 4)); } }
    if (s.mode != WM_UQ) {
        const int c4 = (lane & 7) * 4, R4 = n0 + c4; int sc4; const float* Wq = s.W;
        if (s.mode == WM_ID) sc4 = R4 < s.nvalid ? R4 + s.soff : -1;
        else if (s.mode == WM_SWIGLU) { sc4 = (R4 >> 8) * 128 + (R4 & 127); if ((R4 >> 7) & 1) Wq = s.W2; }
        else if (s.mode == WM_E1) sc4 = R4 < 1568 ? R4 : (R4 < 1696 ? R4 + 128 : (R4 < 1720 ? R4 + 256 : -1));
        else sc4 = R4 < 128 ? 1568 + R4 : 1824 + (R4 - 128);
        const float msk = sc4 >= 0 ? 1.f : 0.f; const int sc4c = sc4 >= 0 ? sc4 : 0;
        f32x4 vv[16];
#pragma unroll
        for (int i = 0; i < 16; ++i) { const int kk = 8 * i + (lane >> 3); vv[i] = *(const f32x4*)(Wq + (size_t)(k0 + kk) * s.Nsrc + sc4c); }
        if (s.gk) {
#pragma unroll
            for (int i = 0; i < 16; ++i) { const int kk = 8 * i + (lane >> 3); vv[i] = vv[i] * s.gk[k0 + kk]; }
        }
#pragma unroll
        for (int i = 0; i < 16; ++i) { const int kk = 8 * i + (lane >> 3); const f32x4 v = vv[i] * msk;
            scr[kk * 33 + c4] = v[0]; scr[kk * 33 + c4 + 1] = v[1]; scr[kk * 33 + c4 + 2] = v[2]; scr[kk * 33 + c4 + 3] = v[3]; }
    } else {
        float vs[64];
#pragma unroll
        for (int i = 0; i < 64; ++i) { const int kk = 2 * i + (lane >> 5); vs[i] = Wp[(size_t)(k0 + kk) * s.Nsrc + sc]; }
#pragma unroll
        for (int i = 0; i < 64; ++i) { const int kk = 2 * i + (lane >> 5); scr[kk * 33 + (lane & 31)] = vs[i] * s.gk[k0 + kk]; }
    }
    asm volatile("s_waitcnt lgkmcnt(0)" ::: "memory");
    const int c = lane & 15;
#pragma unroll
    for (int j = 0; j < 8; ++j) { const int nn = (lane >> 4) + 4 * j; const LAS float* sp = scr + (8 * c) * 33 + nn;
        u32x4 o; o.x = cvt_pk_bf16(sp[0 * 33], sp[1 * 33]); o.y = cvt_pk_bf16(sp[2 * 33], sp[3 * 33]); o.z = cvt_pk_bf16(sp[4 * 33], sp[5 * 33]); o.w = cvt_pk_bf16(sp[6 * 33], sp[7 * 33]);
        *(u32x4*)(s.WT + (size_t)(n0 + nn) * s.K + k0 + 8 * c) = o; }
    asm volatile("s_waitcnt lgkmcnt(0)" ::: "memory");
}
__device__ __forceinline__ const float* ffn_w(const Args& a, int f, int which) {
    const int L = f >> 1; const bool second = (f & 1) != 0;
    const float* base = which == 0 ? (second ? a.in[23] : a.in[4]) : (which == 1 ? (second ? a.in[24] : a.in[5]) : (second ? a.in[25] : a.in[6]));
    return base + (size_t)L * 1024 * 2816;
}
__device__ __forceinline__ void p0_prologue(const Args& a, const KP& P, LAS unsigned char* lds, int tid, int gw, int NGW) {
    const int lane = tid & 63, w = tid >> 6;
    LAS float* scr = (LAS float*)(lds + w * 17408);
    int cum = 0;
    for (int wi = 0; wi < 21; ++wi) {
        WSpec s; s.W2 = nullptr; s.gk = nullptr; s.mode = WM_ID; s.soff = 0;
        if (wi < 4) { s.W = ffn_w(a, wi, 0); s.W2 = ffn_w(a, wi, 1); s.K = 1024; s.Nsrc = 2816; s.Ndst = 5632; s.mode = WM_SWIGLU; s.WT = P.WB() + WE_GU + (size_t)wi * 5632 * 1024; }
        else if (wi < 8) { s.W = ffn_w(a, wi - 4, 2); s.K = 2816; s.Nsrc = 1024; s.Ndst = 1024; s.WT = P.WB() + WE_D + (size_t)(wi - 4) * 1024 * 2816; }
        else if (wi == 8) { s.W = a.in[7]; s.K = 1024; s.Nsrc = 1976; s.Ndst = 1792; s.mode = WM_E1; s.WT = P.WB() + WE_E1; }
        else if (wi == 9) { s.W = a.in[7]; s.K = 1024; s.Nsrc = 1976; s.Ndst = 256; s.mode = WM_E2; s.WT = P.WB() + WE_E2; }
        else if (wi == 10) { s.W = a.in[10]; s.gk = a.in[8]; s.K = 384; s.Nsrc = 768; s.Ndst = 768; s.mode = WM_UQ; s.WT = P.WB() + WE_UQ; }
        else if (wi == 11) { s.W = a.in[11]; s.gk = a.in[9]; s.K = 256; s.Nsrc = 512; s.Ndst = 512; s.WT = P.WB() + WE_UK; }
        else if (wi == 12) { s.W = a.in[12]; s.gk = a.in[9]; s.K = 256; s.Nsrc = 512; s.Ndst = 512; s.WT = P.WB() + WE_UV; }
        else if (wi == 13) { s.W = a.in[14]; s.K = 2048; s.Nsrc = 256; s.Ndst = 256; s.WT = P.WB() + WE_C1K; }
        else if (wi == 14) { s.W = a.in[16]; s.K = 2048; s.Nsrc = 256; s.Ndst = 256; s.WT = P.WB() + WE_C1V; }
        else if (wi == 15) { s.W = a.in[15]; s.K = 256; s.Nsrc = 64; s.Ndst = 256; s.WT = P.WB() + WE_C2K; }
        else if (wi == 16) { s.W = a.in[17]; s.K = 256; s.Nsrc = 64; s.Ndst = 256; s.WT = P.WB() + WE_C2V; }
        else if (wi == 17) { s.W = a.in[18]; s.K = 1024; s.Nsrc = 1024; s.Ndst = 1024; s.WT = P.WB() + WE_OE; }
        else if (wi == 18) { s.W = a.in[19]; s.K = 1024; s.Nsrc = 4608; s.Ndst = 3072; s.WT = P.WB() + WE_O1; }
        else if (wi == 19) { s.W = a.in[19]; s.K = 1024; s.Nsrc = 4608; s.Ndst = 1536; s.soff = 3072; s.WT = P.WB() + WE_O2; }
        else { s.W = a.in[20]; s.K = 512; s.Nsrc = 1024; s.Ndst = 1024; s.WT = P.WB() + WE_OO; }
        s.nvalid = (wi == 15 || wi == 16) ? 64 : s.Ndst;
        const int nitems = (s.K / 128) * (s.Ndst / 32);
        { int it0 = (gw - cum) % NGW; if (it0 < 0) it0 += NGW; for (int it = it0; it < nitems; it += NGW) transpose_item(s, scr, it, lane); cum = (cum + nitems) % NGW; }
    }
    { const float* x = a.in[0]; const size_t n8 = (size_t)T * DM / 8; const size_t gt = (size_t)gw * 64 + lane, NT_ = (size_t)NGW * 64;
#pragma unroll 4
      for (size_t i = gt; i < n8; i += NT_) { const f32x4 v0 = *(const f32x4*)(x + i * 8), v1 = *(const f32x4*)(x + i * 8 + 4);
          u32x4 o; o.x = cvt_pk_bf16(v0[0], v0[1]); o.y = cvt_pk_bf16(v0[2], v0[3]); o.z = cvt_pk_bf16(v1[0], v1[1]); o.w = cvt_pk_bf16(v1[2], v1[3]); *(u32x4*)(P.XB() + i * 8) = o; } }
    if (gw < 512) { const int kv = gw >> 8, nn = gw & 255; const float* w1 = kv ? a.in[16] : a.in[14]; const float* cp = a.in[13]; float sacc = 0.f;
        for (int i = 0; i < 32; ++i) { const int kk = lane + 64 * i; sacc += cp[kk] * w1[(size_t)kk * 256 + nn]; }
        sacc = wave_sum(sacc); if (lane == 0) P.CB()[kv * 256 + nn] = sacc; }
    if (gw == 0) { P.CTL()[lane] = 0u; if (lane < 28) ((const float**)(P.ws + WS_PT))[lane] = a.in[lane]; }
}
__device__ __forceinline__ void ln_pass(const KP& P, const float* gam, const float* bet, bool write_x, int lane, int gw, int NGW) {
    float* ST = (float*)(P.ws + WS_ST);
    f32x4 gv[4], bv[4];
#pragma unroll
    for (int j = 0; j < 4; ++j) { gv[j] = *(const f32x4*)(gam + 4 * lane + 256 * j); bv[j] = *(const f32x4*)(bet + 4 * lane + 256 * j); }
    for (int row = gw; row < T; row += 2 * NGW) {
        const int row2 = row + NGW; const bool has2 = row2 < T;
        float* xr = P.out + (size_t)row * DM + 4 * lane; float* xr2 = P.out + (size_t)(has2 ? row2 : row) * DM + 4 * lane;
        f32x4 v[4], u[4]; float s = 0.f, t = 0.f;
#pragma unroll
        for (int j = 0; j < 4; ++j) { v[j] = *(const f32x4*)(xr + 256 * j); u[j] = *(const f32x4*)(xr2 + 256 * j); }
#pragma unroll
        for (int j = 0; j < 4; ++j) { s += (v[j][0] + v[j][1]) + (v[j][2] + v[j][3]); t += (u[j][0] + u[j][1]) + (u[j][2] + u[j][3]); }
        const float mean = wave_sum(s) * (1.f / DM), mean2 = wave_sum(t) * (1.f / DM); float s2 = 0.f, t2 = 0.f;
#pragma unroll
        for (int j = 0; j < 4; ++j) { v[j] = v[j] - mean; s2 += (v[j][0] * v[j][0] + v[j][1] * v[j][1]) + (v[j][2] * v[j][2] + v[j][3] * v[j][3]);
                                      u[j] = u[j] - mean2; t2 += (u[j][0] * u[j][0] + u[j][1] * u[j][1]) + (u[j][2] * u[j][2] + u[j][3] * u[j][3]); }
        const float rstd = 1.f / sqrtf(wave_sum(s2) * (1.f / DM) + 1e-5f), rstd2 = 1.f / sqrtf(wave_sum(t2) * (1.f / DM) + 1e-5f);
        bf16* xb = P.XB() + (size_t)row * DM + 4 * lane; bf16* xb2 = P.XB() + (size_t)row2 * DM + 4 * lane;
#pragma unroll
        for (int j = 0; j < 4; ++j) { const f32x4 y = v[j] * rstd * gv[j] + bv[j]; if (write_x) *(f32x4*)(xr + 256 * j) = y;
            u32x2 o; o.x = cvt_pk_bf16(y[0], y[1]); o.y = cvt_pk_bf16(y[2], y[3]); *(u32x2*)(xb + 256 * j) = o; }
        if (lane == 0) { ST[2 * row] = mean; ST[2 * row + 1] = rstd; if (has2) { ST[2 * row2] = mean2; ST[2 * row2 + 1] = rstd2; } }
        if (has2) {
#pragma unroll
            for (int j = 0; j < 4; ++j) { const f32x4 y = u[j] * rstd2 * gv[j] + bv[j]; if (write_x) *(f32x4*)(xr2 + 256 * j) = y;
                u32x2 o; o.x = cvt_pk_bf16(y[0], y[1]); o.y = cvt_pk_bf16(y[2], y[3]); *(u32x2*)(xb2 + 256 * j) = o; }
        }
    }
}
__device__ __forceinline__ void small_pass(const KP& P, int lane, int gw, int NGW) {
    constexpr int NR = 4;
    const int lq = lane < 48 ? lane : 47, lg = lane < 32 ? 0 : (lane < 56 ? lane - 32 : 23);
    double inv = 1.0; for (int k = 0; k < (lane & 15); ++k) inv *= 0.5623413251903491;
    for (int tok0 = gw; tok0 < T; tok0 += NR * NGW) {
        u32x4 cq[NR], ck[NR]; bf16 p1[NR], p2[NR], gl[NR]; int ps[NR];
#pragma unroll
        for (int r = 0; r < NR; ++r) { const int tok = tok0 + r * NGW < T ? tok0 + r * NGW : tok0; const bf16* he = P.HE() + (size_t)tok * HE_LD;
            cq[r] = *(const u32x4*)(he + lq * 8); ck[r] = *(const u32x4*)(he + HE_CKV + (lane & 31) * 8);
            p1[r] = he[HE_KPE + (lane & 15)]; p2[r] = he[HE_KPE + 16 + (lane & 15)]; gl[r] = he[HE_GT + lg]; ps[r] = P.pos[tok]; }
#pragma unroll
        for (int r = 0; r < NR; ++r) {
            const int tok = tok0 + r * NGW; float sq = 0.f, skv = 0.f;
#pragma unroll
            for (int e2 = 0; e2 < 4; ++e2) { const float a0 = __uint_as_float(cq[r][e2] << 16), a1 = __uint_as_float(cq[r][e2] & 0xffff0000u); sq += a0 * a0 + a1 * a1;
                                             const float b0 = __uint_as_float(ck[r][e2] << 16), b1 = __uint_as_float(ck[r][e2] & 0xffff0000u); skv += b0 * b0 + b1 * b1; }
            sq = wave_sum(lane < 48 ? sq : 0.f); skv = wave_sum(lane < 32 ? skv : 0.f);
            if (tok < T) {
                if (lane == 0) { P.RSTD()[tok] = 1.f / sqrtf(sq * (1.f / 384.f) + 1e-6f); P.RSTD()[T + tok] = 1.f / sqrtf(skv * (1.f / 256.f) + 1e-6f); }
                if (lane < 16) {
                    const double rev = (double)ps[r] * inv * 0.15915494309189535; const float fr = (float)(rev - floor(rev));
                    const float sn = __builtin_amdgcn_sinf(fr), cs = __builtin_amdgcn_cosf(fr);
                    P.RT()[(size_t)tok * 32 + 2 * lane] = cs; P.RT()[(size_t)tok * 32 + 2 * lane + 1] = sn;
                    const float x1 = bf2f(p1[r]), x2 = bf2f(p2[r]);
                    const int q1 = 8 * (lane >> 2) + (lane & 3);
                    const unsigned o1 = cvt_pk_bf16(x1 * cs - x2 * sn, 0.f), o2 = cvt_pk_bf16(x2 * cs + x1 * sn, 0.f);
                    P.KROT()[(size_t)tok * 32 + q1] = (bf16)(o1 & 0xffffu); P.KROT()[(size_t)tok * 32 + q1 + 4] = (bf16)(o2 & 0xffffu);
                }
                if (lane >= 32 && lane < 56) { const float x = bf2f(gl[r]); P.GT()[(size_t)tok * 24 + (lane - 32)] = fast_rcp(1.f + fast_exp2(-LOG2E * x)); }
            }
        }
    }
}
__device__ __forceinline__ void merge_pass(const KP& P, int lane, int gw, int NGW) {
    const size_t n = (size_t)T * 64, gt = (size_t)gw * 64 + lane, NT_ = (size_t)NGW * 64;
    for (size_t idx = gt; idx < n; idx += NT_) {
        const size_t tok = idx >> 6; const int col = (int)(idx & 63) * 8, h = col >> 7;
        const float l0 = P.LSE()[tok * 4 + h], l1 = P.LSE()[((size_t)T + tok) * 4 + h], l2 = P.LSE()[((size_t)2 * T + tok) * 4 + h];
        const float mx = fmaxf(l0, fmaxf(l1, l2)); float w0 = fast_exp2(l0 - mx), w1 = fast_exp2(l1 - mx), w2 = fast_exp2(l2 - mx);
        const float inv = 1.f / (w0 + w1 + w2); w0 *= inv; w1 *= inv; w2 *= inv;
        const u32x4 a = *(const u32x4*)(P.OG() + tok * 512 + col), b = *(const u32x4*)(P.OG() + ((size_t)T + tok) * 512 + col), c = *(const u32x4*)(P.OG() + ((size_t)2 * T + tok) * 512 + col);
        u32x4 o;
#pragma unroll
        for (int e = 0; e < 4; ++e) {
            const float lo = w0 * __uint_as_float(a[e] << 16) + w1 * __uint_as_float(b[e] << 16) + w2 * __uint_as_float(c[e] << 16);
            const float hi = w0 * __uint_as_float(a[e] & 0xffff0000u) + w1 * __uint_as_float(b[e] & 0xffff0000u) + w2 * __uint_as_float(c[e] & 0xffff0000u);
            o[e] = cvt_pk_bf16(lo, hi);
        }
        *(u32x4*)(P.OO() + tok * 512 + col) = o;
    }
}

#define ONE_LAUNCH 1
#define PROBE_F1 0
#define PROBE_O12 0
#define PROBE_EFRONT 0
#define PROBE_F2 0
#define USE_XBAR 1
#define PROBE_P0 0
#define PROBE_SYNC 0
#define PROBE_ATTE 0
#define PROBE_ATTO 0
#define PROBE_MLA_ONLY 0

enum { K_P0, K_F1, K_F2, K_LN, K_E12, K_SMALL, K_E345, K_C2, K_ATTE, K_OUTE, K_O12, K_ATTO, K_MERGE, K_OUTO };
constexpr int NPH = 25;
#define GEMM_CALL(EPI, g_, E_, off_) do { pg8::StaticOrder S_; S_.init((g_).M, (g_).N, (int)gridDim.x, (int)((blockIdx.x + (off_)) % gridDim.x)); \
    pg8::gemm_phase<EPI, pg8::StaticOrder, true, true>(lds, (g_), S_, (E_)); } while (0)

__global__ void __launch_bounds__(512, 2) mega(Args a) {
    extern __shared__ __attribute__((aligned(16))) unsigned char lds_raw[];
    LAS unsigned char* lds = (LAS unsigned char*)lds_raw;
    cg::grid_group grid = cg::this_grid();
    const int wv = __builtin_amdgcn_readfirstlane((int)threadIdx.x >> 6);
    const int G = gridDim.x, gw = blockIdx.x * 8 + wv, NGW = G * 8;
    KP P; unsigned char* ws = a.ws;
    P.out = a.out; P.ws = ws; P.pos = (const int*)a.in[1];
    LAS int* su = (LAS int*)(lds + LDS_BYTES - 64);
    volatile LAS unsigned* bst = (volatile LAS unsigned*)(lds + LDS_BYTES - 32);
    if (threadIdx.x < 2) bst[threadIdx.x] = 0u;
    __syncthreads();
    XcdBarrier bar = xcd_barrier_post((unsigned*)(a.ws + WS_CTL) + 4096, bst);

    if (a.ph_lo == 0) {
 p0_prologue(a, P, lds, threadIdx.x, gw, NGW);
#if PROBE_P0
 p0_prologue(a, P, lds, threadIdx.x, gw, NGW);
#endif
 if (a.ph_hi > 1) {
#if USE_XBAR
        if (a.ph_hi < 0) grid.sync();
        xcd_barrier(bar);
#else
        grid.sync();
#endif
    } }
#define IN(k) (((const float* const*)(P.ws + WS_PT))[k])
    for (int ph = (a.ph_lo == 0 ? 1 : a.ph_lo); ph < a.ph_hi; ++ph) {
        int tid = threadIdx.x; asm volatile("" : "+v"(tid));
        const int lane = tid & 63;
        { unsigned char* ws_i = a.ws; float* out_i = a.out; asm volatile("" : "+s"(ws_i), "+s"(out_i)); P.ws = ws_i; P.out = out_i; P.pos = (const int*)IN(1); }
        int kind, f = 0, lns = 0, layer = 0;
        switch (ph) {
            case 1: kind = K_F1; f = 0; break;  case 2: kind = K_F2; f = 0; break;  case 3: kind = K_LN; lns = 0; layer = 0; break;
            case 4: kind = K_E12; break; case 5: kind = K_SMALL; break; case 6: kind = K_E345; break; case 7: kind = K_C2; break; case 8: kind = K_ATTE; break; case 9: kind = K_OUTE; break;
            case 10: kind = K_LN; lns = 1; layer = 0; break;
            case 11: kind = K_F1; f = 1; break; case 12: kind = K_F2; f = 1; break; case 13: kind = K_LN; lns = 2; layer = 0; break;
            case 14: kind = K_F1; f = 2; break; case 15: kind = K_F2; f = 2; break; case 16: kind = K_LN; lns = 0; layer = 1; break;
            case 17: kind = K_O12; break; case 18: kind = K_ATTO; break; case 19: kind = K_MERGE; break; case 20: kind = K_OUTO; break;
            case 21: kind = K_LN; lns = 1; layer = 1; break;
            case 22: kind = K_F1; f = 3; break; case 23: kind = K_F2; f = 3; break; default: kind = K_LN; lns = 2; layer = 1; break;
        }
        if (kind == K_F1) {
            pg8::Gemm g{P.XB(), P.WB() + WE_GU + (size_t)f * 5632 * 1024, T, 5632, 1024, 1024, 1024, 128, 0}; EpiSwiglu E{P.H(), FF};
            GEMM_CALL(EpiSwiglu, g, E, 0);
#if PROBE_F1
            GEMM_CALL(EpiSwiglu, g, E, 0);
#endif
        }
        else if (kind == K_F2) {
            pg8::Gemm g{P.H(), P.WB() + WE_D + (size_t)f * 1024 * 2816, T, 1024, FF, FF, FF, 128, 0};
            if (f == 0) { EpiResidT<false> E{IN(0), P.out, P.ws, 0, 0, 0, DN_ALPHA, 0.5f}; GEMM_CALL(EpiResidT<false>, g, E, 0); }
            else {
#if PROBE_F2
                { EpiResidT<true> E{P.out, (float*)(P.ws + WS_R + 352 * MiB), P.ws, (f == 2 ? 26 : 21), (f == 2 ? 27 : 22), (f == 3 ? DM : 0), DN_ALPHA, 0.5f}; GEMM_CALL(EpiResidT<true>, g, E, 0); }
#endif
 EpiResidT<true> E{P.out, P.out, P.ws, (f == 2 ? 26 : 21), (f == 2 ? 27 : 22), (f == 3 ? DM : 0), DN_ALPHA, 0.5f}; GEMM_CALL(EpiResidT<true>, g, E, 0); }
        }
        else if (kind == K_OUTE) {
            pg8::Gemm g{P.OE(), P.WB() + WE_OE, T, 1024, 1024, 1024, 1024, 128, 0}; EpiResidT<true> E{P.out, P.out, P.ws, 2, 3, 0, DN_ALPHA, 1.f};
            GEMM_CALL(EpiResidT<true>, g, E, 0);
        }
        else if (kind == K_OUTO) {
            pg8::Gemm g{P.OO(), P.WB() + WE_OO, T, 1024, 512, 512, 512, 128, 0}; EpiResidT<true> E{P.out, P.out, P.ws, 2, 3, DM, DN_ALPHA, 1.f};
            GEMM_CALL(EpiResidT<true>, g, E, 0);
        }
        else if (kind == K_LN) {
            const float* gam = (lns == 0 ? IN(2) : (lns == 1 ? IN(21) : IN(26))) + layer * DM;
            const float* bet = (lns == 0 ? IN(3) : (lns == 1 ? IN(22) : IN(27))) + layer * DM;

#ifndef DIS_LN
 ln_pass(P, gam, bet, ph == NPH - 1, lane, gw, NGW);
#endif

        }
        else if (kind == K_SMALL) {
#ifndef DIS_SMALL
 small_pass(P, lane, gw, NGW);
#endif
 }
        else if (kind == K_MERGE) {
#ifndef DIS_MERGE
 merge_pass(P, lane, gw, NGW);
#endif
 }
        else if (kind == K_E12) {
            { pg8::Gemm g{P.XB(), P.WB() + WE_E1, T, 1792, 1024, 1024, 1024, 128, 0}; EpiStore E{P.HE(), HE_LD, nullptr, nullptr, nullptr, 0, 1792, T, 0, 0}; GEMM_CALL(EpiStore, g, E, 0); }
            { pg8::Gemm g{P.WB() + WE_E2, P.XB(), 256, T, 1024, 1024, 1024, 128, 0}; EpiStore E{P.VT(), T, nullptr, nullptr, nullptr, 0, T, 256, 0, 0}; GEMM_CALL(EpiStore, g, E, 0); }
        }
        else if (kind == K_E345) {
            for (int j = 0; j < 4; ++j) { const int kv = j >> 1, gg = j & 1;
                pg8::Gemm g{P.HE() + (kv ? HE_VC : HE_KC) + gg * 64, P.WB() + (kv ? WE_C1V : WE_C1K), 8192, 256, 2048, 16 * HE_LD, 2048, HE_LD * 2, 0};
                EpiStore E{P.HC() + (size_t)j * 8192 * 256, 256, nullptr, nullptr, P.CB() + kv * 256, 1, 256, 8192, 0, 0}; GEMM_CALL(EpiStore, g, E, 32 * j); }
            { pg8::Gemm g{P.HE() + HE_CQ, P.WB() + WE_UQ, T, 768, 384, HE_LD, 384, 128, 0}; EpiRopeQ E{P.QM(), 768, P.RSTD(), P.RT(), 0.10206207261596575f * LOG2E}; GEMM_CALL(EpiRopeQ, g, E, 128); }
            { pg8::Gemm g{P.HE() + HE_CKV, P.WB() + WE_UK, T, 512, 256, HE_LD, 256, 128, 0}; EpiStore E{P.KN(), 512, P.RSTD() + T, nullptr, nullptr, 0, 512, T, 0, 0}; GEMM_CALL(EpiStore, g, E, 128); }
            { pg8::Gemm g{P.WB() + WE_UV, P.HE() + HE_CKV, 512, T, 256, 256, HE_LD, 128, 0}; EpiStore E{P.VMT(), T, nullptr, P.RSTD() + T, nullptr, 0, T, 512, 0, 0}; GEMM_CALL(EpiStore, g, E, 128); }
        }
        else if (kind == K_C2) {
            for (int gg = 0; gg < 2; ++gg) { pg8::Gemm g{P.HC() + (size_t)gg * 8192 * 256, P.WB() + WE_C2K, 8192, 256, 256, 256, 256, 128, 0};
                EpiStore E{P.KCC() + gg * 64, 128, nullptr, nullptr, nullptr, 0, 64, 8192, 1, 0}; GEMM_CALL(EpiStore, g, E, 32 * gg); }
            for (int gg = 0; gg < 2; ++gg) { pg8::Gemm g{P.WB() + WE_C2V, P.HC() + (size_t)(2 + gg) * 8192 * 256, 256, 8192, 256, 256, 256, 128, 0};
                EpiStore E{P.VCT() + (size_t)gg * 64 * 8192, 8192, nullptr, nullptr, nullptr, 0, 8192, 64, 0, 1}; GEMM_CALL(EpiStore, g, E, 64 + 32 * gg); }
        }
        else if (kind == K_O12) {
            { pg8::Gemm g{P.XB(), P.WB() + WE_O1, T, 3072, 1024, 1024, 1024, 128, 0}; EpiStore E{P.QK(), 3072, nullptr, nullptr, nullptr, 0, 3072, T, 0, 0}; GEMM_CALL(EpiStore, g, E, 0); }
            for (int gg = 0; gg < 3; ++gg) { const int dil = gg == 0 ? 1 : (gg == 1 ? 4 : 16);
                pg8::Gemm g{P.WB() + WE_O2 + (size_t)gg * 512 * 1024, P.XB(), 512, T, 1024, 1024, dil * 1024, 128, dil};
                EpiStore E{P.VOT() + (size_t)gg * 512 * T, T, nullptr, nullptr, nullptr, 0, T, 512, 0, 0}; GEMM_CALL(EpiStore, g, E, 0); }
        }
        else if (kind == K_ATTE) {
            __syncthreads();
            const unsigned xq = bar.x & 7u;
            for (;;) {
                if (tid == 0) { int uu = -1;
                    for (unsigned k = 0; k < 8u && uu < 0; ++k) { const unsigned q = (xq + k) & 7u; const unsigned i = atomicAdd(&P.CTL()[16 + q], 1u); if (i < 512u) uu = (int)(q * 512u + i); }
                    *su = uu; }
                __syncthreads(); const int u = *su; __syncthreads();
                if (u < 0) break;
                const int q = u >> 9, i = u & 511;
                if (i < 256) { const int qb = 31 - (i >> 3), bh = q * 8 + (i & 7);
#ifndef DIS_MLA
 mla_unit(P, lds, bh >> 3, bh & 7, qb, tid);
#endif
 }
                else { const int j = i - 256, c = 127 - (j >> 1), bg = q * 2 + (j & 1);
#ifndef DIS_NSA
 nsa_unit(P, lds, bg >> 1, c, bg & 1, tid);
#endif
 }
            }
        }
        else if (kind == K_ATTO) {
            __syncthreads();
            const unsigned xq = bar.x & 7u;
            for (;;) {
                if (tid == 0) { int uu = -1;
                    for (unsigned k = 0; k < 8u && uu < 0; ++k) { const unsigned q = (xq + k) & 7u; const unsigned i = atomicAdd(&P.CTL()[32 + q], 1u); if (i < 384u) uu = (int)(q * 384u + i); }
                    *su = uu; }
                __syncthreads(); const int u = *su; __syncthreads();
                if (u < 0) break;
                const int rj = u & 31, rest = u >> 5, h = rest & 3, g = (rest >> 2) % 3, b = rest / 12;
#ifndef DIS_DIL
 dil_unit(P, lds, b, g, h, rj, tid);
#endif
            }
        }
        if (ph + 1 < a.ph_hi) {
#if USE_XBAR
            xcd_barrier(bar);
#else
            grid.sync();
#endif
        }
#if PROBE_SYNC
        if (ph + 1 < a.ph_hi) { grid.sync(); grid.sync(); }
#endif
    }
}

#ifndef ONE_LAUNCH_X
#define ONE_LAUNCH 1
#endif
extern "C" void kernel_launch(void* const* d_in, const int* in_sizes, int n_in, void* d_out, int out_size, void* d_ws, size_t ws_size, hipStream_t stream) {
    static int grid = 0;
    if (grid == 0) {
        if (n_in != 28 || ws_size < WS_NEED) { fprintf(stderr, "kernel_launch: unexpected n_in %d / ws %zu\n", n_in, ws_size); grid = -1; return; }
        int dev = 0, cus = 0, per_cu = 0;
        hipGetDevice(&dev); hipDeviceGetAttribute(&cus, hipDeviceAttributeMultiprocessorCount, dev);
        if (hipFuncSetAttribute((const void*)mega, hipFuncAttributeMaxDynamicSharedMemorySize, LDS_BYTES) != hipSuccess) { fprintf(stderr, "hipFuncSetAttribute failed\n"); grid = -1; return; }
        hipOccupancyMaxActiveBlocksPerMultiprocessor(&per_cu, (const void*)mega, 512, LDS_BYTES);
        if (per_cu < 1) per_cu = 1;
        grid = cus * 1;
        (void)hipGetLastError();
    }
    if (grid < 0) return;
    if (hipMemsetAsync((char*)d_ws + WS_CTL, 0, 65536, stream) != hipSuccess) { fprintf(stderr, "memset failed\n"); return; }
    Args a{};
    for (int i = 0; i < 28; ++i) a.in[i] = (const float*)d_in[i];
    a.out = (float*)d_out; a.ws = (unsigned char*)d_ws;
#if ONE_LAUNCH
    a.ph_lo = 0; a.ph_hi = NPH;
    void* args[] = {&a};
    hipError_t e = hipLaunchCooperativeKernel((const void*)mega, dim3(grid), dim3(512), args, LDS_BYTES, stream);
    if (e != hipSuccess) fprintf(stderr, "cooperative launch failed: %s (grid %d)\n", hipGetErrorString(e), grid);
#else
    for (int ph = 0; ph < NPH; ++ph) { a.ph_lo = ph; a.ph_hi = ph + 1; hipLaunchKernelGGL(mega, dim3(grid), dim3(512), LDS_BYTES, stream, a); }
#endif
}
```

```cpp
#include <hip/hip_runtime.h>
#include <hip/hip_cooperative_groups.h>
#include <cstdio>
#include <cstdint>
namespace cg = cooperative_groups;
namespace pg8 {
#define PG8_LAS __attribute__((address_space(3)))
typedef unsigned short bf16_t;
typedef short bf16x8 __attribute__((ext_vector_type(8)));
typedef float f32x4 __attribute__((ext_vector_type(4)));
typedef unsigned u32x4 __attribute__((ext_vector_type(4)));
constexpr int BM = 256, BK = 64, HALF = 128, HTB = HALF * BK * 2  , STAGE_BYTES = 8 * HTB, NXCD = 8, WGM = 8;

__host__ __device__ __forceinline__ int lds_byte(int r, int c) { const int st = (r >> 4) * 2 + (c >> 5), rr = r & 15, cc = c & 31, ob = rr * 64 + cc * 2; return st * 1024 + (ob ^ (((ob >> 9) & 1) << 5)); }
__host__ __device__ __forceinline__ void stage_rc(int b, int& R, int& C) { const int st = b / 1024, sb = b % 1024, swz = sb ^ (((sb >> 9) & 1) << 5); R = (st >> 1) * 16 + swz / 64; C = (st & 1) * 32 + (swz % 64) / 2; }
__host__ __device__ __forceinline__ int perm32(int rho) { const int n = rho >> 4, i = rho & 15; return 8 * (i >> 2) + 4 * n + (i & 3); }

struct Unit { int pm, pn; };
struct Gemm { const bf16_t* A; const bf16_t* Bt; int M, N, K; int lda, ldb, kstepA, bdil;
    __device__ __forceinline__ size_t aoff(int pm) const { return (size_t)pm * 256 * lda * 2; }
    __device__ __forceinline__ size_t boff(int pn) const {
        if (bdil == 0) return (size_t)pn * 256 * ldb * 2;
        const int per = 32 / bdil, b = pn >> 5, rem = pn & 31, r = rem / per, jt = rem % per;
        return ((size_t)b * 8192 + r + (size_t)bdil * 256 * jt) * 1024 * 2; } };

struct StaticOrder {
    int nM, nN, nwg, G, c;
    __host__ __device__ void init(int M, int N, int G_, int c_) { nM = M / BM; nN = N / BM; nwg = nM * nN; G = G_; c = c_; }
    __host__ __device__ bool next(int i, Unit& u) const {
        const long L = (long)i * G + c; if (L >= nwg) return false;
        int wgid = (int)L; { const int q = nwg / NXCD, r = nwg % NXCD, xcd = wgid % NXCD, off = wgid / NXCD; wgid = (xcd < r ? xcd * (q + 1) : r * (q + 1) + (xcd - r) * q) + off; }
        const int nig = WGM * nN, gid = wgid / nig, fm = gid * WGM, gsz = (nM - fm) < WGM ? (nM - fm) : WGM;
        u.pm = fm + ((wgid % nig) % gsz); u.pn = (wgid % nig) / gsz; return true;
    }
    __device__ __forceinline__ void a_ready(const Unit&) const {}
    __device__ __forceinline__ void done(const Unit&) const {}
};

__device__ __forceinline__ unsigned cvt_pk_bf16(float lo, float hi) { unsigned r; asm volatile("v_cvt_pk_bf16_f32 %0, %1, %2" : "=v"(r) : "v"(lo), "v"(hi)); return r; }
typedef float f32x2 __attribute__((ext_vector_type(2)));
template <class Epi, class Sched, bool ALIGN_EPI = false, bool SP2 = false>
__device__ __forceinline__ void gemm_phase(PG8_LAS unsigned char* lds, const Gemm g, const Sched& S, const Epi& E) {
    int tid_o = threadIdx.x; asm volatile("" : "+v"(tid_o)); const int tid = tid_o, wid = __builtin_amdgcn_readfirstlane(tid >> 6), lane = tid & 63, wr = wid >> 2, wc = wid & 3, fr = lane & 15, fq = lane >> 4;
    const int K = g.K, nt = K / BK;
    unsigned voffA[2], voffB[2];
#pragma unroll
    for (int i = 0; i < 2; ++i) { int R, C; stage_rc(tid * 16 + i * 8192, R, C); const int Rb = Epi::PERM ? ((R & ~31) + perm32(R & 31)) : R;
        voffA[i] = (unsigned)(R * g.lda + C) * 2u; voffB[i] = (unsigned)(Rb * g.ldb + C) * 2u; }
    const size_t kstepB = (size_t)(BK * 2), kstepA = (size_t)g.kstepA;
    const size_t hstepA = (size_t)HALF * g.lda * 2, hstepB = (size_t)HALF * g.ldb * 2;
    const unsigned ldsw = (unsigned)wid * 1024u;
    const int aoff = lds_byte(wr * 64 + fr, fq * 8), boff = lds_byte(wc * 32 + fr, fq * 8);
#define PG8_SA(b, h) (((b) * 2 + (h)) * HTB)
#define PG8_SB(b, h) ((4 + (b) * 2 + (h)) * HTB)
#define PG8_STAGE(bufoff, gbase, voff) do { _Pragma("unroll") for (int _i = 0; _i < 2; ++_i) \
        __builtin_amdgcn_global_load_lds((const unsigned*)((const char*)(gbase) + (voff)[_i]), (PG8_LAS unsigned*)(lds + (bufoff) + ldsw + _i * 8192), 16, 0, 0); } while (0)
#define PG8_LDA(dst, b, h) do { _Pragma("unroll") for (int m = 0; m < 4; ++m) _Pragma("unroll") for (int k = 0; k < 2; ++k) dst[m][k] = *(const PG8_LAS bf16x8*)(lds + PG8_SA(b, h) + aoff + m * 2048 + k * 1024); } while (0)
#define PG8_LDB(dst, b, h) do { _Pragma("unroll") for (int n = 0; n < 2; ++n) _Pragma("unroll") for (int k = 0; k < 2; ++k) dst[n][k] = *(const PG8_LAS bf16x8*)(lds + PG8_SB(b, h) + boff + n * 2048 + k * 1024); } while (0)
#define PG8_MMA(ai, bj, At, Bt) do { __builtin_amdgcn_s_setprio(1); _Pragma("unroll") for (int m = 0; m < 4; ++m) _Pragma("unroll") for (int n = 0; n < 2; ++n) _Pragma("unroll") for (int k = 0; k < 2; ++k) \
        acc[ai][bj][m][n] = __builtin_amdgcn_mfma_f32_16x16x32_bf16(Bt[n][k], At[m][k], acc[ai][bj][m][n], 0, 0, 0); __builtin_amdgcn_s_setprio(0); } while (0)
#define PG8_WAIT_V(n) asm volatile("s_waitcnt vmcnt(" #n ")" ::: "memory")
#define PG8_WAIT_L(n) asm volatile("s_waitcnt lgkmcnt(" #n ")" ::: "memory")
#define PG8_BAR __builtin_amdgcn_s_barrier()
#define PG8_SCHED __builtin_amdgcn_sched_barrier(0)
    Unit cur, nxt; int ui = 0;
    if (!S.next(0, cur)) return;
    f32x4 acc[2][2][4][2];
#pragma unroll
    for (int a = 0; a < 2; ++a)
#pragma unroll
        for (int b = 0; b < 2; ++b)
#pragma unroll
            for (int m = 0; m < 4; ++m)
#pragma unroll
                for (int n = 0; n < 2; ++n) acc[a][b][m][n] = (f32x4){0.f, 0.f, 0.f, 0.f};
    bf16x8 At[4][2], B0[2][2], B1[2][2];
    const char* cA = (const char*)g.A + g.aoff(cur.pm); const char* cB = (const char*)g.Bt + g.boff(cur.pn);
    S.a_ready(cur);
    if constexpr (SP2) {
        PG8_STAGE(PG8_SB(0, 0), cB, voffB); PG8_STAGE(PG8_SB(0, 1), cB + hstepB, voffB); PG8_STAGE(PG8_SA(0, 0), cA, voffA); PG8_STAGE(PG8_SA(0, 1), cA + hstepA, voffA);
        if (wr == 1) PG8_BAR;
        PG8_WAIT_V(2); PG8_BAR;
        PG8_STAGE(PG8_SB(1, 0), cB + kstepB, voffB); PG8_STAGE(PG8_SA(1, 0), cA + kstepA, voffA); PG8_STAGE(PG8_SB(1, 1), cB + hstepB + kstepB, voffB);
        PG8_WAIT_V(6); PG8_BAR;
    } else {
        PG8_STAGE(PG8_SB(0, 0), cB, voffB); PG8_STAGE(PG8_SA(0, 0), cA, voffA); PG8_STAGE(PG8_SB(0, 1), cB + hstepB, voffB); PG8_STAGE(PG8_SA(0, 1), cA + hstepA, voffA);
        if (wr == 1) PG8_BAR;
        PG8_WAIT_V(4); PG8_BAR;
        PG8_STAGE(PG8_SB(1, 0), cB + kstepB, voffB); PG8_STAGE(PG8_SA(1, 0), cA + kstepA, voffA); PG8_STAGE(PG8_SB(1, 1), cB + hstepB + kstepB, voffB);
        PG8_WAIT_V(6); PG8_BAR;
    }
    for (;;) {
        const bool has_next = S.next(ui + 1, nxt);
        const char* nA = has_next ? (const char*)g.A + g.aoff(nxt.pm) : cA; const char* nB = has_next ? (const char*)g.Bt + g.boff(nxt.pn) : cB;
        _Pragma("clang loop unroll(disable)") for (int t = 0; t < nt; t += 2) {
            const bool last = (t == nt - 2);
            const char* a1 = cA + (size_t)(t + 1) * kstepA;
            const char* a2 = last ? nA : cA + (size_t)(t + 2) * kstepA; const char* b2 = last ? nB : cB + (size_t)(t + 2) * kstepB;
            const char* a3 = a2 + kstepA; const char* b3 = b2 + kstepB;
            if (last && has_next) S.a_ready(nxt);
            if constexpr (SP2) {
            PG8_LDB(B0, 0, 0); PG8_LDB(B1, 0, 1); PG8_SCHED; PG8_LDA(At, 0, 0); PG8_STAGE(PG8_SA(1, 1), a1 + hstepA, voffA);
            PG8_WAIT_V(8); PG8_WAIT_L(0); PG8_BAR; PG8_MMA(0, 0, At, B0); PG8_MMA(0, 1, At, B1); PG8_BAR; PG8_SCHED;
            PG8_LDA(At, 0, 1); PG8_STAGE(PG8_SB(0, 0), b2, voffB); PG8_STAGE(PG8_SB(0, 1), b2 + hstepB, voffB); PG8_STAGE(PG8_SA(0, 0), a2, voffA);
            PG8_WAIT_V(8); PG8_WAIT_L(0); PG8_BAR; PG8_MMA(1, 0, At, B0); PG8_MMA(1, 1, At, B1); PG8_BAR; PG8_SCHED;
            PG8_LDB(B0, 1, 0); PG8_LDB(B1, 1, 1); PG8_SCHED; PG8_LDA(At, 1, 0); PG8_STAGE(PG8_SA(0, 1), a2 + hstepA, voffA);
            PG8_WAIT_V(8); PG8_WAIT_L(0); PG8_BAR; PG8_MMA(0, 0, At, B0); PG8_MMA(0, 1, At, B1); PG8_BAR; PG8_SCHED;
            PG8_LDA(At, 1, 1); PG8_STAGE(PG8_SB(1, 0), b3, voffB); PG8_STAGE(PG8_SB(1, 1), b3 + hstepB, voffB); PG8_STAGE(PG8_SA(1, 0), a3, voffA);
            PG8_WAIT_V(8); PG8_WAIT_L(0); PG8_BAR; PG8_MMA(1, 0, At, B0); PG8_MMA(1, 1, At, B1); PG8_BAR; PG8_SCHED;
            } else {
            PG8_LDB(B0, 0, 0); PG8_SCHED; PG8_LDA(At, 0, 0); PG8_STAGE(PG8_SA(1, 1), a1 + hstepA, voffA);
            PG8_WAIT_L(8); PG8_BAR; PG8_WAIT_L(0); PG8_MMA(0, 0, At, B0); PG8_BAR; PG8_SCHED;
            PG8_LDB(B1, 0, 1); PG8_STAGE(PG8_SB(0, 0), b2, voffB);
            PG8_BAR; PG8_WAIT_L(0); PG8_MMA(0, 1, At, B1); PG8_BAR;
            PG8_LDA(At, 0, 1); PG8_STAGE(PG8_SA(0, 0), a2, voffA);
            PG8_BAR; PG8_WAIT_L(0); PG8_MMA(1, 0, At, B0); PG8_BAR; PG8_SCHED;
            PG8_STAGE(PG8_SB(0, 1), b2 + hstepB, voffB);
            PG8_WAIT_V(6); PG8_BAR; PG8_MMA(1, 1, At, B1); PG8_BAR;
            PG8_LDB(B0, 1, 0); PG8_SCHED; PG8_LDA(At, 1, 0); PG8_STAGE(PG8_SA(0, 1), a2 + hstepA, voffA);
            PG8_WAIT_L(8); PG8_BAR; PG8_WAIT_L(0); PG8_MMA(0, 0, At, B0); PG8_BAR; PG8_SCHED;
            PG8_LDB(B1, 1, 1); PG8_STAGE(PG8_SB(1, 0), b3, voffB);
            PG8_BAR; PG8_WAIT_L(0); PG8_MMA(0, 1, At, B1); PG8_BAR;
            PG8_LDA(At, 1, 1); PG8_STAGE(PG8_SA(1, 0), a3, voffA);
            PG8_BAR; PG8_WAIT_L(0); PG8_MMA(1, 0, At, B0); PG8_BAR; PG8_SCHED;
            PG8_STAGE(PG8_SB(1, 1), b3 + hstepB, voffB);
            PG8_WAIT_V(6); PG8_BAR; PG8_MMA(1, 1, At, B1); PG8_BAR;
            }
        }
        if constexpr (ALIGN_EPI) { if (wr == 0) PG8_BAR; }
        if constexpr (!Epi::AFTER_DRAIN) { E(acc, cur, wr, wc, fr, fq); S.done(cur); }
        if (!has_next) break;
#pragma unroll
        for (int a = 0; a < 2; ++a)
#pragma unroll
            for (int b = 0; b < 2; ++b)
#pragma unroll
                for (int m = 0; m < 4; ++m)
#pragma unroll
                    for (int n = 0; n < 2; ++n) acc[a][b][m][n] = (f32x4){0.f, 0.f, 0.f, 0.f};
        cur = nxt; cA = nA; cB = nB; ++ui;
        if constexpr (ALIGN_EPI) { if (wr == 1) PG8_BAR; }
    }
    PG8_WAIT_V(0);
    if constexpr (!ALIGN_EPI) { if (wr == 0) PG8_BAR; }
    PG8_BAR;
    if constexpr (Epi::AFTER_DRAIN) { E.fused(acc, cur, wr, wc, fr, fq, lds, wid, lane); S.done(cur); }
#undef PG8_SA
#undef PG8_SB
#undef PG8_STAGE
#undef PG8_LDA
#undef PG8_LDB
#undef PG8_MMA
#undef PG8_WAIT_V
#undef PG8_WAIT_L
#undef PG8_BAR
#undef PG8_SCHED
}
}
#define LAS __attribute__((address_space(3)))
typedef unsigned short bf16;
using pg8::f32x4; using pg8::bf16x8; using pg8::u32x4; using pg8::Unit; using pg8::cvt_pk_bf16;
typedef float f32x16 __attribute__((ext_vector_type(16)));
typedef unsigned u32x2 __attribute__((ext_vector_type(2)));
typedef short s16x4 __attribute__((ext_vector_type(4)));

constexpr int NB = 8, SEQ = 8192, T = NB * SEQ, DM = 1024, FF = 2816;
constexpr int HE_LD = 1792;
constexpr int HE_CQ = 0, HE_CKV = 384, HE_KPE = 640, HE_Q = 672, HE_KC = 1184, HE_VC = 1312, HE_KS = 1440, HE_KW = 1568, HE_GT = 1696;
constexpr float LOG2E = 1.4426950408889634f;
constexpr float DN_ALPHA = 1.4142135623730951f;
constexpr float NEGB = -1e30f;

constexpr size_t MiB = 1u << 20;
constexpr size_t WS_CTL = 0;
constexpr size_t WS_W = 1 * MiB;
constexpr size_t WS_PT = 256 * 1024;
constexpr size_t WS_ST = 512 * 1024;
constexpr size_t WE_GU = 0;
constexpr size_t WE_D = WE_GU + 4ull * 5632 * 1024;
constexpr size_t WE_E1 = WE_D + 4ull * 1024 * 2816;
constexpr size_t WE_E2 = WE_E1 + 1792ull * 1024;
constexpr size_t WE_UQ = WE_E2 + 256ull * 1024;
constexpr size_t WE_UK = WE_UQ + 768ull * 384;
constexpr size_t WE_UV = WE_UK + 512ull * 256;
constexpr size_t WE_C1K = WE_UV + 512ull * 256;
constexpr size_t WE_C1V = WE_C1K + 256ull * 2048;
constexpr size_t WE_C2K = WE_C1V + 256ull * 2048;
constexpr size_t WE_C2V = WE_C2K + 256ull * 256;
constexpr size_t WE_OE = WE_C2V + 256ull * 256;
constexpr size_t WE_O1 = WE_OE + 1024ull * 1024;
constexpr size_t WE_O2 = WE_O1 + 3072ull * 1024;
constexpr size_t WE_OO = WE_O2 + 1536ull * 1024;
constexpr size_t WE_END = WE_OO + 1024ull * 512;
static_assert(WE_END * 2 <= 95 * MiB, "weights fit");
constexpr size_t WS_CB = 96 * MiB;
constexpr size_t WS_XB = 97 * MiB;
constexpr size_t WS_R = 225 * MiB;
constexpr size_t R_H = WS_R;
constexpr size_t R_HE = WS_R;
constexpr size_t R_VT = WS_R + 224 * MiB;
constexpr size_t R_QM = WS_R + 256 * MiB;
constexpr size_t R_KN = WS_R + 352 * MiB;
constexpr size_t R_VMT = WS_R + 416 * MiB;
constexpr size_t R_OE = WS_R + 480 * MiB;
constexpr size_t R_KROT = WS_R + 608 * MiB;
constexpr size_t R_RT = WS_R + 612 * MiB;
constexpr size_t R_GT = WS_R + 620 * MiB;
constexpr size_t R_RSTD = WS_R + 628 * MiB;
constexpr size_t R_HC = WS_R + 629 * MiB;
constexpr size_t R_KCC = WS_R + 645 * MiB;
constexpr size_t R_VCT = WS_R + 647 * MiB;
constexpr size_t R_QK = WS_R;
constexpr size_t R_VOT = WS_R + 384 * MiB;
constexpr size_t R_OG = WS_R + 576 * MiB;
constexpr size_t R_LSE = WS_R + 768 * MiB;
constexpr size_t R_OO = WS_R;
constexpr size_t WS_NEED = WS_R + 772 * MiB;
static_assert(WS_NEED <= 1024 * MiB, "ws");

constexpr int LDS_BYTES = 147456;

__device__ __forceinline__ float fast_exp2(float x) { return __builtin_amdgcn_exp2f(x); }
__device__ __forceinline__ float fast_rcp(float x) { return __builtin_amdgcn_rcpf(x); }
__device__ __forceinline__ float bf2f(bf16 v) { return __uint_as_float(((unsigned)v) << 16); }
__device__ __forceinline__ float wave_sum(float v) {
#pragma unroll
    for (int o = 1; o < 64; o <<= 1) v += __shfl_xor(v, o);
    return v;
}

struct EpiStore {
    static constexpr bool PERM = true, AFTER_DRAIN = false;
    bf16* O; int ldc; const float* rscale; const float* cscale; const float* bias; int act; int ncv; int nrv; int zrow; int zcol;
    __device__ __forceinline__ void operator()(const f32x4 (&acc)[2][2][4][2], const Unit& u, int wr, int wc, int fr, int fq) const {
#pragma unroll
        for (int bj = 0; bj < 2; ++bj) {
            const int col = u.pn * 256 + bj * 128 + wc * 32 + 8 * fq;
            if (col < ncv) {
                float cs[8], bs[8];
#pragma unroll
                for (int e = 0; e < 8; ++e) { cs[e] = cscale ? cscale[col + e] : 1.f; bs[e] = bias ? bias[col + e] : 0.f; }
#pragma unroll
                for (int ai = 0; ai < 2; ++ai)
#pragma unroll
                    for (int m = 0; m < 4; ++m) {
                        const int row = u.pm * 256 + ai * 128 + wr * 64 + m * 16 + fr;
                        if (row < nrv) {
                            const float rs = rscale ? rscale[row] : 1.f;
                            const f32x4 v0 = acc[ai][bj][m][0], v1 = acc[ai][bj][m][1];
                            float v[8] = {v0[0], v0[1], v0[2], v0[3], v1[0], v1[1], v1[2], v1[3]};
                            const bool zr = zrow && ((row & 511) == 511);
#pragma unroll
                            for (int e = 0; e < 8; ++e) {
                                float x = v[e] + bs[e];
                                if (act == 1) { const float y = 0.7978845608028654f * (x + 0.044715f * x * x * x); x = x * fast_rcp(1.f + fast_exp2(-2.f * LOG2E * y)); }
                                x *= rs * cs[e];
                                if (zr || (zcol && (((col + e) & 511) == 511))) x = 0.f;
                                v[e] = x;
                            }
                            u32x4 w; w.x = cvt_pk_bf16(v[0], v[1]); w.y = cvt_pk_bf16(v[2], v[3]); w.z = cvt_pk_bf16(v[4], v[5]); w.w = cvt_pk_bf16(v[6], v[7]);
                            *(u32x4*)(O + (size_t)row * ldc + col) = w;
                        }
                    }
            }
        }
    }
};
struct EpiSwiglu {
    static constexpr bool PERM = true, AFTER_DRAIN = false;
    bf16* H; int ldh;
    __device__ __forceinline__ void operator()(const f32x4 (&acc)[2][2][4][2], const Unit& u, int wr, int wc, int fr, int fq) const {
        const int col = u.pn * 128 + wc * 32 + 8 * fq;
#pragma unroll
        for (int ai = 0; ai < 2; ++ai)
#pragma unroll
            for (int m = 0; m < 4; ++m) {
                const int row = u.pm * 256 + ai * 128 + wr * 64 + m * 16 + fr;
                const f32x4 g0 = acc[ai][0][m][0], g1 = acc[ai][0][m][1], u0 = acc[ai][1][m][0], u1 = acc[ai][1][m][1];
                float g[8] = {g0[0], g0[1], g0[2], g0[3], g1[0], g1[1], g1[2], g1[3]};
                float uu[8] = {u0[0], u0[1], u0[2], u0[3], u1[0], u1[1], u1[2], u1[3]};
#pragma unroll
                for (int e = 0; e < 8; ++e) g[e] = g[e] * fast_rcp(1.f + fast_exp2(-LOG2E * g[e])) * uu[e];
                u32x4 w; w.x = cvt_pk_bf16(g[0], g[1]); w.y = cvt_pk_bf16(g[2], g[3]); w.z = cvt_pk_bf16(g[4], g[5]); w.w = cvt_pk_bf16(g[6], g[7]);
                *(u32x4*)(H + (size_t)row * ldh + col) = w;
            }
    }
};
template <bool LN>
struct EpiResidT {
    static constexpr bool PERM = true, AFTER_DRAIN = false;
    const float* Xin; float* Xout; unsigned char* ws; int gi, bi, goff; float alpha, beta;
    __device__ __forceinline__ void operator()(const f32x4 (&acc)[2][2][4][2], const Unit& u, int wr, int wc, int fr, int fq) const {
        constexpr int ldx = 1024;
        const float* st = (const float*)(ws + WS_ST); const float* gam = nullptr; const float* bet = nullptr;
        if (LN) { const float* const* PT = (const float* const*)(ws + WS_PT); gam = PT[gi] + goff; bet = PT[bi] + goff; }
#pragma unroll
        for (int bj = 0; bj < 2; ++bj) {
            const int col = u.pn * 256 + bj * 128 + wc * 32 + 8 * fq;
            f32x4 g0, g1, b0, b1;
            if (LN) { g0 = *(const f32x4*)(gam + col); g1 = *(const f32x4*)(gam + col + 4); b0 = *(const f32x4*)(bet + col); b1 = *(const f32x4*)(bet + col + 4); }
#pragma unroll
            for (int ai = 0; ai < 2; ++ai) {
                f32x4 x0[4], x1[4]; float mean[4], rstd[4];
#pragma unroll
                for (int m = 0; m < 4; ++m) {
                    const int row = u.pm * 256 + ai * 128 + wr * 64 + m * 16 + fr;
                    const size_t off = (size_t)row * ldx + col;
                    x0[m] = *(const f32x4*)(Xin + off); x1[m] = *(const f32x4*)(Xin + off + 4);
                    if (LN) { mean[m] = st[2 * row]; rstd[m] = st[2 * row + 1]; }
                }
#pragma unroll
                for (int m = 0; m < 4; ++m) {
                    const int row = u.pm * 256 + ai * 128 + wr * 64 + m * 16 + fr;
                    const size_t off = (size_t)row * ldx + col;
                    f32x4 a0 = x0[m], a1 = x1[m];
                    if (LN) { a0 = (a0 - mean[m]) * rstd[m] * g0 + b0; a1 = (a1 - mean[m]) * rstd[m] * g1 + b1; }
                    *(f32x4*)(Xout + off) = a0 * alpha + acc[ai][bj][m][0] * beta;
                    *(f32x4*)(Xout + off + 4) = a1 * alpha + acc[ai][bj][m][1] * beta;
                }
            }
        }
    }
};
struct EpiRopeQ {
    static constexpr bool PERM = true, AFTER_DRAIN = false;
    bf16* Q; int ldq; const float* rstd; const float* RT; float qscale;
    __device__ __forceinline__ void operator()(const f32x4 (&acc)[2][2][4][2], const Unit& u, int wr, int wc, int fr, int fq) const {
#pragma unroll
        for (int bj = 0; bj < 2; ++bj) {
            const int grp = u.pn * 8 + bj * 4 + wc; const bool is_rope = (grp % 3) == 2;
            const int col = u.pn * 256 + bj * 128 + wc * 32 + 8 * fq;
#pragma unroll
            for (int ai = 0; ai < 2; ++ai)
#pragma unroll
                for (int m = 0; m < 4; ++m) {
                    const int row = u.pm * 256 + ai * 128 + wr * 64 + m * 16 + fr;
                    const float rs = rstd[row] * qscale;
                    f32x4 v0 = acc[ai][bj][m][0] * rs, v1 = acc[ai][bj][m][1] * rs;
                    if (is_rope) {
                        const f32x4 c01 = *(const f32x4*)(RT + (size_t)row * 32 + 8 * fq), c23 = *(const f32x4*)(RT + (size_t)row * 32 + 8 * fq + 4);
                        const float cs[4] = {c01[0], c01[2], c23[0], c23[2]}, sn[4] = {c01[1], c01[3], c23[1], c23[3]};
                        f32x4 o1, o2;
#pragma unroll
                        for (int e = 0; e < 4; ++e) { o1[e] = v0[e] * cs[e] - v1[e] * sn[e]; o2[e] = v1[e] * cs[e] + v0[e] * sn[e]; }
                        v0 = o1; v1 = o2;
                    }
                    u32x4 w; w.x = cvt_pk_bf16(v0[0], v0[1]); w.y = cvt_pk_bf16(v0[2], v0[3]); w.z = cvt_pk_bf16(v1[0], v1[1]); w.w = cvt_pk_bf16(v1[2], v1[3]);
                    *(u32x4*)(Q + (size_t)row * ldq + col) = w;
                }
        }
    }
};
#define XB_TMO      128
#define XB_XCNT(j)  (256  + 64 * (j))
#define XB_XSUB(j)  (1280 + 64 * (j))
#define XB_XGEN(j)  (2304 + 64 * (j))
#define XB_TOP      3328
#define XB_TOPGEN   3392
#define XCD_BAR_WORDS 3456
#define XB_SPIN_CAP (1u << 18)

__device__ __forceinline__ unsigned xb_ld(unsigned* p)              { return __hip_atomic_load(p, __ATOMIC_RELAXED, __HIP_MEMORY_SCOPE_AGENT); }
__device__ __forceinline__ unsigned xb_add(unsigned* p, unsigned v) { return __hip_atomic_fetch_add(p, v, __ATOMIC_RELAXED, __HIP_MEMORY_SCOPE_AGENT); }
__device__ __forceinline__ unsigned xb_xcc_id() { return (unsigned)__builtin_amdgcn_s_getreg((3 << 11) | 20) & 0xFu; }
#define XB_SPIN(cond, bar) do { unsigned _sp = 0; while (cond) { __builtin_amdgcn_s_sleep(1); \
    if ((++_sp & 255u) == 0u) { if (xb_ld(&(bar)[XB_TMO])) break; if (_sp > XB_SPIN_CAP) { atomicAdd(&(bar)[XB_TMO], 1u); break; } } } } while (0)

struct XcdBarrier {
    unsigned* bar; unsigned x;
    volatile LAS unsigned* st;
};

__device__ __forceinline__ XcdBarrier xcd_barrier_post(unsigned* bar, volatile LAS unsigned* st) {
    XcdBarrier b; b.bar = bar; b.x = xb_xcc_id(); b.st = st;
    if (threadIdx.x == 0) (void)xb_add(&bar[XB_XCNT(b.x)], 1u);
    return b;
}
__device__ __forceinline__ void xcd_barrier_complete(unsigned* bar, unsigned x, unsigned& nloc, unsigned& nx) {
    const unsigned G = gridDim.x * gridDim.y * gridDim.z;
    unsigned sum, cnt, mine, sp = 0u;
    for (;;) {
        sum = 0u; cnt = 0u; mine = 0u;
#pragma unroll
        for (unsigned j = 0; j < 16; ++j) { const unsigned c = xb_ld(&bar[XB_XCNT(j)]); sum += c; cnt += (c > 0u) ? 1u : 0u; mine = (j == x) ? c : mine; }
        if (sum == G) break;
        __builtin_amdgcn_s_sleep(1);
        if ((++sp & 255u) == 0u) { if (xb_ld(&bar[XB_TMO])) break; if (sp > XB_SPIN_CAP) { atomicAdd(&bar[XB_TMO], 1u); break; } }
    }
    nloc = mine > 0u ? mine : 1u; nx = cnt > 0u ? cnt : 1u;
}

__device__ __forceinline__ void xcd_barrier(const XcdBarrier& b) {
    asm volatile("s_waitcnt vmcnt(0)" ::: "memory");
    __syncthreads();
    if (threadIdx.x == 0) {
        unsigned* bar = b.bar;
        __builtin_amdgcn_s_waitcnt(0);
        unsigned nloc = b.st[0], nx = b.st[1];
        if (nloc == 0u) { xcd_barrier_complete(bar, b.x, nloc, nx); b.st[0] = nloc; b.st[1] = nx; }
        const unsigned old = xb_add(&bar[XB_XSUB(b.x)], 1u);
        const unsigned gen = old / nloc;
        if (old + 1u == (gen + 1u) * nloc) {
            __builtin_amdgcn_fence(__ATOMIC_RELEASE, "agent");
            asm volatile("s_waitcnt vmcnt(0)" ::: "memory");
            const unsigned og = xb_add(&bar[XB_TOP], 1u);
            const unsigned tg = og / nx;
            if (og + 1u == (tg + 1u) * nx) xb_add(&bar[XB_TOPGEN], 1u);
            else XB_SPIN(xb_ld(&bar[XB_TOPGEN]) == tg, bar);
            __builtin_amdgcn_fence(__ATOMIC_ACQUIRE, "agent");
            xb_add(&bar[XB_XGEN(b.x)], 1u);
            asm volatile("s_waitcnt vmcnt(0)" ::: "memory");
        } else {
            XB_SPIN(xb_ld(&bar[XB_XGEN(b.x)]) == gen, bar);
            __builtin_amdgcn_fence(__ATOMIC_ACQUIRE, "agent");
            asm volatile("s_waitcnt vmcnt(0)" ::: "memory");
        }
    }
    __syncthreads();
}
constexpr float RESC_THR = 6.f;
struct KP {
    float* out; unsigned char* ws; const int* pos;
    __device__ __forceinline__ const int* pos_local() const { int one = 1; asm volatile("" : "+s"(one)); return (const int*)(((const float* const*)(ws + WS_PT))[one]); }
#define KP_ACC(T_, NAME, OFF) __device__ __forceinline__ T_* NAME() const { return (T_*)(ws + (OFF)); }
    KP_ACC(bf16, WB, WS_W) KP_ACC(bf16, XB, WS_XB) KP_ACC(bf16, H, R_H) KP_ACC(bf16, HE, R_HE) KP_ACC(bf16, VT, R_VT) KP_ACC(bf16, QM, R_QM)
    KP_ACC(bf16, KN, R_KN) KP_ACC(bf16, VMT, R_VMT) KP_ACC(bf16, OE, R_OE) KP_ACC(bf16, KROT, R_KROT) KP_ACC(bf16, HC, R_HC) KP_ACC(bf16, KCC, R_KCC)
    KP_ACC(bf16, VCT, R_VCT) KP_ACC(bf16, QK, R_QK) KP_ACC(bf16, VOT, R_VOT) KP_ACC(bf16, OG, R_OG) KP_ACC(bf16, OO, R_OO)
    KP_ACC(float, RT, R_RT) KP_ACC(float, GT, R_GT) KP_ACC(float, RSTD, R_RSTD) KP_ACC(float, LSE, R_LSE) KP_ACC(float, CB, WS_CB) KP_ACC(unsigned, CTL, WS_CTL)
};

__device__ __forceinline__ int crow(int v, int hi) { return (v & 3) + 8 * (v >> 2) + 4 * hi; }
__device__ __forceinline__ float xhalf_max(float x) { auto rr = __builtin_amdgcn_permlane32_swap(__float_as_uint(x), __float_as_uint(x), false, false); return fmaxf(__uint_as_float(rr[0]), __uint_as_float(rr[1])); }
__device__ __forceinline__ float xhalf_sum(float x) { auto rr = __builtin_amdgcn_permlane32_swap(__float_as_uint(x), __float_as_uint(x), false, false); return __uint_as_float(rr[0]) + __uint_as_float(rr[1]); }
__device__ __forceinline__ float max16(const f32x16& s) {
    float a = fmaxf(fmaxf(s[0], s[1]), s[2]), b = fmaxf(fmaxf(s[3], s[4]), s[5]);
    a = fmaxf(fmaxf(a, s[6]), s[7]); b = fmaxf(fmaxf(b, s[8]), s[9]); a = fmaxf(fmaxf(a, s[10]), s[11]); b = fmaxf(fmaxf(b, s[12]), s[13]);
    return fmaxf(fmaxf(a, b), fmaxf(s[14], s[15])); }

template <int DK16>
__device__ __forceinline__ f32x16 qk_sub(const LAS unsigned char* Kt, int ks, int sub, const bf16x8 (&qf)[DK16], int r32, int hi) {
    f32x16 s;
#pragma unroll
    for (int v = 0; v < 16; ++v) s[v] = 0.f;
    const LAS unsigned char* p = Kt + (sub * 32 + r32) * ks + hi * 16;
#pragma unroll
    for (int dk = 0; dk < DK16; ++dk) { const bf16x8 kf = *(const LAS bf16x8*)(p + dk * 32); s = __builtin_amdgcn_mfma_f32_32x32x16_bf16(kf, qf[dk], s, 0, 0, 0); }
    return s;
}
template <int DV32>
__device__ __forceinline__ void pv_sub(f32x16 (&o)[DV32], const LAS unsigned char* Vt, int vs, int sub, const f32x16& p, int r32, int hi) {
#pragma unroll
    for (int kb = 0; kb < 2; ++kb) {
        u32x4 pw; pw.x = cvt_pk_bf16(p[8 * kb + 0], p[8 * kb + 1]); pw.y = cvt_pk_bf16(p[8 * kb + 2], p[8 * kb + 3]); pw.z = cvt_pk_bf16(p[8 * kb + 4], p[8 * kb + 5]); pw.w = cvt_pk_bf16(p[8 * kb + 6], p[8 * kb + 7]);
        const bf16x8 pf = __builtin_bit_cast(bf16x8, pw);
#pragma unroll
        for (int i = 0; i < DV32; ++i) {
            const bf16x8 vf = *(const LAS bf16x8*)(Vt + (32 * i + r32) * vs + sub * 64 + kb * 32 + hi * 16);
            o[i] = __builtin_amdgcn_mfma_f32_32x32x16_bf16(vf, pf, o[i], 0, 0, 0);
        }
    }
}
template <int DV32>
__device__ __forceinline__ void pv_packed(f32x16 (&o)[DV32], const LAS unsigned char* Vt, int vs, int sub, const u32x4& pk0, const u32x4& pk1, int r32, int hi) {
#pragma unroll
    for (int kb = 0; kb < 2; ++kb) {
        const bf16x8 pf = __builtin_bit_cast(bf16x8, kb == 0 ? pk0 : pk1);
#pragma unroll
        for (int i = 0; i < DV32; ++i) {
            const bf16x8 vf = *(const LAS bf16x8*)(Vt + (32 * i + r32) * vs + sub * 64 + kb * 32 + hi * 16);
            o[i] = __builtin_amdgcn_mfma_f32_32x32x16_bf16(vf, pf, o[i], 0, 0, 0);
        }
    }
}
__device__ __forceinline__ u32x4 pack8(const f32x16& p, int kb) {
    u32x4 pw; pw.x = cvt_pk_bf16(p[8 * kb + 0], p[8 * kb + 1]); pw.y = cvt_pk_bf16(p[8 * kb + 2], p[8 * kb + 3]); pw.z = cvt_pk_bf16(p[8 * kb + 4], p[8 * kb + 5]); pw.w = cvt_pk_bf16(p[8 * kb + 6], p[8 * kb + 7]); return pw; }
template <int D, int DV, int MODE, bool HASBIAS, bool JOINT, bool DEFER, class KA, class VA, class PF, class BF, class VF, class NM, class WS, class CB>
__device__ __forceinline__ void fa_loop(LAS unsigned char* lds, int nt, const KA& ka, const VA& va, const PF& pf, const BF& bf, const VF& vf, const NM& nm, const WS& wskip, const CB& cb, float c1,
                                        const bf16x8 (&qf)[D / 16], float& m, float& l, f32x16 (&o)[DV / 32], int tid_in, int r32, int hi) {
    int tid = tid_in; asm volatile("" : "+v"(tid));
    constexpr int KS = D * 2 + 16, VS = 144, KCH = D / 8, NKR = (64 * KCH + 511) / 512, NVR = (DV * 8) / 512, NVS = DEFER ? 3 : 2, KOFF = 0, VOFF = 2 * 64 * KS, POFF = VOFF + NVS * DV * VS;
    constexpr bool NEEDV = (MODE != 1);
    u32x4 kregA[NKR], kregB[NKR]; u32x4 vregA[NVR], vregB[NVR]; float pregA = 0.f, pregB = 0.f;
    if (nt <= 0) return;
    if (__builtin_amdgcn_readfirstlane(tid_in) >= 256) __builtin_amdgcn_s_setprio(1);
#define FA_LOAD(t_, KR, VR, PR) do { \
    _Pragma("unroll") for (int r_ = 0; r_ < NKR; ++r_) { const int idx_ = tid + 512 * r_; if (idx_ < 64 * KCH) { const int row_ = idx_ / KCH, ch_ = idx_ % KCH; KR[r_] = *(const u32x4*)ka((t_), row_, ch_); } } \
    if (NEEDV) { _Pragma("unroll") for (int r_ = 0; r_ < NVR; ++r_) { const int idx_ = tid + 512 * r_; const int d_ = idx_ >> 3, ch_ = idx_ & 7; VR[r_] = *(const u32x4*)va((t_), d_, ch_); } } \
    if (HASBIAS) { if (tid < 64) PR = pf((t_), tid); } } while (0)
#define FA_STORE(tt_, KR, VR, PR) do { LAS unsigned char* kb_ = lds + KOFF + ((tt_) & 1) * (64 * KS); LAS unsigned char* vb_ = lds + VOFF + ((tt_) % NVS) * (DV * VS); \
    _Pragma("unroll") for (int r_ = 0; r_ < NKR; ++r_) { const int idx_ = tid + 512 * r_; if (idx_ < 64 * KCH) { const int row_ = idx_ / KCH, ch_ = idx_ % KCH; *(LAS u32x4*)(kb_ + row_ * KS + ch_ * 16) = KR[r_]; } } \
    if (NEEDV) { _Pragma("unroll") for (int r_ = 0; r_ < NVR; ++r_) { const int idx_ = tid + 512 * r_; const int d_ = idx_ >> 3, ch_ = idx_ & 7; LAS unsigned char* q_ = vb_ + d_ * VS + (ch_ >> 2) * 64 + ((ch_ & 2) << 4) + ((ch_ & 1) << 3); *(LAS u32x2*)q_ = (u32x2){VR[r_].x, VR[r_].y}; *(LAS u32x2*)(q_ + 16) = (u32x2){VR[r_].z, VR[r_].w}; } } \
    if (HASBIAS) { if (tid < 64) *(LAS float*)(lds + POFF + ((tt_) & 1) * 256 + tid * 4) = PR; } } while (0)
    const bool defer_wave = DEFER && (tid_in >= 256);
    u32x4 pp0 = {0u, 0u, 0u, 0u}, pp1 = pp0, pp2 = pp0, pp3 = pp0; int pend = -1;
    auto compute = [&](int t, int bufi) __attribute__((always_inline)) {
        const LAS unsigned char* cur = lds + KOFF + (t & 1) * (64 * KS);
        const int vslot = t % NVS; const LAS unsigned char* curv = lds + VOFF + vslot * (DV * VS);
        const LAS float* kp = (const LAS float*)(lds + POFF + (t & 1) * 256);
        if (DEFER) { if (pend >= 0) { const LAS unsigned char* pv_ = lds + VOFF + pend * (DV * VS); pv_packed<DV / 32>(o, pv_, VS, 0, pp0, pp1, r32, hi); pv_packed<DV / 32>(o, pv_, VS, 1, pp2, pp3, r32, hi); pend = -1; } }
        const bool sk0 = wskip(t, 0), sk1 = wskip(t, 1);
        if (JOINT && MODE != 2 && !sk0 && !sk1) {
            f32x16 s0 = qk_sub<D / 16>(cur, KS, 0, qf, r32, hi); if (DEFER) __builtin_amdgcn_sched_barrier(0); f32x16 s1 = qk_sub<D / 16>(cur, KS, 1, qf, r32, hi);
            if (HASBIAS) {
#pragma unroll
                for (int a4 = 0; a4 < 4; ++a4) { const int kin0 = 8 * a4 + 4 * hi; const f32x4 kq0 = *(const LAS f32x4*)(kp + kin0), kq1 = *(const LAS f32x4*)(kp + 32 + kin0);
#pragma unroll
                    for (int e = 0; e < 4; ++e) { s0[4 * a4 + e] = s0[4 * a4 + e] * c1 + bf(t, kin0 + e, kq0[e]); s1[4 * a4 + e] = s1[4 * a4 + e] * c1 + bf(t, 32 + kin0 + e, kq1[e]); } }
            }
            const bool masked = nm(t, 0) || nm(t, 1);
            if (masked) {
#pragma unroll
                for (int v = 0; v < 16; ++v) { const int kin = crow(v, hi); if (!vf(t, kin)) s0[v] = NEGB; if (!vf(t, 32 + kin)) s1[v] = NEGB; }
            }
            float mx = xhalf_max(fmaxf(max16(s0), max16(s1)));
            const bool grow = __any(mx > m + RESC_THR);
            const float mn = grow ? fmaxf(m, mx) : m; float sum0 = 0.f, sum1 = 0.f;
            if (masked) {
#pragma unroll
                for (int v = 0; v < 16; ++v) { const float p0 = s0[v] > -1e29f ? fast_exp2(s0[v] - mn) : 0.f, p1 = s1[v] > -1e29f ? fast_exp2(s1[v] - mn) : 0.f; s0[v] = p0; s1[v] = p1; sum0 += p0; sum1 += p1; }
            } else {
#pragma unroll
                for (int v = 0; v < 16; ++v) { const float p0 = fast_exp2(s0[v] - mn), p1 = fast_exp2(s1[v] - mn); s0[v] = p0; s1[v] = p1; sum0 += p0; sum1 += p1; }
            }
            if (grow) {
                const float alpha = fast_exp2(m - mn); l *= alpha;
                if (MODE == 0) {
#pragma unroll
                    for (int i = 0; i < DV / 32; ++i)
#pragma unroll
                        for (int v = 0; v < 16; ++v) o[i][v] *= alpha;
                }
            }
            l += sum0 + sum1; m = mn;
            if (MODE == 0) {
                if (defer_wave) { pp0 = pack8(s0, 0); pp1 = pack8(s0, 1); pp2 = pack8(s1, 0); pp3 = pack8(s1, 1); pend = vslot; }
                else { pv_sub<DV / 32>(o, curv, VS, 0, s0, r32, hi); pv_sub<DV / 32>(o, curv, VS, 1, s1, r32, hi); }
            }
        } else
#pragma unroll
        for (int sub = 0; sub < 2; ++sub) {
            if (!wskip(t, sub)) {
                f32x16 s = qk_sub<D / 16>(cur, KS, sub, qf, r32, hi);
                if (HASBIAS) {
#pragma unroll
                    for (int a4 = 0; a4 < 4; ++a4) { const int kin0 = sub * 32 + 8 * a4 + 4 * hi; const f32x4 kq = *(const LAS f32x4*)(kp + kin0);
#pragma unroll
                        for (int e = 0; e < 4; ++e) s[4 * a4 + e] = s[4 * a4 + e] * c1 + bf(t, kin0 + e, kq[e]); }
                }
                const bool masked = nm(t, sub);
                if (masked) {
#pragma unroll
                    for (int v = 0; v < 16; ++v) { const int kin = sub * 32 + crow(v, hi); if (!vf(t, kin)) s[v] = NEGB; }
                }
                if (MODE == 2) {
                    if (masked) {
#pragma unroll
                        for (int v = 0; v < 16; ++v) s[v] = s[v] > -1e29f ? fast_exp2(s[v] - m) * l : 0.f;
                    } else {
#pragma unroll
                        for (int v = 0; v < 16; ++v) s[v] = fast_exp2(s[v] - m) * l;
                    }
                    cb(t, sub, s);
                    pv_sub<DV / 32>(o, curv, VS, sub, s, r32, hi);
                } else {
                    float mx0 = fmaxf(fmaxf(s[0], s[1]), s[2]), mx1 = fmaxf(fmaxf(s[3], s[4]), s[5]);
                    mx0 = fmaxf(fmaxf(mx0, s[6]), s[7]); mx1 = fmaxf(fmaxf(mx1, s[8]), s[9]); mx0 = fmaxf(fmaxf(mx0, s[10]), s[11]); mx1 = fmaxf(fmaxf(mx1, s[12]), s[13]);
                    float mx = fmaxf(fmaxf(mx0, mx1), fmaxf(s[14], s[15]));
                    mx = xhalf_max(mx);
                    const bool grow = __any(mx > m + RESC_THR);
                    const float mn = grow ? fmaxf(m, mx) : m; float sum = 0.f;
                    if (masked) {
#pragma unroll
                        for (int v = 0; v < 16; ++v) { const float p = s[v] > -1e29f ? fast_exp2(s[v] - mn) : 0.f; s[v] = p; sum += p; }
                    } else {
#pragma unroll
                        for (int v = 0; v < 16; ++v) { const float p = fast_exp2(s[v] - mn); s[v] = p; sum += p; }
                    }
                    if (grow) {
                        const float alpha = fast_exp2(m - mn); l *= alpha;
                        if (MODE == 0) {
#pragma unroll
                            for (int i = 0; i < DV / 32; ++i)
#pragma unroll
                                for (int v = 0; v < 16; ++v) o[i][v] *= alpha;
                        }
                    }
                    l += sum; m = mn;
                    if (MODE == 0) pv_sub<DV / 32>(o, curv, VS, sub, s, r32, hi);
                }
            }
        }
    };
    if (DEFER) {
        FA_LOAD(0, kregA, vregA, pregA); FA_STORE(0, kregA, vregA, pregA); __syncthreads();
        for (int t = 0; t < nt; ++t) {
            asm volatile("" : "+v"(tid));
            if (t + 1 < nt) FA_LOAD(t + 1, kregA, vregA, pregA);
            compute(t, 0);
            asm volatile("" : "+v"(tid));
            if (t + 1 < nt) FA_STORE(t + 1, kregA, vregA, pregA);
            __syncthreads();
        }
    } else {
    FA_LOAD(0, kregA, vregA, pregA); FA_STORE(0, kregA, vregA, pregA); if (nt > 1) FA_LOAD(1, kregB, vregB, pregB); __syncthreads();
    for (int t = 0; t < nt; t += 2) {
        if (t + 2 < nt) FA_LOAD(t + 2, kregA, vregA, pregA);
        compute(t, 0);
        if (t + 1 < nt) FA_STORE(t + 1, kregB, vregB, pregB);
        __syncthreads();
        if (t + 1 < nt) {
            if (t + 3 < nt) FA_LOAD(t + 3, kregB, vregB, pregB);
            compute(t + 1, 1);
            if (t + 2 < nt) FA_STORE(t + 2, kregA, vregA, pregA);
            __syncthreads();
        }
    }
    }
    if (DEFER) { if (pend >= 0) { const LAS unsigned char* pv_ = lds + VOFF + pend * (DV * VS); pv_packed<DV / 32>(o, pv_, VS, 0, pp0, pp1, r32, hi); pv_packed<DV / 32>(o, pv_, VS, 1, pp2, pp3, r32, hi); }
        __syncthreads(); }
    __builtin_amdgcn_s_setprio(0);
#undef FA_LOAD
#undef FA_STORE
}
template <int NV>
__device__ __forceinline__ void store_o(bf16* op, const f32x16 (&o)[NV], float sc, int hi) {
#pragma unroll
    for (int i = 0; i < NV; ++i)
#pragma unroll
        for (int a = 0; a < 4; ++a) {
            u32x2 wv; wv.x = cvt_pk_bf16(o[i][4 * a] * sc, o[i][4 * a + 1] * sc); wv.y = cvt_pk_bf16(o[i][4 * a + 2] * sc, o[i][4 * a + 3] * sc);
            *(u32x2*)(op + 32 * i + 8 * a + 4 * hi) = wv;
        }
}
struct NoCb { __device__ __forceinline__ void operator()(int, int, const f32x16&) const {} };

__device__ __forceinline__ void mla_unit(const KP& P, LAS unsigned char* lds, int b, int h, int qb, int tid_u) {
    int tid = tid_u; asm volatile("" : "+v"(tid));
    const int* const posp = P.pos_local();
    const int lane = tid & 63, w = __builtin_amdgcn_readfirstlane(tid >> 6), r32 = lane & 31, hi = lane >> 5;
    const int q0 = qb * 256, tq = q0 + 32 * w + r32; const size_t bS = (size_t)b * SEQ, tok = bS + tq;
    bf16x8 qf[6];
#pragma unroll
    for (int dk = 0; dk < 6; ++dk) qf[dk] = *(const bf16x8*)(P.QM() + tok * 768 + h * 96 + dk * 16 + hi * 8);
    const int nt = (q0 + 256) / 64;
    auto ka = [&](int t, int row, int ch) -> const bf16* { const size_t tk = bS + 64 * t + row; return ch < 8 ? P.KN() + tk * 512 + h * 64 + ch * 8 : P.KROT() + tk * 32 + (ch - 8) * 8; };
    auto va = [&](int t, int d, int ch) -> const bf16* { return P.VMT() + (size_t)(h * 64 + d) * T + bS + 64 * t + ch * 8; };
    auto pf = [&](int, int) -> float { return 0.f; };
    auto bf = [&](int, int, float) -> float { return 0.f; };
    auto vf = [&](int t, int kin) -> bool { return 64 * t + kin <= tq; };
    const int wq_lo = q0 + 32 * w, wq_hi = wq_lo + 31;
    auto nm = [&](int t, int sub) -> bool { return 64 * t + 32 * sub + 31 > wq_lo; };
    auto ws = [&](int t, int sub) -> bool { return 64 * t + 32 * sub > wq_hi; };
    float m = NEGB, l = 0.f; f32x16 o[2];
#pragma unroll
    for (int i = 0; i < 2; ++i)
#pragma unroll
        for (int v = 0; v < 16; ++v) o[i][v] = 0.f;
    fa_loop<96, 64, 0, false, true, false>(lds, nt, ka, va, pf, bf, vf, nm, ws, NoCb(), 1.f, qf, m, l, o, tid, r32, hi);
    l = xhalf_sum(l); const float inv = l > 0.f ? 1.f / l : 0.f;
    store_o<2>(P.OE() + tok * 1024 + h * 64, o, inv, hi);
}

constexpr int NSA_GL = 40960, NSA_SELM = NSA_GL + 8 * 2 * 8 * 132 * 4, NSA_BU = NSA_SELM + 1024, NSA_TL = NSA_BU + 32;
__device__ __forceinline__ void nsa_unit(const KP& P, LAS unsigned char* lds, int b, int c, int g, int tid_u) {
    int tid = tid_u; asm volatile("" : "+v"(tid));
    const int* const posp = P.pos_local();
    const int lane = tid & 63, w = __builtin_amdgcn_readfirstlane(tid >> 6), r32 = lane & 31, hi = lane >> 5;
    const int n = r32 >> 3, qi = r32 & 7, hh = g * 4 + n;
    const int tq = 64 * c + 8 * w + qi; const size_t bS = (size_t)b * SEQ, tok = bS + tq;
    const float slope2 = fast_exp2(-(float)(hh + 1)) * LOG2E, c1 = 0.125f * LOG2E;
    const float pq = (float)posp[tok], nbq = -slope2 * pq;
    bf16x8 qf[4];
#pragma unroll
    for (int dk = 0; dk < 4; ++dk) qf[dk] = *(const bf16x8*)(P.HE() + tok * HE_LD + HE_Q + hh * 64 + dk * 16 + hi * 8);
    LAS float* GLw = (LAS float*)(lds + NSA_GL) + w * (2 * 8 * 132);
    LAS unsigned long long* SELM = (LAS unsigned long long*)(lds + NSA_SELM);
    LAS unsigned* BU = (LAS unsigned*)(lds + NSA_BU);
    LAS int* TL = (LAS int*)(lds + NSA_TL);
    for (int i = tid; i < 8 * 2 * 8 * 132; i += 512) ((LAS float*)(lds + NSA_GL))[i] = 0.f;
    if (tid < 8) BU[tid] = 0u;
    __syncthreads();
    const int wq_lo = 64 * c + 8 * w, wq_hi = wq_lo + 7;
    f32x16 o[2];
#pragma unroll
    for (int i = 0; i < 2; ++i)
#pragma unroll
        for (int v = 0; v < 16; ++v) o[i][v] = 0.f;
    LAS float* stash = (LAS float*)(lds + NSA_GL) + tid;
    {
        const int nt1 = (4 * c + 3 + 63) >> 6;
        auto ka1 = [&](int t, int row, int ch) -> const bf16* { return P.KCC() + ((size_t)b * 512 + 64 * t + row) * 128 + g * 64 + ch * 8; };
        auto va1 = [&](int t, int d, int ch) -> const bf16* { return P.VCT() + (size_t)(g * 64 + d) * 8192 + b * 512 + 64 * t + ch * 8; };
        auto pf1 = [&](int t, int i) -> float { int j = 64 * t + i; j = j > 510 ? 510 : j; return (float)posp[bS + 31 + 16 * j]; };
        auto bf1 = [&](int, int, float kp) -> float { return kp * slope2 + nbq; };
        auto vf1 = [&](int t, int kin) -> bool { const int j = 64 * t + kin; return 16 * j + 31 <= tq; };
        auto nm1 = [&](int t, int sub) -> bool { return 16 * (64 * t + 32 * sub + 31) + 31 > wq_lo; };
        auto ws1 = [&](int t, int sub) -> bool { return 16 * (64 * t + 32 * sub) + 31 > wq_hi; };
        float m1 = NEGB, l1 = 0.f;
        fa_loop<64, 64, 1, true, false, false>(lds, nt1, ka1, va1, pf1, bf1, vf1, nm1, ws1, NoCb(), c1, qf, m1, l1, o, tid, r32, hi);
        l1 = xhalf_sum(l1); float invl = l1 > 0.f ? 1.f / l1 : 0.f;
        auto cb1 = [&](int t, int sub, const f32x16& p) {
#pragma unroll
            for (int a = 0; a < 4; ++a) {
                float gsum = (p[4 * a] + p[4 * a + 1]) + (p[4 * a + 2] + p[4 * a + 3]), last = p[4 * a + 3];
                gsum += __shfl_xor(gsum, 8); gsum += __shfl_xor(gsum, 16); last += __shfl_xor(last, 8); last += __shfl_xor(last, 16);
                const int u = (64 * t + 32 * sub) / 4 + 2 * a + hi;
                if (r32 < 8) { GLw[qi * 132 + u] = gsum; GLw[8 * 132 + qi * 132 + u + 1] = last; }
            }
        };
        fa_loop<64, 64, 2, true, false, false>(lds, nt1, ka1, va1, pf1, bf1, vf1, nm1, ws1, cb1, c1, qf, m1, invl, o, tid, r32, hi);
        const float gtc = P.GT()[tok * 24 + hh];
#pragma unroll
        for (int i = 0; i < 2; ++i)
#pragma unroll
            for (int v = 0; v < 16; ++v) o[i][v] *= gtc;
    }
    unsigned long long wu0 = 0ull, wu1 = 0ull;
    {
        const int ncand = c - 1 > 0 ? c - 1 : 0, need = 16 - (c == 0 ? 1 : 2);
        for (int q = 0; q < 8; ++q) {
            const int s0 = lane, s1 = lane + 64;
            const bool c0 = (s0 >= 1) && (s0 <= c - 1), cc1 = (s1 <= c - 1);
            const float f0 = c0 ? GLw[q * 132 + s0] + GLw[8 * 132 + q * 132 + s0] : 0.f;
            const float f1 = cc1 ? GLw[q * 132 + s1] + GLw[8 * 132 + q * 132 + s1] : 0.f;
            const unsigned b0 = __float_as_uint(f0), b1 = __float_as_uint(f1);
            unsigned long long sel0, sel1;
            if (ncand <= need) { sel0 = __ballot(c0); sel1 = __ballot(cc1); }
            else {
                unsigned x = 0u;
                for (int bit = 30; bit >= 0; --bit) {
                    const unsigned tt = x | (1u << bit);
                    const int cnt = __popcll(__ballot(c0 && b0 >= tt)) + __popcll(__ballot(cc1 && b1 >= tt));
                    if (cnt >= need) x = tt;
                }
                sel0 = __ballot(c0 && b0 > x); sel1 = __ballot(cc1 && b1 > x);
                int rem = need - (__popcll(sel0) + __popcll(sel1));
                unsigned long long e0 = __ballot(c0 && b0 == x), e1 = __ballot(cc1 && b1 == x);
                while (rem > 0 && e0) { const unsigned long long low = e0 & (~e0 + 1ull); sel0 |= low; e0 ^= low; --rem; }
                while (rem > 0 && e1) { const unsigned long long low = e1 & (~e1 + 1ull); sel1 |= low; e1 ^= low; --rem; }
            }
            sel0 |= 1ull; if (c < 64) sel0 |= 1ull << c; else sel1 |= 1ull << (c - 64);
            if (lane == 0) { SELM[(w * 8 + q) * 2] = sel0; SELM[(w * 8 + q) * 2 + 1] = sel1; }
            wu0 |= sel0; wu1 |= sel1;
        }
        if (lane == 0) { atomicOr((unsigned*)&BU[0], (unsigned)wu0); atomicOr((unsigned*)&BU[1], (unsigned)(wu0 >> 32)); atomicOr((unsigned*)&BU[2], (unsigned)wu1); atomicOr((unsigned*)&BU[3], (unsigned)(wu1 >> 32)); }
    }
    __syncthreads();
#pragma unroll
    for (int i = 0; i < 2; ++i)
#pragma unroll
        for (int v = 0; v < 16; ++v) { stash[(i * 16 + v) * 512] = o[i][v]; o[i][v] = 0.f; }
    if (tid < 128) {
        const unsigned u0 = BU[0], u1 = BU[1], u2 = BU[2], u3 = BU[3];
        const int k = tid >> 5; const unsigned wk = k == 0 ? u0 : (k == 1 ? u1 : (k == 2 ? u2 : u3));
        if ((wk >> (tid & 31)) & 1u) {
            int pos = __popc(wk & ((1u << (tid & 31)) - 1u));
            if (k > 0) pos += __popc(u0); if (k > 1) pos += __popc(u1); if (k > 2) pos += __popc(u2);
            TL[pos] = tid;
        }
        if (tid == 0) BU[4] = __popc(u0) + __popc(u1) + __popc(u2) + __popc(u3);
    }
    __syncthreads();
    const unsigned long long ms0 = SELM[(w * 8 + qi) * 2], ms1 = SELM[(w * 8 + qi) * 2 + 1];
    {
        const int nsel = (int)BU[4];
        auto ka2 = [&](int t, int row, int ch) -> const bf16* { const int sb = TL[t]; return P.HE() + (bS + 64 * sb + row) * HE_LD + HE_KS + g * 64 + ch * 8; };
        auto va2 = [&](int t, int d, int ch) -> const bf16* { const int sb = TL[t]; return P.VT() + (size_t)(g * 64 + d) * T + bS + 64 * sb + ch * 8; };
        auto pf2 = [&](int t, int i) -> float { const int sb = TL[t]; return (float)posp[bS + 64 * sb + i]; };
        auto bf2 = [&](int, int, float kp) -> float { return kp * slope2 + nbq; };
        auto vf2 = [&](int t, int kin) -> bool { const int sb = TL[t]; const bool selb = (((sb < 64 ? ms0 : ms1) >> (sb & 63)) & 1ull) != 0ull; return selb && (64 * sb + kin <= tq); };
        auto nm2 = [&](int t, int) -> bool { const int sb = TL[t]; const bool selb = (((sb < 64 ? ms0 : ms1) >> (sb & 63)) & 1ull) != 0ull; return sb == c || !__all(selb); };
        auto ws2 = [&](int t, int) -> bool { const int sb = TL[t]; return (((sb < 64 ? wu0 : wu1) >> (sb & 63)) & 1ull) == 0ull; };
        float m2 = NEGB, l2 = 0.f;
        fa_loop<64, 64, 0, true, false, false>(lds, nsel, ka2, va2, pf2, bf2, vf2, nm2, ws2, NoCb(), c1, qf, m2, l2, o, tid, r32, hi);
        l2 = xhalf_sum(l2); const float gts = P.GT()[tok * 24 + 8 + hh]; const float sc = l2 > 0.f ? gts / l2 : 0.f;
#pragma unroll
        for (int i = 0; i < 2; ++i)
#pragma unroll
            for (int v = 0; v < 16; ++v) { stash[(i * 16 + v) * 512] += o[i][v] * sc; o[i][v] = 0.f; }
    }
    {
        const int first = c < 8 ? 8 - c : 0, nt3 = 9 - first, base3 = 64 * c - 512 + 64 * first;
        auto ka3 = [&](int t, int row, int ch) -> const bf16* { return P.HE() + (bS + base3 + 64 * t + row) * HE_LD + HE_KW + g * 64 + ch * 8; };
        auto va3 = [&](int t, int d, int ch) -> const bf16* { return P.VT() + (size_t)(128 + g * 64 + d) * T + bS + base3 + 64 * t + ch * 8; };
        auto pf3 = [&](int t, int i) -> float { return (float)posp[bS + base3 + 64 * t + i]; };
        auto bf3 = [&](int, int, float kp) -> float { return kp * slope2 + nbq; };
        auto vf3 = [&](int t, int kin) -> bool { const int df = tq - (base3 + 64 * t + kin); return df >= 0 && df < 512; };
        auto nm3 = [&](int t, int sub) -> bool { const int k0 = base3 + 64 * t + 32 * sub; return k0 + 31 > wq_lo || k0 < wq_hi - 511; };
        auto ws3 = [&](int t, int sub) -> bool { const int k0 = base3 + 64 * t + 32 * sub; return k0 > wq_hi || k0 + 31 < wq_lo - 511; };
        float m3 = NEGB, l3 = 0.f;
        fa_loop<64, 64, 0, true, false, false>(lds, nt3, ka3, va3, pf3, bf3, vf3, nm3, ws3, NoCb(), c1, qf, m3, l3, o, tid, r32, hi);
        l3 = xhalf_sum(l3); const float gtw = P.GT()[tok * 24 + 16 + hh]; const float sc = l3 > 0.f ? gtw / l3 : 0.f;
#pragma unroll
        for (int i = 0; i < 2; ++i)
#pragma unroll
            for (int v = 0; v < 16; ++v) o[i][v] = o[i][v] * sc + stash[(i * 16 + v) * 512];
    }
    store_o<2>(P.OE() + tok * 1024 + 512 + hh * 64, o, 1.f, hi);
}

__device__ __forceinline__ void dil_unit(const KP& P, LAS unsigned char* lds, int b, int g, int h, int rj, int tid_u) {
    int tid = tid_u; asm volatile("" : "+v"(tid));
    const int* const posp = P.pos_local();
    const int lane = tid & 63, w = __builtin_amdgcn_readfirstlane(tid >> 6), r32 = lane & 31, hi = lane >> 5;
    const int dil = g == 0 ? 1 : (g == 1 ? 4 : 16), per = 32 / dil, r = rj / per, jt = rj % per, clen = SEQ / dil;
    const int J = 256 * jt + 32 * w + r32; const size_t bS = (size_t)b * SEQ, tok = bS + r + dil * J;
    const float slope2 = fast_exp2(-8.f * (float)(g * 4 + h + 1) / 12.f) * LOG2E, c1 = 0.08838834764831845f * LOG2E;
    const float pq = (float)posp[tok], nbq = -slope2 * pq;
    bf16x8 qf[8];
#pragma unroll
    for (int dk = 0; dk < 8; ++dk) qf[dk] = *(const bf16x8*)(P.QK() + tok * 3072 + g * 512 + h * 128 + dk * 16 + hi * 8);
    const int first = jt == 0 ? 2 : 0, nt = 6 - first, I00 = 256 * jt - 128 + 64 * first;
    auto ka = [&](int t, int row, int ch) -> const bf16* { return P.QK() + (bS + r + (size_t)dil * (I00 + 64 * t + row)) * 3072 + 1536 + g * 512 + h * 128 + ch * 8; };
    auto va = [&](int t, int d, int ch) -> const bf16* { return P.VOT() + (size_t)(g * 512 + h * 128 + d) * T + bS + (size_t)r * clen + I00 + 64 * t + ch * 8; };
    auto pf = [&](int t, int i) -> float { return (float)posp[bS + r + dil * (I00 + 64 * t + i)]; };
    auto bf = [&](int, int, float kp) -> float { return kp * slope2 + nbq; };
    auto vf = [&](int t, int kin) -> bool { const int df = J - (I00 + 64 * t + kin); return df >= 0 && df <= 128; };
    const int Jw = 256 * jt + 32 * w;
    auto nm = [&](int t, int sub) -> bool { const int i0 = I00 + 64 * t + 32 * sub; return i0 + 31 > Jw || i0 < Jw + 31 - 128; };
    auto ws = [&](int t, int sub) -> bool { const int i0 = I00 + 64 * t + 32 * sub; return i0 > Jw + 31 || i0 + 31 < Jw - 128; };
    float m = NEGB, l = 0.f; f32x16 o[4];
#pragma unroll
    for (int i = 0; i < 4; ++i)
#pragma unroll
        for (int v = 0; v < 16; ++v) o[i][v] = 0.f;
    fa_loop<128, 128, 0, true, false, false>(lds, nt, ka, va, pf, bf, vf, nm, ws, NoCb(), c1, qf, m, l, o, tid, r32, hi);
    l = xhalf_sum(l); const float inv = l > 0.f ? 1.f / l : 0.f;
    store_o<4>(P.OG() + ((size_t)g * T + tok) * 512 + h * 128, o, inv, hi);
    if (hi == 0) P.LSE()[((size_t)g * T + tok) * 4 + h] = m + __log2f(l);
}
struct Args { const float* in[28]; float* out; unsigned char* ws; int ph_lo, ph_hi; };

enum { WM_ID = 0, WM_SWIGLU = 1, WM_E1 = 2, WM_E2 = 3, WM_UQ = 4 };
struct WSpec { const float* W; const float* W2; const float* gk; bf16* WT; int K, Nsrc, Ndst, mode, soff, nvalid; };
__device__ __forceinline__ void transpose_item(const WSpec& s, LAS float* scr, int item, int lane) {
    const int nblk = s.Ndst / 32, kb = item / nblk, nb = item % nblk, k0 = 128 * kb, n0 = 32 * nb;
    const int R = n0 + (lane & 31); int sc; const float* Wp = s.W;
    if (s.mode == WM_ID) sc = R < s.nvalid ? R + s.soff : -1;
    else if (s.mode == WM_SWIGLU) { sc = (R >> 8) * 128 + (R & 127); if ((R >> 7) & 1) Wp = s.W2; }
    else if (s.mode == WM_E1) sc = R < 1568 ? R : (R < 1696 ? R + 128 : (R < 1720 ? R + 256 : -1));
    else if (s.mode == WM_E2) sc = R < 128 ? 1568 + R : 1824 + (R - 128);
    else { const int h = R / 96, wq = R % 96; if (wq < 64) sc = R; else { const int p = wq - 64, fq = p >> 3, sub = p & 7; sc = 96 * h + 64 + (sub < 4 ? 4 * fq + sub : 16 + 4 * fq + (sub - 4)); } }
    if (s.mode != WM_UQ) {
        const int c4 = (lane & 7) * 4, R4 = n0 + c4; int sc4; const float* Wq = s.W;
        if (s.mode == WM_ID) sc4 = R4 < s.nvalid ? R4 + s.soff : -1;
        else if (s.mode == WM_SWIGLU) { sc4 = (R4 >> 8) * 128 + (R4 & 127); if ((R4 >> 7) & 1) Wq = s.W2; }
        else if (s.mode == WM_E1) sc4 = R4 < 1568 ? R4 : (R4 < 1696 ? R4 + 128 : (R4 < 1720 ? R4 + 256 : -1));
        else sc4 = R4 < 128 ? 1568 + R4 : 1824 + (R4 - 128);
        const float msk = sc4 >= 0 ? 1.f : 0.f; const int sc4c = sc4 >= 0 ? sc4 : 0;
        f32x4 vv[16];
#pragma unroll
        for (int i = 0; i < 16; ++i) { const int kk = 8 * i + (lane >> 3); vv[i] = *(const f32x4*)(Wq + (size_t)(k0 + kk) * s.Nsrc + sc4c); }
        if (s.gk) {
#pragma unroll
            for (int i = 0; i < 16; ++i) { const int kk = 8 * i + (lane >> 3); vv[i] = vv[i] * s.gk[k0 + kk]; }
        }
#pragma unroll
        for (int i = 0; i < 16; ++i) { const int kk = 8 * i + (lane >> 3); const f32x4 v = vv[i] * msk;
            scr[kk * 33 + c4] = v[0]; scr[kk * 33 + c4 + 1] = v[1]; scr[kk * 33 + c4 + 2] = v[2]; scr[kk * 33 + c4 + 3] = v[3]; }
    } else {
        float vs[64];
#pragma unroll
        for (int i = 0; i < 64; ++i) { const int kk = 2 * i + (lane >> 5); vs[i] = Wp[(size_t)(k0 + kk) * s.Nsrc + sc]; }
#pragma unroll
        for (int i = 0; i < 64; ++i) { const int kk = 2 * i + (lane >> 5); scr[kk * 33 + (lane & 31)] = vs[i] * s.gk[k0 + kk]; }
    }
    asm volatile("s_waitcnt lgkmcnt(0)" ::: "memory");
    const int c = lane & 15;
#pragma unroll
    for (int j = 0; j < 8; ++j) { const int nn = (lane >> 4) + 4 * j; const LAS float* sp = scr + (8 * c) * 33 + nn;
        u32x4 o; o.x = cvt_pk_bf16(sp[0 * 33], sp[1 * 33]); o.y = cvt_pk_bf16(sp[2 * 33], sp[3 * 33]); o.z = cvt_pk_bf16(sp[4 * 33], sp[5 * 33]); o.w = cvt_pk_bf16(sp[6 * 33], sp[7 * 33]);
        *(u32x4*)(s.WT + (size_t)(n0 + nn) * s.K + k0 + 8 * c) = o; }
    asm volatile("s_waitcnt lgkmcnt(0)" ::: "memory");
}
__device__ __forceinline__ const float* ffn_w(const Args& a, int f, int which) {
    const int L = f >> 1; const bool second = (f & 1) != 0;
    const float* base = which == 0 ? (second ? a.in[23] : a.in[4]) : (which == 1 ? (second ? a.in[24] : a.in[5]) : (second ? a.in[25] : a.in[6]));
    return base + (size_t)L * 1024 * 2816;
}
__device__ __forceinline__ void p0_prologue(const Args& a, const KP& P, LAS unsigned char* lds, int tid, int gw, int NGW) {
    const int lane = tid & 63, w = tid >> 6;
    LAS float* scr = (LAS float*)(lds + w * 17408);
    int cum = 0;
    for (int wi = 0; wi < 21; ++wi) {
        WSpec s; s.W2 = nullptr; s.gk = nullptr; s.mode = WM_ID; s.soff = 0;
        if (wi < 4) { s.W = ffn_w(a, wi, 0); s.W2 = ffn_w(a, wi, 1); s.K = 1024; s.Nsrc = 2816; s.Ndst = 5632; s.mode = WM_SWIGLU; s.WT = P.WB() + WE_GU + (size_t)wi * 5632 * 1024; }
        else if (wi < 8) { s.W = ffn_w(a, wi - 4, 2); s.K = 2816; s.Nsrc = 1024; s.Ndst = 1024; s.WT = P.WB() + WE_D + (size_t)(wi - 4) * 1024 * 2816; }
        else if (wi == 8) { s.W = a.in[7]; s.K = 1024; s.Nsrc = 1976; s.Ndst = 1792; s.mode = WM_E1; s.WT = P.WB() + WE_E1; }
        else if (wi == 9) { s.W = a.in[7]; s.K = 1024; s.Nsrc = 1976; s.Ndst = 256; s.mode = WM_E2; s.WT = P.WB() + WE_E2; }
        else if (wi == 10) { s.W = a.in[10]; s.gk = a.in[8]; s.K = 384; s.Nsrc = 768; s.Ndst = 768; s.mode = WM_UQ; s.WT = P.WB() + WE_UQ; }
        else if (wi == 11) { s.W = a.in[11]; s.gk = a.in[9]; s.K = 256; s.Nsrc = 512; s.Ndst = 512; s.WT = P.WB() + WE_UK; }
        else if (wi == 12) { s.W = a.in[12]; s.gk = a.in[9]; s.K = 256; s.Nsrc = 512; s.Ndst = 512; s.WT = P.WB() + WE_UV; }
        else if (wi == 13) { s.W = a.in[14]; s.K = 2048; s.Nsrc = 256; s.Ndst = 256; s.WT = P.WB() + WE_C1K; }
        else if (wi == 14) { s.W = a.in[16]; s.K = 2048; s.Nsrc = 256; s.Ndst = 256; s.WT = P.WB() + WE_C1V; }
        else if (wi == 15) { s.W = a.in[15]; s.K = 256; s.Nsrc = 64; s.Ndst = 256; s.WT = P.WB() + WE_C2K; }
        else if (wi == 16) { s.W = a.in[17]; s.K = 256; s.Nsrc = 64; s.Ndst = 256; s.WT = P.WB() + WE_C2V; }
        else if (wi == 17) { s.W = a.in[18]; s.K = 1024; s.Nsrc = 1024; s.Ndst = 1024; s.WT = P.WB() + WE_OE; }
        else if (wi == 18) { s.W = a.in[19]; s.K = 1024; s.Nsrc = 4608; s.Ndst = 3072; s.WT = P.WB() + WE_O1; }
        else if (wi == 19) { s.W = a.in[19]; s.K = 1024; s.Nsrc = 4608; s.Ndst = 1536; s.soff = 3072; s.WT = P.WB() + WE_O2; }
        else { s.W = a.in[20]; s.K = 512; s.Nsrc = 1024; s.Ndst = 1024; s.WT = P.WB() + WE_OO; }
        s.nvalid = (wi == 15 || wi == 16) ? 64 : s.Ndst;
        const int nitems = (s.K / 128) * (s.Ndst / 32);
        { int it0 = (gw - cum) % NGW; if (it0 < 0) it0 += NGW; for (int it = it0; it < nitems; it += NGW) transpose_item(s, scr, it, lane); cum = (cum + nitems) % NGW; }
    }
    { const float* x = a.in[0]; const size_t n8 = (size_t)T * DM / 8; const size_t gt = (size_t)gw * 64 + lane, NT_ = (size_t)NGW * 64;
#pragma unroll 4
      for (size_t i = gt; i < n8; i += NT_) { const f32x4 v0 = *(const f32x4*)(x + i * 8), v1 = *(const f32x4*)(x + i * 8 + 4);
          u32x4 o; o.x = cvt_pk_bf16(v0[0], v0[1]); o.y = cvt_pk_bf16(v0[2], v0[3]); o.z = cvt_pk_bf16(v1[0], v1[1]); o.w = cvt_pk_bf16(v1[2], v1[3]); *(u32x4*)(P.XB() + i * 8) = o; } }
    if (gw < 512) { const int kv = gw >> 8, nn = gw & 255; const float* w1 = kv ? a.in[16] : a.in[14]; const float* cp = a.in[13]; float sacc = 0.f;
        for (int i = 0; i < 32; ++i) { const int kk = lane + 64 * i; sacc += cp[kk] * w1[(size_t)kk * 256 + nn]; }
        sacc = wave_sum(sacc); if (lane == 0) P.CB()[kv * 256 + nn] = sacc; }
    if (gw == 0) { P.CTL()[lane] = 0u; if (lane < 28) ((const float**)(P.ws + WS_PT))[lane] = a.in[lane]; }
}
__device__ __forceinline__ void ln_pass(const KP& P, const float* gam, const float* bet, bool write_x, int lane, int gw, int NGW) {
    float* ST = (float*)(P.ws + WS_ST);
    f32x4 gv[4], bv[4];
#pragma unroll
    for (int j = 0; j < 4; ++j) { gv[j] = *(const f32x4*)(gam + 4 * lane + 256 * j); bv[j] = *(const f32x4*)(bet + 4 * lane + 256 * j); }
    for (int row = gw; row < T; row += 2 * NGW) {
        const int row2 = row + NGW; const bool has2 = row2 < T;
        float* xr = P.out + (size_t)row * DM + 4 * lane; float* xr2 = P.out + (size_t)(has2 ? row2 : row) * DM + 4 * lane;
        f32x4 v[4], u[4]; float s = 0.f, t = 0.f;
#pragma unroll
        for (int j = 0; j < 4; ++j) { v[j] = *(const f32x4*)(xr + 256 * j); u[j] = *(const f32x4*)(xr2 + 256 * j); }
#pragma unroll
        for (int j = 0; j < 4; ++j) { s += (v[j][0] + v[j][1]) + (v[j][2] + v[j][3]); t += (u[j][0] + u[j][1]) + (u[j][2] + u[j][3]); }
        const float mean = wave_sum(s) * (1.f / DM), mean2 = wave_sum(t) * (1.f / DM); float s2 = 0.f, t2 = 0.f;
#pragma unroll
        for (int j = 0; j < 4; ++j) { v[j] = v[j] - mean; s2 += (v[j][0] * v[j][0] + v[j][1] * v[j][1]) + (v[j][2] * v[j][2] + v[j][3] * v[j][3]);
                                      u[j] = u[j] - mean2; t2 += (u[j][0] * u[j][0] + u[j][1] * u[j][1]) + (u[j][2] * u[j][2] + u[j][3] * u[j][3]); }
        const float rstd = 1.f / sqrtf(wave_sum(s2) * (1.f / DM) + 1e-5f), rstd2 = 1.f / sqrtf(wave_sum(t2) * (1.f / DM) + 1e-5f);
        bf16* xb = P.XB() + (size_t)row * DM + 4 * lane; bf16* xb2 = P.XB() + (size_t)row2 * DM + 4 * lane;
#pragma unroll
        for (int j = 0; j < 4; ++j) { const f32x4 y = v[j] * rstd * gv[j] + bv[j]; if (write_x) *(f32x4*)(xr + 256 * j) = y;
            u32x2 o; o.x = cvt_pk_bf16(y[0], y[1]); o.y = cvt_pk_bf16(y[2], y[3]); *(u32x2*)(xb + 256 * j) = o; }
        if (lane == 0) { ST[2 * row] = mean; ST[2 * row + 1] = rstd; if (has2) { ST[2 * row2] = mean2; ST[2 * row2 + 1] = rstd2; } }
        if (has2) {
#pragma unroll
            for (int j = 0; j < 4; ++j) { const f32x4 y = u[j] * rstd2 * gv[j] + bv[j]; if (write_x) *(f32x4*)(xr2 + 256 * j) = y;
                u32x2 o; o.x = cvt_pk_bf16(y[0], y[1]); o.y = cvt_pk_bf16(y[2], y[3]); *(u32x2*)(xb2 + 256 * j) = o; }
        }
    }
}
__device__ __forceinline__ void small_pass(const KP& P, int lane, int gw, int NGW) {
    constexpr int NR = 4;
    const int lq = lane < 48 ? lane : 47, lg = lane < 32 ? 0 : (lane < 56 ? lane - 32 : 23);
    double inv = 1.0; for (int k = 0; k < (lane & 15); ++k) inv *= 0.5623413251903491;
    for (int tok0 = gw; tok0 < T; tok0 += NR * NGW) {
        u32x4 cq[NR], ck[NR]; bf16 p1[NR], p2[NR], gl[NR]; int ps[NR];
#pragma unroll
        for (int r = 0; r < NR; ++r) { const int tok = tok0 + r * NGW < T ? tok0 + r * NGW : tok0; const bf16* he = P.HE() + (size_t)tok * HE_LD;
            cq[r] = *(const u32x4*)(he + lq * 8); ck[r] = *(const u32x4*)(he + HE_CKV + (lane & 31) * 8);
            p1[r] = he[HE_KPE + (lane & 15)]; p2[r] = he[HE_KPE + 16 + (lane & 15)]; gl[r] = he[HE_GT + lg]; ps[r] = P.pos[tok]; }
#pragma unroll
        for (int r = 0; r < NR; ++r) {
            const int tok = tok0 + r * NGW; float sq = 0.f, skv = 0.f;
#pragma unroll
            for (int e2 = 0; e2 < 4; ++e2) { const float a0 = __uint_as_float(cq[r][e2] << 16), a1 = __uint_as_float(cq[r][e2] & 0xffff0000u); sq += a0 * a0 + a1 * a1;
                                             const float b0 = __uint_as_float(ck[r][e2] << 16), b1 = __uint_as_float(ck[r][e2] & 0xffff0000u); skv += b0 * b0 + b1 * b1; }
            sq = wave_sum(lane < 48 ? sq : 0.f); skv = wave_sum(lane < 32 ? skv : 0.f);
            if (tok < T) {
                if (lane == 0) { P.RSTD()[tok] = 1.f / sqrtf(sq * (1.f / 384.f) + 1e-6f); P.RSTD()[T + tok] = 1.f / sqrtf(skv * (1.f / 256.f) + 1e-6f); }
                if (lane < 16) {
                    const double rev = (double)ps[r] * inv * 0.15915494309189535; const float fr = (float)(rev - floor(rev));
                    const float sn = __builtin_amdgcn_sinf(fr), cs = __builtin_amdgcn_cosf(fr);
                    P.RT()[(size_t)tok * 32 + 2 * lane] = cs; P.RT()[(size_t)tok * 32 + 2 * lane + 1] = sn;
                    const float x1 = bf2f(p1[r]), x2 = bf2f(p2[r]);
                    const int q1 = 8 * (lane >> 2) + (lane & 3);
                    const unsigned o1 = cvt_pk_bf16(x1 * cs - x2 * sn, 0.f), o2 = cvt_pk_bf16(x2 * cs + x1 * sn, 0.f);
                    P.KROT()[(size_t)tok * 32 + q1] = (bf16)(o1 & 0xffffu); P.KROT()[(size_t)tok * 32 + q1 + 4] = (bf16)(o2 & 0xffffu);
                }
                if (lane >= 32 && lane < 56) { const float x = bf2f(gl[r]); P.GT()[(size_t)tok * 24 + (lane - 32)] = fast_rcp(1.f + fast_exp2(-LOG2E * x)); }
            }
        }
    }
}
__device__ __forceinline__ void merge_pass(const KP& P, int lane, int gw, int NGW) {
    const size_t n = (size_t)T * 64, gt = (size_t)gw * 64 + lane, NT_ = (size_t)NGW * 64;
    for (size_t idx = gt; idx < n; idx += NT_) {
        const size_t tok = idx >> 6; const int col = (int)(idx & 63) * 8, h = col >> 7;
        const float l0 = P.LSE()[tok * 4 + h], l1 = P.LSE()[((size_t)T + tok) * 4 + h], l2 = P.LSE()[((size_t)2 * T + tok) * 4 + h];
        const float mx = fmaxf(l0, fmaxf(l1, l2)); float w0 = fast_exp2(l0 - mx), w1 = fast_exp2(l1 - mx), w2 = fast_exp2(l2 - mx);
        const float inv = 1.f / (w0 + w1 + w2); w0 *= inv; w1 *= inv; w2 *= inv;
        const u32x4 a = *(const u32x4*)(P.OG() + tok * 512 + col), b = *(const u32x4*)(P.OG() + ((size_t)T + tok) * 512 + col), c = *(const u32x4*)(P.OG() + ((size_t)2 * T + tok) * 512 + col);
        u32x4 o;
#pragma unroll
        for (int e = 0; e < 4; ++e) {
            const float lo = w0 * __uint_as_float(a[e] << 16) + w1 * __uint_as_float(b[e] << 16) + w2 * __uint_as_float(c[e] << 16);
            const float hi = w0 * __uint_as_float(a[e] & 0xffff0000u) + w1 * __uint_as_float(b[e] & 0xffff0000u) + w2 * __uint_as_float(c[e] & 0xffff0000u);
            o[e] = cvt_pk_bf16(lo, hi);
        }
        *(u32x4*)(P.OO() + tok * 512 + col) = o;
    }
}

#define ONE_LAUNCH 1
#define PROBE_F1 0
#define PROBE_O12 0
#define PROBE_EFRONT 0
#define PROBE_F2 0
#define USE_XBAR 1
#define PROBE_P0 0
#define PROBE_SYNC 0
#define PROBE_ATTE 0
#define PROBE_ATTO 0
#define PROBE_MLA_ONLY 0

enum { K_P0, K_F1, K_F2, K_LN, K_E12, K_SMALL, K_E345, K_C2, K_ATTE, K_OUTE, K_O12, K_ATTO, K_MERGE, K_OUTO };
constexpr int NPH = 25;
#define GEMM_CALL(EPI, g_, E_, off_) do { pg8::StaticOrder S_; S_.init((g_).M, (g_).N, (int)gridDim.x, (int)((blockIdx.x + (off_)) % gridDim.x)); \
    pg8::gemm_phase<EPI, pg8::StaticOrder, true, true>(lds, (g_), S_, (E_)); } while (0)

__global__ void __launch_bounds__(512, 2) mega(Args a) {
    extern __shared__ __attribute__((aligned(16))) unsigned char lds_raw[];
    LAS unsigned char* lds = (LAS unsigned char*)lds_raw;
    cg::grid_group grid = cg::this_grid();
    const int wv = __builtin_amdgcn_readfirstlane((int)threadIdx.x >> 6);
    const int G = gridDim.x, gw = blockIdx.x * 8 + wv, NGW = G * 8;
    KP P; unsigned char* ws = a.ws;
    P.out = a.out; P.ws = ws; P.pos = (const int*)a.in[1];
    LAS int* su = (LAS int*)(lds + LDS_BYTES - 64);
    volatile LAS unsigned* bst = (volatile LAS unsigned*)(lds + LDS_BYTES - 32);
    if (threadIdx.x < 2) bst[threadIdx.x] = 0u;
    __syncthreads();
    XcdBarrier bar = xcd_barrier_post((unsigned*)(a.ws + WS_CTL) + 4096, bst);

    if (a.ph_lo == 0) {
 p0_prologue(a, P, lds, threadIdx.x, gw, NGW);
#if PROBE_P0
 p0_prologue(a, P, lds, threadIdx.x, gw, NGW);
#endif
 if (a.ph_hi > 1) {
#if USE_XBAR
        if (a.ph_hi < 0) grid.sync();
        xcd_barrier(bar);
#else
        grid.sync();
#endif
    } }
#define IN(k) (((const float* const*)(P.ws + WS_PT))[k])
    for (int ph = (a.ph_lo == 0 ? 1 : a.ph_lo); ph < a.ph_hi; ++ph) {
        int tid = threadIdx.x; asm volatile("" : "+v"(tid));
        const int lane = tid & 63;
        { unsigned char* ws_i = a.ws; float* out_i = a.out; asm volatile("" : "+s"(ws_i), "+s"(out_i)); P.ws = ws_i; P.out = out_i; P.pos = (const int*)IN(1); }
        int kind, f = 0, lns = 0, layer = 0;
        switch (ph) {
            case 1: kind = K_F1; f = 0; break;  case 2: kind = K_F2; f = 0; break;  case 3: kind = K_LN; lns = 0; layer = 0; break;
            case 4: kind = K_E12; break; case 5: kind = K_SMALL; break; case 6: kind = K_E345; break; case 7: kind = K_C2; break; case 8: kind = K_ATTE; break; case 9: kind = K_OUTE; break;
            case 10: kind = K_LN; lns = 1; layer = 0; break;
            case 11: kind = K_F1; f = 1; break; case 12: kind = K_F2; f = 1; break; case 13: kind = K_LN; lns = 2; layer = 0; break;
            case 14: kind = K_F1; f = 2; break; case 15: kind = K_F2; f = 2; break; case 16: kind = K_LN; lns = 0; layer = 1; break;
            case 17: kind = K_O12; break; case 18: kind = K_ATTO; break; case 19: kind = K_MERGE; break; case 20: kind = K_OUTO; break;
            case 21: kind = K_LN; lns = 1; layer = 1; break;
            case 22: kind = K_F1; f = 3; break; case 23: kind = K_F2; f = 3; break; default: kind = K_LN; lns = 2; layer = 1; break;
        }
        if (kind == K_F1) {
            pg8::Gemm g{P.XB(), P.WB() + WE_GU + (size_t)f * 5632 * 1024, T, 5632, 1024, 1024, 1024, 128, 0}; EpiSwiglu E{P.H(), FF};
            GEMM_CALL(EpiSwiglu, g, E, 0);
#if PROBE_F1
            GEMM_CALL(EpiSwiglu, g, E, 0);
#endif
        }
        else if (kind == K_F2) {
            pg8::Gemm g{P.H(), P.WB() + WE_D + (size_t)f * 1024 * 2816, T, 1024, FF, FF, FF, 128, 0};
            if (f == 0) { EpiResidT<false> E{IN(0), P.out, P.ws, 0, 0, 0, DN_ALPHA, 0.5f}; GEMM_CALL(EpiResidT<false>, g, E, 0); }
            else {
#if PROBE_F2
                { EpiResidT<true> E{P.out, (float*)(P.ws + WS_R + 352 * MiB), P.ws, (f == 2 ? 26 : 21), (f == 2 ? 27 : 22), (f == 3 ? DM : 0), DN_ALPHA, 0.5f}; GEMM_CALL(EpiResidT<true>, g, E, 0); }
#endif
 EpiResidT<true> E{P.out, P.out, P.ws, (f == 2 ? 26 : 21), (f == 2 ? 27 : 22), (f == 3 ? DM : 0), DN_ALPHA, 0.5f}; GEMM_CALL(EpiResidT<true>, g, E, 0); }
        }
        else if (kind == K_OUTE) {
            pg8::Gemm g{P.OE(), P.WB() + WE_OE, T, 1024, 1024, 1024, 1024, 128, 0}; EpiResidT<true> E{P.out, P.out, P.ws, 2, 3, 0, DN_ALPHA, 1.f};
            GEMM_CALL(EpiResidT<true>, g, E, 0);
        }
        else if (kind == K_OUTO) {
            pg8::Gemm g{P.OO(), P.WB() + WE_OO, T, 1024, 512, 512, 512, 128, 0}; EpiResidT<true> E{P.out, P.out, P.ws, 2, 3, DM, DN_ALPHA, 1.f};
            GEMM_CALL(EpiResidT<true>, g, E, 0);
        }
        else if (kind == K_LN) {
            const float* gam = (lns == 0 ? IN(2) : (lns == 1 ? IN(21) : IN(26))) + layer * DM;
            const float* bet = (lns == 0 ? IN(3) : (lns == 1 ? IN(22) : IN(27))) + layer * DM;

#ifndef DIS_LN
 ln_pass(P, gam, bet, ph == NPH - 1, lane, gw, NGW);
#endif

        }
        else if (kind == K_SMALL) {
#ifndef DIS_SMALL
 small_pass(P, lane, gw, NGW);
#endif
 }
        else if (kind == K_MERGE) {
#ifndef DIS_MERGE
 merge_pass(P, lane, gw, NGW);
#endif
 }
        else if (kind == K_E12) {
            { pg8::Gemm g{P.XB(), P.WB() + WE_E1, T, 1792, 1024, 1024, 1024, 128, 0}; EpiStore E{P.HE(), HE_LD, nullptr, nullptr, nullptr, 0, 1792, T, 0, 0}; GEMM_CALL(EpiStore, g, E, 0); }
            { pg8::Gemm g{P.WB() + WE_E2, P.XB(), 256, T, 1024, 1024, 1024, 128, 0}; EpiStore E{P.VT(), T, nullptr, nullptr, nullptr, 0, T, 256, 0, 0}; GEMM_CALL(EpiStore, g, E, 0); }
        }
        else if (kind == K_E345) {
            for (int j = 0; j < 4; ++j) { const int kv = j >> 1, gg = j & 1;
                pg8::Gemm g{P.HE() + (kv ? HE_VC : HE_KC) + gg * 64, P.WB() + (kv ? WE_C1V : WE_C1K), 8192, 256, 2048, 16 * HE_LD, 2048, HE_LD * 2, 0};
                EpiStore E{P.HC() + (size_t)j * 8192 * 256, 256, nullptr, nullptr, P.CB() + kv * 256, 1, 256, 8192, 0, 0}; GEMM_CALL(EpiStore, g, E, 32 * j); }
            { pg8::Gemm g{P.HE() + HE_CQ, P.WB() + WE_UQ, T, 768, 384, HE_LD, 384, 128, 0}; EpiRopeQ E{P.QM(), 768, P.RSTD(), P.RT(), 0.10206207261596575f * LOG2E}; GEMM_CALL(EpiRopeQ, g, E, 128); }
            { pg8::Gemm g{P.HE() + HE_CKV, P.WB() + WE_UK, T, 512, 256, HE_LD, 256, 128, 0}; EpiStore E{P.KN(), 512, P.RSTD() + T, nullptr, nullptr, 0, 512, T, 0, 0}; GEMM_CALL(EpiStore, g, E, 128); }
            { pg8::Gemm g{P.WB() + WE_UV, P.HE() + HE_CKV, 512, T, 256, 256, HE_LD, 128, 0}; EpiStore E{P.VMT(), T, nullptr, P.RSTD() + T, nullptr, 0, T, 512, 0, 0}; GEMM_CALL(EpiStore, g, E, 128); }
        }
        else if (kind == K_C2) {
            for (int gg = 0; gg < 2; ++gg) { pg8::Gemm g{P.HC() + (size_t)gg * 8192 * 256, P.WB() + WE_C2K, 8192, 256, 256, 256, 256, 128, 0};
                EpiStore E{P.KCC() + gg * 64, 128, nullptr, nullptr, nullptr, 0, 64, 8192, 1, 0}; GEMM_CALL(EpiStore, g, E, 32 * gg); }
            for (int gg = 0; gg < 2; ++gg) { pg8::Gemm g{P.WB() + WE_C2V, P.HC() + (size_t)(2 + gg) * 8192 * 256, 256, 8192, 256, 256, 256, 128, 0};
                EpiStore E{P.VCT() + (size_t)gg * 64 * 8192, 8192, nullptr, nullptr, nullptr, 0, 8192, 64, 0, 1}; GEMM_CALL(EpiStore, g, E, 64 + 32 * gg); }
        }
        else if (kind == K_O12) {
            { pg8::Gemm g{P.XB(), P.WB() + WE_O1, T, 3072, 1024, 1024, 1024, 128, 0}; EpiStore E{P.QK(), 3072, nullptr, nullptr, nullptr, 0, 3072, T, 0, 0}; GEMM_CALL(EpiStore, g, E, 0); }
            for (int gg = 0; gg < 3; ++gg) { const int dil = gg == 0 ? 1 : (gg == 1 ? 4 : 16);
                pg8::Gemm g{P.WB() + WE_O2 + (size_t)gg * 512 * 1024, P.XB(), 512, T, 1024, 1024, dil * 1024, 128, dil};
                EpiStore E{P.VOT() + (size_t)gg * 512 * T, T, nullptr, nullptr, nullptr, 0, T, 512, 0, 0}; GEMM_CALL(EpiStore, g, E, 0); }
        }
        else if (kind == K_ATTE) {
            __syncthreads();
            const unsigned xq = bar.x & 7u;
            for (;;) {
                if (tid == 0) { int uu = -1;
                    for (unsigned k = 0; k < 8u && uu < 0; ++k) { const unsigned q = (xq + k) & 7u; const unsigned i = atomicAdd(&P.CTL()[16 + q], 1u); if (i < 512u) uu = (int)(q * 512u + i); }
                    *su = uu; }
                __syncthreads(); const int u = *su; __syncthreads();
                if (u < 0) break;
                const int q = u >> 9, i = u & 511;
                if (i < 256) { const int qb = 31 - (i >> 3), bh = q * 8 + (i & 7);
#ifndef DIS_MLA
 mla_unit(P, lds, bh >> 3, bh & 7, qb, tid);
#endif
 }
                else { const int j = i - 256, c = 127 - (j >> 1), bg = q * 2 + (j & 1);
#ifndef DIS_NSA
 nsa_unit(P, lds, bg >> 1, c, bg & 1, tid);
#endif
 }
            }
        }
        else if (kind == K_ATTO) {
            __syncthreads();
            const unsigned xq = bar.x & 7u;
            for (;;) {
                if (tid == 0) { int uu = -1;
                    for (unsigned k = 0; k < 8u && uu < 0; ++k) { const unsigned q = (xq + k) & 7u; const unsigned i = atomicAdd(&P.CTL()[32 + q], 1u); if (i < 384u) uu = (int)(q * 384u + i); }
                    *su = uu; }
                __syncthreads(); const int u = *su; __syncthreads();
                if (u < 0) break;
                const int rj = u & 31, rest = u >> 5, h = rest & 3, g = (rest >> 2) % 3, b = rest / 12;
#ifndef DIS_DIL
 dil_unit(P, lds, b, g, h, rj, tid);
#endif
            }
        }
        if (ph + 1 < a.ph_hi) {
#if USE_XBAR
            xcd_barrier(bar);
#else
            grid.sync();
#endif
        }
#if PROBE_SYNC
        if (ph + 1 < a.ph_hi) { grid.sync(); grid.sync(); }
#endif
    }
}

#ifndef ONE_LAUNCH_X
#define ONE_LAUNCH 1
#endif
extern "C" void kernel_launch(void* const* d_in, const int* in_sizes, int n_in, void* d_out, int out_size, void* d_ws, size_t ws_size, hipStream_t stream) {
    static int grid = 0;
    if (grid == 0) {
        if (n_in != 28 || ws_size < WS_NEED) { fprintf(stderr, "kernel_launch: unexpected n_in %d / ws %zu\n", n_in, ws_size); grid = -1; return; }
        int dev = 0, cus = 0, per_cu = 0;
        hipGetDevice(&dev); hipDeviceGetAttribute(&cus, hipDeviceAttributeMultiprocessorCount, dev);
        if (hipFuncSetAttribute((const void*)mega, hipFuncAttributeMaxDynamicSharedMemorySize, LDS_BYTES) != hipSuccess) { fprintf(stderr, "hipFuncSetAttribute failed\n"); grid = -1; return; }
        hipOccupancyMaxActiveBlocksPerMultiprocessor(&per_cu, (const void*)mega, 512, LDS_BYTES);
        if (per_cu < 1) per_cu = 1;
        grid = cus * 1;
        (void)hipGetLastError();
    }
    if (grid < 0) return;
    if (hipMemsetAsync((char*)d_ws + WS_CTL, 0, 65536, stream) != hipSuccess) { fprintf(stderr, "memset failed\n"); return; }
    Args a{};
    for (int i = 0; i < 28; ++i) a.in[i] = (const float*)d_in[i];
    a.out = (float*)d_out; a.ws = (unsigned char*)d_ws;
#if ONE_LAUNCH
    a.ph_lo = 0; a.ph_hi = NPH;
    void* args[] = {&a};
    hipError_t e = hipLaunchCooperativeKernel((const void*)mega, dim3(grid), dim3(512), args, LDS_BYTES, stream);
    if (e != hipSuccess) fprintf(stderr, "cooperative launch failed: %s (grid %d)\n", hipGetErrorString(e), grid);
#else
    for (int ph = 0; ph < NPH; ++ph) { a.ph_lo = ph; a.ph_hi = ph + 1; hipLaunchKernelGGL(mega, dim3(grid), dim3(512), LDS_BYTES, stream, a); }
#endif
}
```
